# Optimizing an MI355X kernel written in HIP

```python
import jax, jax.numpy as jnp
from jax import lax
import numpy as np

D_MODEL = 1024
BATCH = 4
SEQ = 4096
DEPTH = 2

GM_GROUPS = 4
GM_DIM = 256
GM_CHUNK = 128
GM_WIDTH = GM_GROUPS * GM_DIM
RET_HEADS = 4
RET_QK_DIM = 128
RET_V_DIM = 256
RET_CHUNK = 128
RET_QK_WIDTH = RET_HEADS * RET_QK_DIM
RET_V_WIDTH = RET_HEADS * RET_V_DIM
HY_SPLITS = [GM_WIDTH, 2 * GM_WIDTH, 2 * GM_WIDTH + RET_QK_WIDTH,
             2 * GM_WIDTH + 2 * RET_QK_WIDTH, 2 * GM_WIDTH + 2 * RET_QK_WIDTH + RET_V_WIDTH]
HY_IN_WIDTH = 2 * GM_WIDTH + 2 * RET_QK_WIDTH + 2 * RET_V_WIDTH
HY_OUT_WIDTH = GM_WIDTH + RET_V_WIDTH
MLA_HEADS = 8
MLA_Q_RANK = 384
MLA_KV_RANK = 256
MLA_NOPE_DIM = 128
MLA_ROPE_DIM = 64
MLA_V_DIM = 128
MLA_QK_DIM = MLA_NOPE_DIM + MLA_ROPE_DIM
MLA_DOWN_WIDTH = MLA_Q_RANK + MLA_KV_RANK + MLA_ROPE_DIM
Q_BLOCK = 128
ROPE_THETA = 10000.0
PEER_HEADS = 8
PEER_N_KEYS = 128
PEER_N_EXPERTS = PEER_N_KEYS * PEER_N_KEYS
PEER_QUERY_DIM = 256
PEER_HALF = PEER_QUERY_DIM // 2
PEER_TOPK = 16
PEER_TOKEN_BLOCK = 128
NORM_EPS = 1e-6

kernel_name = "gmlp_retention_mla_peer_hybrid"


def rmsnorm(x, g):
    xf = x.astype(jnp.float32)
    y = xf * lax.rsqrt(jnp.mean(xf * xf, axis=-1, keepdims=True) + NORM_EPS)
    return (y * g.astype(jnp.float32)).astype(x.dtype)


def rope(x):
    s, d = x.shape[1], x.shape[-1]
    half = d // 2
    inv = 1.0 / (ROPE_THETA ** (jnp.arange(half, dtype=jnp.float32) / half))
    ang = jnp.arange(s, dtype=jnp.float32)[:, None] * inv[None, :]
    cos = jnp.cos(ang)[None, :, None, :]
    sin = jnp.sin(ang)[None, :, None, :]
    xf = x.astype(jnp.float32)
    x1, x2 = xf[..., :half], xf[..., half:]
    return jnp.concatenate([x1 * cos - x2 * sin, x1 * sin + x2 * cos], axis=-1).astype(x.dtype)


def chunk_gating_mlp(u, v, v_norm, w_s, b_s):
    b, s, _ = u.shape
    nc = s // GM_CHUNK
    v = rmsnorm(v.reshape(b, s, GM_GROUPS, GM_DIM), v_norm.reshape(GM_GROUPS, GM_DIM))
    v = v.reshape(b, nc, GM_CHUNK, GM_GROUPS, GM_DIM)
    causal = jnp.tril(jnp.ones((GM_CHUNK, GM_CHUNK), dtype=bool))
    w = jnp.where(causal[None], w_s, 0.0).astype(v.dtype)
    mixed = jnp.einsum('gts,bnsgd->bntgd', w, v) + jnp.transpose(b_s)[None, None, :, :, None]
    return u * mixed.reshape(b, s, GM_WIDTH)


def retention(q, k, v):
    b, s, h, dk = q.shape
    dv = v.shape[-1]
    c = RET_CHUNK
    nc = s // c
    log_gamma = jnp.log(1.0 - 2.0 ** (-5.0 - jnp.arange(h, dtype=jnp.float32)))
    pos = jnp.arange(c, dtype=jnp.float32)
    diff = pos[:, None] - pos[None, :]
    decay_mask = jnp.where(diff[None] >= 0, jnp.exp(diff[None] * log_gamma[:, None, None]), 0.0)
    q_decay = jnp.exp((pos[:, None] + 1.0) * log_gamma[None, :])
    k_decay = jnp.exp((c - 1.0 - pos[:, None]) * log_gamma[None, :])
    chunk_decay = jnp.exp(c * log_gamma)
    qf = q.astype(jnp.float32).reshape(b, nc, c, h, dk)
    kf = k.astype(jnp.float32).reshape(b, nc, c, h, dk) * (dk ** -0.5)
    vf = v.astype(jnp.float32).reshape(b, nc, c, h, dv)
    scores = jnp.einsum('bnihd,bnjhd->bnhij', qf, kf) * decay_mask[None, None]
    intra = jnp.einsum('bnhij,bnjhe->bnihe', scores, vf)

    def step(state, inp):
        qc, kc, vc = inp
        cross = jnp.einsum('bchd,bhde->bche', qc, state) * q_decay[None, :, :, None]
        state = state * chunk_decay[None, :, None, None] + jnp.einsum(
            'bchd,bche->bhde', kc, vc * k_decay[None, :, :, None])
        return state, cross

    init = jnp.zeros((b, h, dk, dv), jnp.float32)
    _, cross = lax.scan(step, init, (jnp.moveaxis(qf, 1, 0), jnp.moveaxis(kf, 1, 0), jnp.moveaxis(vf, 1, 0)))
    out = intra + jnp.moveaxis(cross, 0, 1)
    return out.reshape(b, s, h, dv).astype(v.dtype)


def gmlp_retention_mixer(h, w_in, gm_v_norm, gm_w_s, gm_b_s, ret_norm, w_out):
    b, s, _ = h.shape
    proj = h @ w_in
    a_u, a_v, r_q, r_k, r_v, r_g = jnp.split(proj, HY_SPLITS, axis=-1)
    y_a = chunk_gating_mlp(jax.nn.gelu(a_u, approximate=False), jax.nn.gelu(a_v, approximate=False),
                           gm_v_norm, gm_w_s, gm_b_s)
    q = rope(r_q.reshape(b, s, RET_HEADS, RET_QK_DIM))
    k = rope(r_k.reshape(b, s, RET_HEADS, RET_QK_DIM))
    y_b = retention(q, k, r_v.reshape(b, s, RET_HEADS, RET_V_DIM))
    y_b = rmsnorm(y_b, ret_norm.reshape(RET_HEADS, RET_V_DIM)).reshape(b, s, RET_V_WIDTH)
    y_b = jax.nn.silu(r_g) * y_b
    return jnp.concatenate([y_a, y_b], axis=-1) @ w_out


def causal_block_attention(q, k, v):
    b, s, h, d = q.shape
    dv = v.shape[-1]
    nb = s // Q_BLOCK
    scale = d ** -0.5
    qb = jnp.moveaxis(q.reshape(b, nb, Q_BLOCK, h, d), 1, 0)
    k_pos = jnp.arange(s)

    def one_block(inp):
        q_blk, i = inp
        scores = jnp.einsum('bqhd,bkhd->bhqk', q_blk, k).astype(jnp.float32) * scale
        q_pos = i * Q_BLOCK + jnp.arange(Q_BLOCK)
        mask = k_pos[None, :] <= q_pos[:, None]
        scores = jnp.where(mask[None, None], scores, -jnp.inf)
        p = jax.nn.softmax(scores, axis=-1).astype(v.dtype)
        return jnp.einsum('bhqk,bkhe->bqhe', p, v)

    out = lax.map(one_block, (qb, jnp.arange(nb)))
    return jnp.moveaxis(out, 0, 1).reshape(b, s, h, dv)


def mla(h, w_down, q_norm, w_q_up, kv_norm, w_kv_up, w_out):
    b, s, _ = h.shape
    down = h @ w_down
    c_q, c_kv, k_rope = jnp.split(down, [MLA_Q_RANK, MLA_Q_RANK + MLA_KV_RANK], axis=-1)
    q = (rmsnorm(c_q, q_norm) @ w_q_up).reshape(b, s, MLA_HEADS, MLA_QK_DIM)
    q = jnp.concatenate([q[..., :MLA_NOPE_DIM], rope(q[..., MLA_NOPE_DIM:])], axis=-1)
    kv = (rmsnorm(c_kv, kv_norm) @ w_kv_up).reshape(b, s, MLA_HEADS, MLA_NOPE_DIM + MLA_V_DIM)
    k_nope, v = kv[..., :MLA_NOPE_DIM], kv[..., MLA_NOPE_DIM:]
    k_rope = rope(k_rope[:, :, None, :])
    k = jnp.concatenate([k_nope, jnp.broadcast_to(k_rope, (b, s, MLA_HEADS, MLA_ROPE_DIM))], axis=-1)
    o = causal_block_attention(q, k, v)
    return o.reshape(b, s, MLA_HEADS * MLA_V_DIM) @ w_out


def peer(h, w_q, sub_keys, u_tab, v_tab):
    b, s, dm = h.shape
    t = b * s
    xt = h.reshape(t, dm)
    qry = (xt @ w_q).reshape(t, PEER_HEADS, 2, PEER_HALF)
    scores = jnp.einsum('thpd,pkd->thpk', qry, sub_keys).astype(jnp.float32)
    top_s, top_i = lax.top_k(scores, PEER_TOPK)
    cand = top_s[:, :, 0, :, None] + top_s[:, :, 1, None, :]
    best_s, best_c = lax.top_k(cand.reshape(t, PEER_HEADS, PEER_TOPK * PEER_TOPK), PEER_TOPK)
    i1 = jnp.take_along_axis(top_i[:, :, 0], best_c // PEER_TOPK, axis=-1)
    i2 = jnp.take_along_axis(top_i[:, :, 1], best_c % PEER_TOPK, axis=-1)
    experts = i1 * PEER_N_KEYS + i2
    gates = jax.nn.softmax(best_s, axis=-1).astype(h.dtype)
    nb = t // PEER_TOKEN_BLOCK

    def block(inp):
        xb, eb, gb = inp
        act = jax.nn.gelu(jnp.einsum('td,thkd->thk', xb, u_tab[eb]), approximate=False)
        return jnp.einsum('thk,thkd->td', gb * act, v_tab[eb])

    out = lax.map(block, (xt.reshape(nb, PEER_TOKEN_BLOCK, dm),
                          experts.reshape(nb, PEER_TOKEN_BLOCK, PEER_HEADS, PEER_TOPK),
                          gates.reshape(nb, PEER_TOKEN_BLOCK, PEER_HEADS, PEER_TOPK)))
    return out.reshape(b, s, dm)


def setup_inputs(seed: int = 0) -> dict:
    key = jax.random.key(seed)
    ks = jax.random.split(key, 24)
    n_even = (DEPTH + 1) // 2
    n_odd = DEPTH // 2
    f32 = jnp.float32

    def nrm(k, shape, scale):
        return jax.random.normal(k, shape, f32) * scale

    def gain(k, shape):
        return 1.0 + 0.01 * jax.random.normal(k, shape, f32)

    return {
        "x": jax.random.normal(ks[0], (BATCH, SEQ, D_MODEL), f32),
        "norm_mix": gain(ks[1], (DEPTH, D_MODEL)),
        "norm_ffn": gain(ks[2], (DEPTH, D_MODEL)),
        "hy_w_in": nrm(ks[3], (n_even, D_MODEL, HY_IN_WIDTH), D_MODEL ** -0.5),
        "gm_v_norm": gain(ks[4], (n_even, GM_WIDTH)),
        "gm_w_s": nrm(ks[5], (n_even, GM_GROUPS, GM_CHUNK, GM_CHUNK), GM_CHUNK ** -0.5),
        "gm_b_s": gain(ks[6], (n_even, GM_GROUPS, GM_CHUNK)),
        "ret_norm": gain(ks[7], (n_even, RET_V_WIDTH)),
        "hy_w_out": nrm(ks[8], (n_even, HY_OUT_WIDTH, D_MODEL), HY_OUT_WIDTH ** -0.5),
        "mla_w_down": nrm(ks[9], (n_odd, D_MODEL, MLA_DOWN_WIDTH), D_MODEL ** -0.5),
        "mla_q_norm": gain(ks[10], (n_odd, MLA_Q_RANK)),
        "mla_w_q_up": nrm(ks[11], (n_odd, MLA_Q_RANK, MLA_HEADS * MLA_QK_DIM), MLA_Q_RANK ** -0.5),
        "mla_kv_norm": gain(ks[12], (n_odd, MLA_KV_RANK)),
        "mla_w_kv_up": nrm(ks[13], (n_odd, MLA_KV_RANK, MLA_HEADS * (MLA_NOPE_DIM + MLA_V_DIM)), MLA_KV_RANK ** -0.5),
        "mla_w_out": nrm(ks[14], (n_odd, MLA_HEADS * MLA_V_DIM, D_MODEL), (MLA_HEADS * MLA_V_DIM) ** -0.5),
        "peer_w_q": nrm(ks[15], (DEPTH, D_MODEL, PEER_HEADS * PEER_QUERY_DIM), D_MODEL ** -0.5),
        "peer_sub_keys": nrm(ks[16], (DEPTH, 2, PEER_N_KEYS, PEER_HALF), PEER_HALF ** -0.5),
        "peer_u": nrm(ks[17], (DEPTH, PEER_N_EXPERTS, D_MODEL), D_MODEL ** -0.5),
        "peer_v": nrm(ks[18], (DEPTH, PEER_N_EXPERTS, D_MODEL), PEER_HEADS ** -0.5),
        "final_norm": gain(ks[19], (D_MODEL,)),
    }


def reference(x, norm_mix, norm_ffn, hy_w_in, gm_v_norm, gm_w_s, gm_b_s, ret_norm, hy_w_out,
              mla_w_down, mla_q_norm, mla_w_q_up, mla_kv_norm, mla_w_kv_up, mla_w_out,
              peer_w_q, peer_sub_keys, peer_u, peer_v, final_norm):
    for layer in range(DEPTH):
        j = layer // 2
        h = rmsnorm(x, norm_mix[layer])
        if layer % 2 == 0:
            x = x + gmlp_retention_mixer(h, hy_w_in[j], gm_v_norm[j], gm_w_s[j], gm_b_s[j],
                                         ret_norm[j], hy_w_out[j])
        else:
            x = x + mla(h, mla_w_down[j], mla_q_norm[j], mla_w_q_up[j], mla_kv_norm[j],
                        mla_w_kv_up[j], mla_w_out[j])
        h = rmsnorm(x, norm_ffn[layer])
        x = x + peer(h, peer_w_q[layer], peer_sub_keys[layer], peer_u[layer], peer_v[layer])
    return rmsnorm(x, final_norm)
```

```cpp
#include <hip/hip_runtime.h>
#include <hip/hip_cooperative_groups.h>
#include <cstdint>
#include <cstdio>
namespace cg = cooperative_groups;

typedef unsigned short u16;
typedef short bf16x8 __attribute__((ext_vector_type(8)));
typedef float f32x16 __attribute__((ext_vector_type(16)));
typedef float f32x4 __attribute__((ext_vector_type(4)));
typedef float f32x2 __attribute__((ext_vector_type(2)));
typedef unsigned u32x4 __attribute__((ext_vector_type(4)));
typedef unsigned u32x2 __attribute__((ext_vector_type(2)));
typedef __bf16 bf16v2 __attribute__((ext_vector_type(2)));

constexpr int T = 16384, DM = 1024, SEQ = 4096;
constexpr int HY_IN = 5120, HY_OUT = 2048;
constexpr int MLA_DOWN = 704, MLA_DOWN_PAD = 768, MLA_QR = 384, MLA_KVR = 256;
constexpr int NEXP = 16384;
constexpr float EPS = 1e-6f;
constexpr int NTHREADS = 256;
constexpr int LDS_BYTES = 81920;

constexpr size_t al256(size_t x) { return (x + 255) & ~(size_t)255; }
constexpr size_t WS_WINT   = 0;
constexpr size_t WS_WOUTT  = WS_WINT   + (size_t)HY_IN * DM * 2;
constexpr size_t WS_WDOWNT = WS_WOUTT  + (size_t)DM * HY_OUT * 2;
constexpr size_t WS_WQUPT  = WS_WDOWNT + (size_t)MLA_DOWN_PAD * DM * 2;
constexpr size_t WS_WKVUPT = WS_WQUPT  + (size_t)1536 * MLA_QR * 2;
constexpr size_t WS_WMOT   = WS_WKVUPT + (size_t)2048 * MLA_KVR * 2;
constexpr size_t WS_WPQT   = WS_WMOT   + (size_t)DM * DM * 2;
constexpr size_t WS_ROPE_R = WS_WPQT   + (size_t)2 * 2048 * DM * 2;
constexpr size_t WS_ROPE_M = WS_ROPE_R + (size_t)SEQ * 64 * 8;
constexpr size_t WS_UBF    = WS_ROPE_M + (size_t)SEQ * 32 * 8;
constexpr size_t WS_VBF    = WS_UBF    + (size_t)2 * NEXP * DM * 2;
constexpr size_t WS_H      = WS_VBF    + (size_t)2 * NEXP * DM * 2;
constexpr size_t WS_PROJ   = WS_H      + (size_t)T * DM * 2;
constexpr size_t WS_Y      = WS_PROJ   + (size_t)T * HY_IN * 2;
constexpr size_t WS_SSQ    = WS_Y      + (size_t)T * HY_OUT * 2;
constexpr size_t WS_DST    = WS_SSQ    + (size_t)T * 8 * 4;
constexpr size_t WS_EXP    = WS_DST    + (size_t)512 * 256 * 128 * 4;
constexpr size_t WS_GATE   = WS_EXP    + (size_t)T * 128 * 2;
constexpr size_t WS_END    = WS_GATE   + (size_t)T * 128 * 4;
constexpr size_t WS_Q      = WS_PROJ;
constexpr size_t WS_KV     = WS_Q  + (size_t)T * 1536 * 2;
constexpr size_t WS_DOWN   = WS_KV + (size_t)T * 2048 * 2;
constexpr size_t WS_SCORES = WS_PROJ;
constexpr size_t WS_O      = WS_Y;
constexpr size_t WS_CQN    = WS_O    + (size_t)T * DM * 2;
constexpr size_t WS_CKVN   = WS_CQN  + (size_t)T * MLA_QR * 2;
constexpr size_t WS_KROPE  = WS_CKVN + (size_t)T * MLA_KVR * 2;
static_assert(WS_DOWN + (size_t)T * 768 * 4 <= WS_Y, "overlay");
static_assert(WS_KROPE + (size_t)T * 64 * 2 <= WS_SSQ, "overlay");

struct Params {
    const float *x, *norm_mix, *norm_ffn, *hy_w_in, *gm_v_norm, *gm_w_s, *gm_b_s, *ret_norm, *hy_w_out;
    const float *mla_w_down, *mla_q_norm, *mla_w_q_up, *mla_kv_norm, *mla_w_kv_up, *mla_w_out;
    const float *peer_w_q, *peer_sub_keys, *peer_u, *peer_v, *final_norm;
    float* out;
    unsigned char* ws;
};

extern __shared__ __attribute__((aligned(16))) unsigned char smem[];

__device__ __forceinline__ unsigned pk2(float lo, float hi) { unsigned r; asm volatile("v_cvt_pk_bf16_f32 %0, %1, %2" : "=v"(r) : "v"(lo), "v"(hi)); return r; }
__device__ __forceinline__ u16 f2bf(float f) { return (u16)(pk2(f, 0.f) & 0xffffu); }
__device__ __forceinline__ float bflo(unsigned u) { return __uint_as_float(u << 16); }
__device__ __forceinline__ float bfhi(unsigned u) { return __uint_as_float(u & 0xffff0000u); }
__device__ __forceinline__ float bf2f(u16 h) { return __uint_as_float((unsigned)h << 16); }
__device__ __forceinline__ u32x4 pack8(const float* v) { u32x4 w; w.x = pk2(v[0], v[1]); w.y = pk2(v[2], v[3]); w.z = pk2(v[4], v[5]); w.w = pk2(v[6], v[7]); return w; }
__device__ __forceinline__ void unpack8(u32x4 w, float* v) { v[0] = bflo(w.x); v[1] = bfhi(w.x); v[2] = bflo(w.y); v[3] = bfhi(w.y); v[4] = bflo(w.z); v[5] = bfhi(w.z); v[6] = bflo(w.w); v[7] = bfhi(w.w); }
__device__ __forceinline__ float gelu_f(float v) { return 0.5f * v * (1.0f + erff(v * 0.70710678118654752f)); }
__device__ __forceinline__ float silu_f(float v) { return v / (1.0f + __expf(-v)); }
__device__ __forceinline__ float wave_sum(float v) {
#pragma unroll
    for (int o = 32; o >= 1; o >>= 1) v += __shfl_xor(v, o);
    return v;
}

__device__ __forceinline__ int opaque(int v) { asm volatile("" : "+v"(v)); return v; }

__device__ __forceinline__ int toff(int r, int c8) { return r * 128 + ((c8 ^ ((r >> 1) & 7)) << 4); }
__device__ __forceinline__ int toff_e(int r, int k) { return toff(r, k >> 3) + (k & 7) * 2; }

template <int PT, int QT>
__device__ __forceinline__ void mma_kb(f32x16 (&acc)[PT][QT], int Ps, int prow0, int Qs, int qrow0, int lane) {
    const int lr = lane & 31, hi = lane >> 5;
#pragma unroll
    for (int s = 0; s < 4; ++s) {
        const int c8 = 2 * s + hi;
        bf16x8 a[PT], b[QT];
#pragma unroll
        for (int i = 0; i < PT; ++i) a[i] = *(const bf16x8*)(smem + Ps + toff(prow0 + i * 32 + lr, c8));
#pragma unroll
        for (int j = 0; j < QT; ++j) b[j] = *(const bf16x8*)(smem + Qs + toff(qrow0 + j * 32 + lr, c8));
#pragma unroll
        for (int i = 0; i < PT; ++i)
#pragma unroll
            for (int j = 0; j < QT; ++j) acc[i][j] = __builtin_amdgcn_mfma_f32_32x32x16_bf16(a[i], b[j], acc[i][j], 0, 0, 0);
    }
#pragma unroll
    for (int i = 0; i < PT; ++i)
#pragma unroll
        for (int j = 0; j < QT; ++j) asm volatile("" : "+v"(acc[i][j]));
}

template <int ROWS>
__device__ __forceinline__ void gload_nat(u32x4 (&r)[ROWS / 32], const u16* src, int ld, int tid) {
    tid = opaque(tid);
#pragma unroll
    for (int i = 0; i < ROWS / 32; ++i) { const int idx = tid + 256 * i, row = idx >> 3, c8 = idx & 7; r[i] = *(const u32x4*)(src + (size_t)row * ld + c8 * 8); }
}
template <int ROWS>
__device__ __forceinline__ void sstore_nat(int lds, const u32x4 (&r)[ROWS / 32], int tid) {
    tid = opaque(tid);
#pragma unroll
    for (int i = 0; i < ROWS / 32; ++i) { const int idx = tid + 256 * i, row = idx >> 3, c8 = idx & 7; *(u32x4*)(smem + lds + toff(row, c8)) = r[i]; }
}
template <int ROWS, bool SCALE>
__device__ __forceinline__ void load_tr(int lds, const u16* src, int ld, int tid, const float* kscale) {
    constexpr int CH = ROWS / 8;
    tid = opaque(tid);
#pragma unroll 2
    for (int i = 0; i < (64 * CH) / 256; ++i) {
        const int idx = tid + 256 * i, k = idx / CH, nc = idx % CH;
        const u32x4 v = *(const u32x4*)(src + (size_t)k * ld + nc * 8);
        const unsigned wd[4] = {v.x, v.y, v.z, v.w};
        float sc = 1.f; if (SCALE) sc = kscale[k];
#pragma unroll
        for (int e = 0; e < 8; ++e) {
            u16 h;
            if (SCALE) h = f2bf(((e & 1) ? bfhi(wd[e >> 1]) : bflo(wd[e >> 1])) * sc);
            else h = (u16)((e & 1) ? (wd[e >> 1] >> 16) : (wd[e >> 1] & 0xffffu));
            *(u16*)(smem + lds + toff_e(nc * 8 + e, k)) = h;
        }
    }
}

constexpr int CS_LD = 132;
__device__ __forceinline__ void stage_c22(const f32x16 (&acc)[2][2], int wm, int wn, int lane) {
    const int lr = lane & 31, hi = lane >> 5;
#pragma unroll
    for (int i = 0; i < 2; ++i)
#pragma unroll
        for (int j = 0; j < 2; ++j)
#pragma unroll
            for (int q = 0; q < 4; ++q) {
                const int n = wm * 64 + i * 32 + 8 * q + 4 * hi, m = wn * 64 + j * 32 + lr;
                f32x4 v = {acc[i][j][4 * q], acc[i][j][4 * q + 1], acc[i][j][4 * q + 2], acc[i][j][4 * q + 3]};
                *(f32x4*)(smem + (m * CS_LD + n) * 4) = v;
            }
}
__device__ __forceinline__ void cs_read8(int m, int c, float* v) {
    const f32x4 a = *(const f32x4*)(smem + (m * CS_LD + c) * 4), b = *(const f32x4*)(smem + (m * CS_LD + c + 4) * 4);
    v[0] = a[0]; v[1] = a[1]; v[2] = a[2]; v[3] = a[3]; v[4] = b[0]; v[5] = b[1]; v[6] = b[2]; v[7] = b[3];
}

template <class Epi>
__device__ __forceinline__ void gemm_tile(const u16* A, int lda, const u16* Bt, int ldb, int K, int m0, int n0, Epi&& epi) {
    const int tid = opaque((int)threadIdx.x), lane = tid & 63, w = tid >> 6, wm = w >> 1, wn = w & 1;
    f32x16 acc[2][2];
#pragma unroll
    for (int i = 0; i < 2; ++i)
#pragma unroll
        for (int j = 0; j < 2; ++j)
#pragma unroll
            for (int r = 0; r < 16; ++r) acc[i][j][r] = 0.f;
    const u16* Ap = A + (size_t)m0 * lda; const u16* Bp = Bt + (size_t)n0 * ldb;
    u32x4 ra[4], rb[4];
    gload_nat<128>(ra, Ap, lda, tid); gload_nat<128>(rb, Bp, ldb, tid);
    const int nk = K >> 6;
    for (int kb = 0; kb < nk; ++kb) {
        const int buf = (kb & 1) * 32768;
        sstore_nat<128>(buf, rb, tid); sstore_nat<128>(buf + 16384, ra, tid);
        __syncthreads();
        if (kb + 1 < nk) { gload_nat<128>(ra, Ap + (kb + 1) * 64, lda, tid); gload_nat<128>(rb, Bp + (kb + 1) * 64, ldb, tid); }
        mma_kb<2, 2>(acc, buf, wm * 64, buf + 16384, wn * 64, lane);
    }
    __syncthreads();
    stage_c22(acc, wm, wn, lane);
    __syncthreads();
    epi(m0, n0);
    __syncthreads();
}

__device__ __forceinline__ void convT_tile(const float* W, int K, int N, u16* Wt, int kt, int nt, int tid) {
    u16* tile = (u16*)smem;
    __syncthreads();
#pragma unroll
    for (int i = 0; i < 16; ++i) {
        const int k = i * 4 + (tid >> 6), n = tid & 63, gn = nt * 64 + n;
        const float v = (gn < N) ? W[(size_t)(kt * 64 + k) * N + gn] : 0.f;
        tile[n * 72 + k] = f2bf(v);
    }
    __syncthreads();
    const int n = tid >> 2, kc = (tid & 3) * 16;
    const u32x4 a = *(const u32x4*)(tile + n * 72 + kc), b = *(const u32x4*)(tile + n * 72 + kc + 8);
    u16* dst = Wt + (size_t)(nt * 64 + n) * K + kt * 64 + kc;
    *(u32x4*)dst = a; *(u32x4*)(dst + 8) = b;
}
__device__ __forceinline__ void convT_all(const float* W, int K, int N, int Npad, u16* Wt, int bid, int nb, int tid) {
    const int nkt = K / 64, nnt = Npad / 64;
    for (int j = bid; j < nkt * nnt; j += nb) convT_tile(W, K, N, Wt, j % nkt, j / nkt, tid);
}
__device__ __forceinline__ void rmsnorm_rows(const float* X, const float* g, u16* H, int bid, int nb, int tid) {
    const int lane = tid & 63, w = tid >> 6;
    for (int row = bid * 4 + w; row < T; row += nb * 4) {
        const float* xr = X + (size_t)row * DM;
        f32x4 v[4]; float ss = 0.f;
#pragma unroll
        for (int c = 0; c < 4; ++c) { v[c] = *(const f32x4*)(xr + c * 256 + lane * 4); ss += v[c][0] * v[c][0] + v[c][1] * v[c][1] + v[c][2] * v[c][2] + v[c][3] * v[c][3]; }
        ss = wave_sum(ss);
        const float r = rsqrtf(ss * (1.0f / DM) + EPS);
#pragma unroll
        for (int c = 0; c < 4; ++c) {
            const f32x4 gg = *(const f32x4*)(g + c * 256 + lane * 4);
            u32x2 o; o.x = pk2(v[c][0] * r * gg[0], v[c][1] * r * gg[1]); o.y = pk2(v[c][2] * r * gg[2], v[c][3] * r * gg[3]);
            *(u32x2*)(H + (size_t)row * DM + c * 256 + lane * 4) = o;
        }
    }
}
__device__ __forceinline__ void phase_prep(const Params& p, int bid, int nb) {
    const int tid = threadIdx.x;
    unsigned char* ws = p.ws;
    convT_all(p.hy_w_in, DM, HY_IN, HY_IN, (u16*)(ws + WS_WINT), bid, nb, tid);
    convT_all(p.hy_w_out, HY_OUT, DM, DM, (u16*)(ws + WS_WOUTT), bid, nb, tid);
    convT_all(p.mla_w_down, DM, MLA_DOWN, MLA_DOWN_PAD, (u16*)(ws + WS_WDOWNT), bid, nb, tid);
    convT_all(p.mla_w_q_up, MLA_QR, 1536, 1536, (u16*)(ws + WS_WQUPT), bid, nb, tid);
    convT_all(p.mla_w_kv_up, MLA_KVR, 2048, 2048, (u16*)(ws + WS_WKVUPT), bid, nb, tid);
    convT_all(p.mla_w_out, DM, DM, DM, (u16*)(ws + WS_WMOT), bid, nb, tid);
    __syncthreads();
    {
        float* Wq_s = (float*)smem; float* key_s = (float*)(smem + 64 * 129 * 4);
        for (int j = bid; j < 2 * 16 * 16 * 2; j += nb) {
            const int kh = j & 1, kt = (j >> 1) & 15, hp = (j >> 5) & 15, L = j >> 9;
            const float* Wq = p.peer_w_q + (size_t)L * DM * 2048 + (size_t)(kt * 64) * 2048 + hp * 128;
            const float* ky = p.peer_sub_keys + (size_t)L * 2 * 128 * 128 + (size_t)(hp & 1) * 128 * 128 + (size_t)(kh * 64) * 128;
            __syncthreads();
#pragma unroll 4
            for (int i = 0; i < 32; ++i) { const int idx = tid + 256 * i, row = idx >> 7, d = idx & 127; Wq_s[row * 129 + d] = Wq[(size_t)row * 2048 + d]; key_s[row * 129 + d] = ky[row * 128 + d]; }
            __syncthreads();
            const int tk = tid & 15, tkey = tid >> 4;
            float acc[4][4];
#pragma unroll
            for (int a = 0; a < 4; ++a)
#pragma unroll
                for (int b = 0; b < 4; ++b) acc[a][b] = 0.f;
            for (int d = 0; d < 128; ++d) {
                float wv[4], kv[4];
#pragma unroll
                for (int a = 0; a < 4; ++a) { wv[a] = Wq_s[(tk * 4 + a) * 129 + d]; kv[a] = key_s[(tkey * 4 + a) * 129 + d]; }
#pragma unroll
                for (int a = 0; a < 4; ++a)
#pragma unroll
                    for (int b = 0; b < 4; ++b) acc[a][b] += kv[a] * wv[b];
            }
            u16* dst = (u16*)(ws + WS_WPQT) + (size_t)L * 2048 * DM;
#pragma unroll
            for (int a = 0; a < 4; ++a) {
                u32x2 o; o.x = pk2(acc[a][0], acc[a][1]); o.y = pk2(acc[a][2], acc[a][3]);
                *(u32x2*)(dst + (size_t)(hp * 128 + kh * 64 + tkey * 4 + a) * DM + kt * 64 + tk * 4) = o;
            }
        }
    }
    {
        const size_t n8 = (size_t)2 * NEXP * DM / 8;
        for (int tb = 0; tb < 2; ++tb) {
            const float* src = tb ? p.peer_v : p.peer_u; u16* dst = (u16*)(ws + (tb ? WS_VBF : WS_UBF));
            for (size_t i = (size_t)bid * 256 + tid; i < n8; i += (size_t)nb * 256) {
                const f32x4 a = *(const f32x4*)(src + i * 8), b = *(const f32x4*)(src + i * 8 + 4);
                u32x4 o; o.x = pk2(a[0], a[1]); o.y = pk2(a[2], a[3]); o.z = pk2(b[0], b[1]); o.w = pk2(b[2], b[3]);
                *(u32x4*)(dst + i * 8) = o;
            }
        }
    }
    {
        f32x2* rr = (f32x2*)(ws + WS_ROPE_R); f32x2* rm = (f32x2*)(ws + WS_ROPE_M);
        for (int i = bid * 256 + tid; i < SEQ * 64; i += nb * 256) {
            const int s = i >> 6, d = i & 63; const float inv = 1.0f / powf(10000.0f, (float)d / 64.0f); const float ang = (float)s * inv;
            float sn, cs; sincosf(ang, &sn, &cs); rr[i] = (f32x2){cs, sn};
        }
        for (int i = bid * 256 + tid; i < SEQ * 32; i += nb * 256) {
            const int s = i >> 5, d = i & 31; const float inv = 1.0f / powf(10000.0f, (float)d / 32.0f); const float ang = (float)s * inv;
            float sn, cs; sincosf(ang, &sn, &cs); rm[i] = (f32x2){cs, sn};
        }
    }
    rmsnorm_rows(p.x, p.norm_mix, (u16*)(ws + WS_H), bid, nb, tid);
}

__device__ __forceinline__ void phase_inproj(const Params& p, int bid, int nb) {
    unsigned char* ws = p.ws;
    const u16* A = (const u16*)(ws + WS_H); const u16* Bt = (const u16*)(ws + WS_WINT);
    u16* proj = (u16*)(ws + WS_PROJ); float* ssq = (float*)(ws + WS_SSQ); const f32x2* rope = (const f32x2*)(ws + WS_ROPE_R);
    const int tid = threadIdx.x;
    constexpr int NT = HY_IN / 128;
    for (int t = bid; t < (T / 128) * NT; t += nb) {
        const int mt = t / NT, nt = t % NT;
        gemm_tile(A, DM, Bt, DM, DM, mt * 128, nt * 128, [&](int m0, int n0) {
            if (n0 >= 2048 && n0 < 3072) {
                const float sc = (n0 >= 2560) ? 0.08838834764831845f : 1.0f;
#pragma unroll
                for (int ps = 0; ps < 4; ++ps) {
                    const int m = ps * 32 + (tid >> 3), c = (tid & 7) * 8;
                    float x1[8], x2[8], y1[8], y2[8]; cs_read8(m, c, x1); cs_read8(m, c + 64, x2);
                    const f32x2* rp = rope + (size_t)((m0 + m) & (SEQ - 1)) * 64 + c;
#pragma unroll
                    for (int e = 0; e < 8; ++e) { const f32x2 cssn = rp[e]; y1[e] = (x1[e] * cssn[0] - x2[e] * cssn[1]) * sc; y2[e] = (x1[e] * cssn[1] + x2[e] * cssn[0]) * sc; }
                    u16* dst = proj + (size_t)(m0 + m) * HY_IN + n0 + c;
                    *(u32x4*)dst = pack8(y1); *(u32x4*)(dst + 64) = pack8(y2);
                }
            } else {
                const int mode = (n0 < 2048) ? 0 : ((n0 < 4096) ? 1 : 2);
#pragma unroll
                for (int ps = 0; ps < 8; ++ps) {
                    const int m = ps * 16 + (tid >> 4), c = (tid & 15) * 8;
                    float v[8]; cs_read8(m, c, v);
                    if (mode == 0) {
#pragma unroll
                        for (int e = 0; e < 8; ++e) v[e] = gelu_f(v[e]);
                        if (n0 >= 1024) {
                            float s = 0.f;
#pragma unroll
                            for (int e = 0; e < 8; ++e) s += v[e] * v[e];
                            s += __shfl_xor(s, 1); s += __shfl_xor(s, 2); s += __shfl_xor(s, 4); s += __shfl_xor(s, 8);
                            if ((tid & 15) == 0) ssq[(size_t)(m0 + m) * 8 + ((n0 - 1024) >> 7)] = s;
                        }
                    } else if (mode == 2) {
#pragma unroll
                        for (int e = 0; e < 8; ++e) v[e] = silu_f(v[e]);
                    }
                    *(u32x4*)(proj + (size_t)(m0 + m) * HY_IN + n0 + c) = pack8(v);
                }
            }
        });
    }
}

__device__ __forceinline__ float ret_log2gamma(int h) { return log2f(1.0f - exp2f(-5.0f - (float)h)); }
constexpr int YS_LD = 264;
__device__ __forceinline__ void zero4(f32x16 (&acc)[4][1]) {
#pragma unroll
    for (int i = 0; i < 4; ++i)
#pragma unroll
        for (int r = 0; r < 16; ++r) acc[i][0][r] = 0.f;
}

__device__ __forceinline__ void gmlp_task(const Params& p, int ci, int g, int dh) {
    unsigned char* ws = p.ws;
    const int tid = opaque((int)threadIdx.x), lane = tid & 63, w = tid >> 6, lr = lane & 31, hi = lane >> 5;
    const int m0 = ci * 128, col0 = g * 256 + dh * 128;
    const u16* proj = (const u16*)(ws + WS_PROJ); const float* ssq = (const float*)(ws + WS_SSQ);
    float* r_s = (float*)(smem + 49152);
    __syncthreads();
    if (tid < 128) { const float s = ssq[(size_t)(m0 + tid) * 8 + 2 * g] + ssq[(size_t)(m0 + tid) * 8 + 2 * g + 1]; r_s[tid] = rsqrtf(s * (1.0f / 256.0f) + EPS); }
    f32x16 acc[4][1]; zero4(acc);
    const float* Wg = p.gm_w_s + (size_t)g * 128 * 128;
    for (int kb = 0; kb < 2; ++kb) {
        __syncthreads();
        load_tr<128, false>(0, proj + (size_t)(m0 + kb * 64) * HY_IN + 1024 + col0, HY_IN, tid, nullptr);
#pragma unroll 2
        for (int i = 0; i < 8; ++i) {
            const int idx = tid + 256 * i, t = idx >> 4, c4 = idx & 15, s0 = kb * 64 + c4 * 4;
            const f32x4 wv = *(const f32x4*)(Wg + t * 128 + s0);
            float o[4];
#pragma unroll
            for (int e = 0; e < 4; ++e) o[e] = (s0 + e <= t) ? wv[e] * r_s[s0 + e] : 0.f;
            u32x2 pk; pk.x = pk2(o[0], o[1]); pk.y = pk2(o[2], o[3]);
            *(u32x2*)(smem + 16384 + toff_e(t, c4 * 4)) = pk;
        }
        __syncthreads();
        mma_kb<4, 1>(acc, 0, 0, 16384, w * 32, lane);
    }
    __syncthreads();
    const int t = w * 32 + lr;
    const float bs = p.gm_b_s[g * 128 + t];
    u16* Ys = (u16*)smem;
#pragma unroll
    for (int i = 0; i < 4; ++i)
#pragma unroll
        for (int q = 0; q < 4; ++q) {
            const int d = i * 32 + 8 * q + 4 * hi;
            const f32x4 gn = *(const f32x4*)(p.gm_v_norm + col0 + d);
            u32x2 pk; pk.x = pk2(acc[i][0][4 * q] * gn[0] + bs, acc[i][0][4 * q + 1] * gn[1] + bs); pk.y = pk2(acc[i][0][4 * q + 2] * gn[2] + bs, acc[i][0][4 * q + 3] * gn[3] + bs);
            *(u32x2*)(Ys + t * YS_LD + d) = pk;
        }
    __syncthreads();
    u16* y = (u16*)(ws + WS_Y);
#pragma unroll
    for (int ps = 0; ps < 8; ++ps) {
        const int tt = ps * 16 + (tid >> 4), c = (tid & 15) * 8;
        float mv[8], uv[8]; unpack8(*(const u32x4*)(Ys + tt * YS_LD + c), mv); unpack8(*(const u32x4*)(proj + (size_t)(m0 + tt) * HY_IN + col0 + c), uv);
#pragma unroll
        for (int e = 0; e < 8; ++e) mv[e] *= uv[e];
        *(u32x4*)(y + (size_t)(m0 + tt) * HY_OUT + col0 + c) = pack8(mv);
    }
}

__device__ __forceinline__ void ret_ds_task(const Params& p, int ci, int h, int eh) {
    unsigned char* ws = p.ws;
    const int tid = opaque((int)threadIdx.x), lane = tid & 63, w = tid >> 6, lr = lane & 31, hi = lane >> 5;
    const int m0 = ci * 128;
    const u16* proj = (const u16*)(ws + WS_PROJ);
    float* kd_s = (float*)(smem + 49152);
    const float l2g = ret_log2gamma(h);
    __syncthreads();
    if (tid < 128) kd_s[tid] = exp2f((float)(127 - tid) * l2g);
    f32x16 acc[4][1]; zero4(acc);
    for (int kb = 0; kb < 2; ++kb) {
        __syncthreads();
        load_tr<128, false>(0, proj + (size_t)(m0 + kb * 64) * HY_IN + 2560 + h * 128, HY_IN, tid, nullptr);
        load_tr<128, true>(16384, proj + (size_t)(m0 + kb * 64) * HY_IN + 3072 + h * 256 + eh * 128, HY_IN, tid, kd_s + kb * 64);
        __syncthreads();
        mma_kb<4, 1>(acc, 0, 0, 16384, w * 32, lane);
    }
    float* dst = (float*)(ws + WS_DST) + (size_t)(ci * 4 + h) * 256 * 128;
#pragma unroll
    for (int i = 0; i < 4; ++i)
#pragma unroll
        for (int q = 0; q < 4; ++q) {
            const int d = i * 32 + 8 * q + 4 * hi, e = eh * 128 + w * 32 + lr;
            f32x4 v = {acc[i][0][4 * q], acc[i][0][4 * q + 1], acc[i][0][4 * q + 2], acc[i][0][4 * q + 3]};
            *(f32x4*)(dst + (size_t)e * 128 + d) = v;
        }
}

__device__ __forceinline__ void phase_mixA(const Params& p, int bid, int nb) {
    for (int t = bid; t < 2048; t += nb) {
        const int ci = t >> 4, sub = t & 15;
        if (sub < 8) gmlp_task(p, ci, sub >> 1, sub & 1); else ret_ds_task(p, ci, (sub - 8) >> 1, sub & 1);
    }
}

__device__ __forceinline__ void phase_scan(const Params& p, int bid, int nb) {
    float* base = (float*)(p.ws + WS_DST);
    for (int i = bid * 256 + threadIdx.x; i < 4 * 4 * 256 * 128 / 4; i += nb * 256) {
        const int b = i >> 15, h = (i >> 13) & 3, rest = i & 8191;
        const float cd = exp2f(128.0f * ret_log2gamma(h));
        f32x4 s = {0.f, 0.f, 0.f, 0.f};
        float* ptr = base + ((size_t)(b * 32) * 4 + h) * 32768 + (size_t)rest * 4;
#pragma unroll 8
        for (int n = 0; n < 32; ++n) {
            f32x4* q = (f32x4*)(ptr + (size_t)n * 4 * 32768);
            const f32x4 tmp = *q; *q = s; s = s * cd + tmp;
        }
    }
}

__device__ __forceinline__ void ret_out_task(const Params& p, int ci, int h) {
    unsigned char* ws = p.ws;
    const int tid = opaque((int)threadIdx.x), lane = tid & 63, w = tid >> 6, lr = lane & 31, hi = lane >> 5;
    const int m0 = ci * 128;
    const u16* proj = (const u16*)(ws + WS_PROJ);
    const float l2g = ret_log2gamma(h);
    const int qi = w * 32 + lr;
    constexpr int RA = 0, RB = 16384, RC = 49152;
    __syncthreads();
    {
        u32x4 r0[4], r1[4];
        const u16* qp = proj + (size_t)m0 * HY_IN + 2048 + h * 128; const u16* kp = proj + (size_t)m0 * HY_IN + 2560 + h * 128;
        gload_nat<128>(r0, qp, HY_IN, tid); gload_nat<128>(r1, qp + 64, HY_IN, tid);
        sstore_nat<128>(RC, r0, tid); sstore_nat<128>(RC + 16384, r1, tid);
        gload_nat<128>(r0, kp, HY_IN, tid); gload_nat<128>(r1, kp + 64, HY_IN, tid);
        sstore_nat<128>(RB, r0, tid); sstore_nat<128>(RB + 16384, r1, tid);
    }
    __syncthreads();
    {
        f32x16 sc[4][1]; zero4(sc);
        mma_kb<4, 1>(sc, RB, 0, RC, w * 32, lane);
        mma_kb<4, 1>(sc, RB + 16384, 0, RC + 16384, w * 32, lane);
        __syncthreads();
#pragma unroll
        for (int i = 0; i < 4; ++i)
#pragma unroll
            for (int q = 0; q < 4; ++q) {
                const int j = i * 32 + 8 * q + 4 * hi;
                float o[4];
#pragma unroll
                for (int e = 0; e < 4; ++e) { const int df = qi - (j + e); o[e] = (df >= 0) ? sc[i][0][4 * q + e] * exp2f((float)df * l2g) : 0.f; }
                u32x2 pk; pk.x = pk2(o[0], o[1]); pk.y = pk2(o[2], o[3]);
                *(u32x2*)(smem + RB + (j >> 6) * 16384 + toff_e(qi, j & 63)) = pk;
            }
#pragma unroll 2
        for (int i = 0; i < 8; ++i) {
            const int idx = tid + 256 * i, row = idx >> 4, c16 = idx & 15;
            unsigned char* ptr = smem + RC + (c16 >> 3) * 16384 + toff(row, c16 & 7);
            float f[8]; unpack8(*(const u32x4*)ptr, f);
            const float qd = exp2f((float)(row + 1) * l2g);
#pragma unroll
            for (int e = 0; e < 8; ++e) f[e] *= qd;
            *(u32x4*)ptr = pack8(f);
        }
    }
    const float* st = (const float*)(ws + WS_DST) + (size_t)(ci * 4 + h) * 256 * 128;
    float ssq = 0.f;
    u16* ytmp = (u16*)(ws + WS_Y) + (size_t)(m0 + qi) * HY_OUT + 1024 + h * 256;
    f32x16 acc[4][1];
#pragma unroll
    for (int eh = 0; eh < 2; ++eh) {
        zero4(acc);
        for (int kb = 0; kb < 4; ++kb) {
            __syncthreads();
            if (kb < 2) {
                load_tr<128, false>(RA, proj + (size_t)(m0 + kb * 64) * HY_IN + 3072 + h * 256 + eh * 128, HY_IN, tid, nullptr);
            } else {
                const int d0 = (kb - 2) * 64, tq = opaque(tid);
#pragma unroll 2
                for (int i = 0; i < 8; ++i) {
                    const int idx = tq + 256 * i, row = idx >> 4, c4 = idx & 15;
                    const f32x4 v = *(const f32x4*)(st + (size_t)(eh * 128 + row) * 128 + d0 + c4 * 4);
                    u32x2 pk; pk.x = pk2(v[0], v[1]); pk.y = pk2(v[2], v[3]);
                    *(u32x2*)(smem + RA + toff_e(row, c4 * 4)) = pk;
                }
            }
            __syncthreads();
            mma_kb<4, 1>(acc, RA, 0, (kb < 2) ? (RB + kb * 16384) : (RC + (kb - 2) * 16384), w * 32, lane);
        }
#pragma unroll
        for (int i = 0; i < 4; ++i)
#pragma unroll
            for (int r = 0; r < 16; ++r) ssq += acc[i][0][r] * acc[i][0][r];
        if (eh == 0) {
#pragma unroll
            for (int i = 0; i < 4; ++i)
#pragma unroll
                for (int q = 0; q < 4; ++q) {
                    u32x2 pk; pk.x = pk2(acc[i][0][4 * q], acc[i][0][4 * q + 1]); pk.y = pk2(acc[i][0][4 * q + 2], acc[i][0][4 * q + 3]);
                    *(u32x2*)(ytmp + i * 32 + 8 * q + 4 * hi) = pk;
                }
        }
    }
    ssq += __shfl_xor(ssq, 32);
    const float rn = rsqrtf(ssq * (1.0f / 256.0f) + EPS);
    __syncthreads();
    u16* Ys = (u16*)smem;
#pragma unroll
    for (int i = 0; i < 4; ++i)
#pragma unroll
        for (int q = 0; q < 4; ++q) {
            const int e = i * 32 + 8 * q + 4 * hi;
            const f32x4 g0 = *(const f32x4*)(p.ret_norm + h * 256 + e), g1 = *(const f32x4*)(p.ret_norm + h * 256 + 128 + e);
            u32x2 pk; const u32x2 z = *(const u32x2*)(ytmp + e);
            pk.x = pk2(bflo(z.x) * rn * g0[0], bfhi(z.x) * rn * g0[1]); pk.y = pk2(bflo(z.y) * rn * g0[2], bfhi(z.y) * rn * g0[3]);
            *(u32x2*)(Ys + qi * YS_LD + e) = pk;
            pk.x = pk2(acc[i][0][4 * q] * rn * g1[0], acc[i][0][4 * q + 1] * rn * g1[1]); pk.y = pk2(acc[i][0][4 * q + 2] * rn * g1[2], acc[i][0][4 * q + 3] * rn * g1[3]);
            *(u32x2*)(Ys + qi * YS_LD + 128 + e) = pk;
        }
    __syncthreads();
    u16* y = (u16*)(ws + WS_Y);
#pragma unroll 4
    for (int ps = 0; ps < 16; ++ps) {
        const int tt = ps * 8 + (tid >> 5), c = (tid & 31) * 8;
        float mv[8], gv[8]; unpack8(*(const u32x4*)(Ys + tt * YS_LD + c), mv); unpack8(*(const u32x4*)(proj + (size_t)(m0 + tt) * HY_IN + 4096 + h * 256 + c), gv);
#pragma unroll
        for (int e = 0; e < 8; ++e) mv[e] *= gv[e];
        *(u32x4*)(y + (size_t)(m0 + tt) * HY_OUT + 1024 + h * 256 + c) = pack8(mv);
    }
}
__device__ __forceinline__ void phase_mixB(const Params& p, int bid, int nb) {
    for (int t = bid; t < 512; t += nb) ret_out_task(p, t >> 2, t & 3);
}

__device__ __forceinline__ void phase_gemm_residual(const Params& p, const u16* A, int lda, const u16* Bt, int K, const float* xsrc, float* xdst, int bid, int nb) {
    const int tid = threadIdx.x;
    constexpr int NT = DM / 128;
    for (int t = bid; t < (T / 128) * NT; t += nb) {
        const int mt = t / NT, nt = t % NT;
        gemm_tile(A, lda, Bt, K, K, mt * 128, nt * 128, [&](int m0, int n0) {
#pragma unroll
            for (int ps = 0; ps < 8; ++ps) {
                const int m = ps * 16 + (tid >> 4), c = (tid & 15) * 8;
                float v[8]; cs_read8(m, c, v);
                const size_t o = (size_t)(m0 + m) * DM + n0 + c;
                const f32x4 a = *(const f32x4*)(xsrc + o), b = *(const f32x4*)(xsrc + o + 4);
                f32x4 ra = {a[0] + v[0], a[1] + v[1], a[2] + v[2], a[3] + v[3]}, rb = {b[0] + v[4], b[1] + v[5], b[2] + v[6], b[3] + v[7]};
                *(f32x4*)(xdst + o) = ra; *(f32x4*)(xdst + o + 4) = rb;
            }
        });
    }
}
template <int K, int N>
__device__ __forceinline__ void phase_gemm_f32(const u16* A, const u16* Bt, float* C, int bid, int nb) {
    const int tid = threadIdx.x;
    constexpr int NT = N / 128, lda = K, ldc = N;
    for (int t = bid; t < (T / 128) * NT; t += nb) {
        const int mt = t / NT, nt = t % NT;
        gemm_tile(A, lda, Bt, K, K, mt * 128, nt * 128, [&](int m0, int n0) {
#pragma unroll
            for (int ps = 0; ps < 8; ++ps) {
                const int m = ps * 16 + (tid >> 4), c = (tid & 15) * 8;
                float v[8]; cs_read8(m, c, v);
                const size_t o = (size_t)(m0 + m) * ldc + n0 + c;
                f32x4 ra = {v[0], v[1], v[2], v[3]}, rb = {v[4], v[5], v[6], v[7]};
                *(f32x4*)(C + o) = ra; *(f32x4*)(C + o + 4) = rb;
            }
        });
    }
}

__device__ __forceinline__ void ins16(float (&L)[16], float e) {
#pragma unroll
    for (int i = 0; i < 16; ++i) { const float hi = fmaxf(L[i], e); e = fminf(L[i], e); L[i] = hi; }
}
__device__ __forceinline__ void phase_topk(const Params& p, int bid, int nb) {
    const int tid = threadIdx.x;
    const float* scores = (const float*)(p.ws + WS_SCORES);
    u16* experts = (u16*)(p.ws + WS_EXP); float* gates = (float*)(p.ws + WS_GATE);
    unsigned* la = (unsigned*)smem;
    for (int base = bid * 256; base < T * 8; base += nb * 256) {
        const int th = base + tid;
        const float* sp = scores + (size_t)th * 256;
        float a[16], b[16];
#pragma unroll
        for (int i = 0; i < 16; ++i) { a[i] = -INFINITY; b[i] = -INFINITY; }
        for (int k4 = 0; k4 < 32; ++k4) {
            const f32x4 v = *(const f32x4*)(sp + k4 * 4); const f32x4 u = *(const f32x4*)(sp + 128 + k4 * 4);
#pragma unroll
            for (int e = 0; e < 4; ++e) {
                ins16(a, __uint_as_float((__float_as_uint(v[e]) & ~127u) | (unsigned)(k4 * 4 + e)));
                ins16(b, __uint_as_float((__float_as_uint(u[e]) & ~127u) | (unsigned)(k4 * 4 + e)));
            }
        }
        __syncthreads();
#pragma unroll
        for (int i = 0; i < 16; ++i) { la[i * 256 + tid] = __float_as_uint(a[i]); la[(16 + i) * 256 + tid] = __float_as_uint(b[i]); }
        float c[16];
#pragma unroll
        for (int i = 0; i < 16; ++i) c[i] = -INFINITY;
#pragma unroll
        for (int i = 0; i < 16; ++i)
#pragma unroll
            for (int j = 0; j < 16; ++j)
                if ((i + 1) * (j + 1) <= 16) {
                    const float s = __uint_as_float(__float_as_uint(a[i]) & ~127u) + __uint_as_float(__float_as_uint(b[j]) & ~127u);
                    ins16(c, __uint_as_float((__float_as_uint(s) & ~255u) | (unsigned)(i * 16 + j)));
                }
        float bs[16]; unsigned ex[16]; float mx = -INFINITY;
#pragma unroll
        for (int k = 0; k < 16; ++k) {
            const unsigned code = __float_as_uint(c[k]) & 255u;
            const unsigned av = la[(code >> 4) * 256 + tid], bv = la[(16 + (code & 15)) * 256 + tid];
            bs[k] = __uint_as_float(av & ~127u) + __uint_as_float(bv & ~127u);
            ex[k] = (av & 127u) * 128u + (bv & 127u);
            mx = fmaxf(mx, bs[k]);
        }
        float sum = 0.f;
#pragma unroll
        for (int k = 0; k < 16; ++k) { bs[k] = __expf(bs[k] - mx); sum += bs[k]; }
        const float inv = 1.0f / sum;
        u32x4 e0, e1;
        e0.x = ex[0] | (ex[1] << 16); e0.y = ex[2] | (ex[3] << 16); e0.z = ex[4] | (ex[5] << 16); e0.w = ex[6] | (ex[7] << 16);
        e1.x = ex[8] | (ex[9] << 16); e1.y = ex[10] | (ex[11] << 16); e1.z = ex[12] | (ex[13] << 16); e1.w = ex[14] | (ex[15] << 16);
        *(u32x4*)(experts + (size_t)th * 16) = e0; *(u32x4*)(experts + (size_t)th * 16 + 8) = e1;
#pragma unroll
        for (int k4 = 0; k4 < 4; ++k4) { f32x4 g = {bs[4 * k4] * inv, bs[4 * k4 + 1] * inv, bs[4 * k4 + 2] * inv, bs[4 * k4 + 3] * inv}; *(f32x4*)(gates + (size_t)th * 16 + k4 * 4) = g; }
        __syncthreads();
    }
}

template <int MODE>
__device__ __forceinline__ void phase_peer(const Params& p, int L, const float* gnext, int bid, int nb) {
    const int tid = threadIdx.x, lane = tid & 63, w = tid >> 6;
    const u16* H = (const u16*)(p.ws + WS_H);
    const u16* U = (const u16*)(p.ws + WS_UBF) + (size_t)L * NEXP * DM; const u16* V = (const u16*)(p.ws + WS_VBF) + (size_t)L * NEXP * DM;
    const u16* experts = (const u16*)(p.ws + WS_EXP); const float* gates = (const float*)(p.ws + WS_GATE);
    for (int t = bid * 4 + w; t < T; t += nb * 4) {
        float xh[16];
        { const u16* hp = H + (size_t)t * DM + lane * 8; unpack8(*(const u32x4*)hp, xh); unpack8(*(const u32x4*)(hp + 512), xh + 8); }
        const unsigned e_lo = experts[(size_t)t * 128 + lane], e_hi = experts[(size_t)t * 128 + 64 + lane];
        const float g_lo = gates[(size_t)t * 128 + lane], g_hi = gates[(size_t)t * 128 + 64 + lane];
        float w_lo = 0.f, w_hi = 0.f;
#pragma unroll 1
        for (int eb = 0; eb < 128; eb += 8) {
            u32x4 r[8][2];
#pragma unroll
            for (int k = 0; k < 8; ++k) {
                const int e = eb + k;
                const unsigned ex = __builtin_amdgcn_readlane((e < 64) ? e_lo : e_hi, e & 63);
                const u16* up = U + (size_t)ex * DM + lane * 8;
                r[k][0] = *(const u32x4*)up; r[k][1] = *(const u32x4*)(up + 512);
            }
#pragma unroll
            for (int k = 0; k < 8; ++k) {
                float f[16]; unpack8(r[k][0], f); unpack8(r[k][1], f + 8);
                float d = 0.f;
#pragma unroll
                for (int i = 0; i < 16; ++i) d += f[i] * xh[i];
                d = wave_sum(d);
                const int e = eb + k;
                const float a = gelu_f(d);
                if (e < 64) { if (lane == e) w_lo = a * g_lo; } else { if (lane == e - 64) w_hi = a * g_hi; }
            }
        }
        float o[16];
#pragma unroll
        for (int i = 0; i < 16; ++i) o[i] = 0.f;
#pragma unroll 1
        for (int eb = 0; eb < 128; eb += 8) {
            u32x4 r[8][2]; float wv[8];
#pragma unroll
            for (int k = 0; k < 8; ++k) {
                const int e = eb + k;
                const unsigned ex = __builtin_amdgcn_readlane((e < 64) ? e_lo : e_hi, e & 63);
                wv[k] = __uint_as_float(__builtin_amdgcn_readlane(__float_as_uint((e < 64) ? w_lo : w_hi), e & 63));
                const u16* vp = V + (size_t)ex * DM + lane * 8;
                r[k][0] = *(const u32x4*)vp; r[k][1] = *(const u32x4*)(vp + 512);
            }
#pragma unroll
            for (int k = 0; k < 8; ++k) {
                float f[16]; unpack8(r[k][0], f); unpack8(r[k][1], f + 8);
#pragma unroll
                for (int i = 0; i < 16; ++i) o[i] += wv[k] * f[i];
            }
        }
        float* xr = p.out + (size_t)t * DM + lane * 8;
        float xv[16];
        { const f32x4 a = *(const f32x4*)xr, b = *(const f32x4*)(xr + 4), c = *(const f32x4*)(xr + 512), d = *(const f32x4*)(xr + 516);
          xv[0] = a[0]; xv[1] = a[1]; xv[2] = a[2]; xv[3] = a[3]; xv[4] = b[0]; xv[5] = b[1]; xv[6] = b[2]; xv[7] = b[3];
          xv[8] = c[0]; xv[9] = c[1]; xv[10] = c[2]; xv[11] = c[3]; xv[12] = d[0]; xv[13] = d[1]; xv[14] = d[2]; xv[15] = d[3]; }
        float ss = 0.f;
#pragma unroll
        for (int i = 0; i < 16; ++i) { xv[i] += o[i]; ss += xv[i] * xv[i]; }
        ss = wave_sum(ss);
        const float rn = rsqrtf(ss * (1.0f / DM) + EPS);
        float gv[16];
        { const float* gp = gnext + lane * 8; const f32x4 a = *(const f32x4*)gp, b = *(const f32x4*)(gp + 4), c = *(const f32x4*)(gp + 512), d = *(const f32x4*)(gp + 516);
          gv[0] = a[0]; gv[1] = a[1]; gv[2] = a[2]; gv[3] = a[3]; gv[4] = b[0]; gv[5] = b[1]; gv[6] = b[2]; gv[7] = b[3];
          gv[8] = c[0]; gv[9] = c[1]; gv[10] = c[2]; gv[11] = c[3]; gv[12] = d[0]; gv[13] = d[1]; gv[14] = d[2]; gv[15] = d[3]; }
        if (MODE == 0) {
            *(f32x4*)xr = (f32x4){xv[0], xv[1], xv[2], xv[3]}; *(f32x4*)(xr + 4) = (f32x4){xv[4], xv[5], xv[6], xv[7]};
            *(f32x4*)(xr + 512) = (f32x4){xv[8], xv[9], xv[10], xv[11]}; *(f32x4*)(xr + 516) = (f32x4){xv[12], xv[13], xv[14], xv[15]};
            float hv[16];
#pragma unroll
            for (int i = 0; i < 16; ++i) hv[i] = xv[i] * rn * gv[i];
            u16* hp = (u16*)(p.ws + WS_H) + (size_t)t * DM + lane * 8;
            *(u32x4*)hp = pack8(hv); *(u32x4*)(hp + 512) = pack8(hv + 8);
        } else {
#pragma unroll
            for (int i = 0; i < 16; ++i) xv[i] = xv[i] * rn * gv[i];
            *(f32x4*)xr = (f32x4){xv[0], xv[1], xv[2], xv[3]}; *(f32x4*)(xr + 4) = (f32x4){xv[4], xv[5], xv[6], xv[7]};
            *(f32x4*)(xr + 512) = (f32x4){xv[8], xv[9], xv[10], xv[11]}; *(f32x4*)(xr + 516) = (f32x4){xv[12], xv[13], xv[14], xv[15]};
        }
    }
}

__device__ __forceinline__ void phase_mla_norm(const Params& p, int bid, int nb) {
    const int tid = threadIdx.x, lane = tid & 63, w = tid >> 6;
    const float* down = (const float*)(p.ws + WS_DOWN);
    u16* cqn = (u16*)(p.ws + WS_CQN); u16* ckvn = (u16*)(p.ws + WS_CKVN); u16* kr = (u16*)(p.ws + WS_KROPE);
    const f32x2* rope = (const f32x2*)(p.ws + WS_ROPE_M);
    for (int t = bid * 4 + w; t < T; t += nb * 4) {
        const float* dr = down + (size_t)t * MLA_DOWN_PAD;
        float q[6], kv[4];
#pragma unroll
        for (int i = 0; i < 6; ++i) q[i] = dr[i * 64 + lane];
#pragma unroll
        for (int i = 0; i < 4; ++i) kv[i] = dr[384 + i * 64 + lane];
        const float rp = dr[640 + lane];
        float sq = 0.f, sk = 0.f;
#pragma unroll
        for (int i = 0; i < 6; ++i) sq += q[i] * q[i];
#pragma unroll
        for (int i = 0; i < 4; ++i) sk += kv[i] * kv[i];
        sq = wave_sum(sq); sk = wave_sum(sk);
        const float rq = rsqrtf(sq * (1.0f / MLA_QR) + EPS), rk = rsqrtf(sk * (1.0f / MLA_KVR) + EPS);
#pragma unroll
        for (int i = 0; i < 6; ++i) cqn[(size_t)t * MLA_QR + i * 64 + lane] = f2bf(q[i] * rq * p.mla_q_norm[i * 64 + lane]);
#pragma unroll
        for (int i = 0; i < 4; ++i) ckvn[(size_t)t * MLA_KVR + i * 64 + lane] = f2bf(kv[i] * rk * p.mla_kv_norm[i * 64 + lane]);
        const float other = __shfl_xor(rp, 32);
        const f32x2 cssn = rope[(size_t)(t & (SEQ - 1)) * 32 + (lane & 31)];
        const float res = (lane < 32) ? (rp * cssn[0] - other * cssn[1]) : (other * cssn[1] + rp * cssn[0]);
        kr[(size_t)t * 64 + lane] = f2bf(res);
    }
}

__device__ __forceinline__ void phase_mla_up(const Params& p, int bid, int nb) {
    const int tid = threadIdx.x;
    unsigned char* ws = p.ws;
    const f32x2* rope = (const f32x2*)(ws + WS_ROPE_M);
    u16* qo = (u16*)(ws + WS_Q); u16* kvo = (u16*)(ws + WS_KV);
    constexpr int NTQ = 1536 / 128, NTKV = 2048 / 128, NTT = NTQ + NTKV;
    for (int t = bid; t < (T / 128) * NTT; t += nb) {
        const int mt = t / NTT, nt = t % NTT;
        if (nt < NTQ) {
            gemm_tile((const u16*)(ws + WS_CQN), MLA_QR, (const u16*)(ws + WS_WQUPT), MLA_QR, MLA_QR, mt * 128, nt * 128, [&](int m0, int n0) {
#pragma unroll
                for (int ps = 0; ps < 8; ++ps) {
                    const int m = ps * 16 + (tid >> 4), c = (tid & 15) * 8;
                    const int within = (n0 + c) % 192;
                    u16* dst = qo + (size_t)(m0 + m) * 1536 + n0 + c;
                    if (within < 128) { float v[8]; cs_read8(m, c, v); *(u32x4*)dst = pack8(v); }
                    else if (within < 160) {
                        float x1[8], x2[8], y1[8], y2[8]; cs_read8(m, c, x1); cs_read8(m, c + 32, x2);
                        const f32x2* rp = rope + (size_t)((m0 + m) & (SEQ - 1)) * 32 + (within - 128);
#pragma unroll
                        for (int e = 0; e < 8; ++e) { const f32x2 cssn = rp[e]; y1[e] = x1[e] * cssn[0] - x2[e] * cssn[1]; y2[e] = x1[e] * cssn[1] + x2[e] * cssn[0]; }
                        *(u32x4*)dst = pack8(y1); *(u32x4*)(dst + 32) = pack8(y2);
                    }
                }
            });
        } else {
            gemm_tile((const u16*)(ws + WS_CKVN), MLA_KVR, (const u16*)(ws + WS_WKVUPT), MLA_KVR, MLA_KVR, mt * 128, (nt - NTQ) * 128, [&](int m0, int n0) {
#pragma unroll
                for (int ps = 0; ps < 8; ++ps) {
                    const int m = ps * 16 + (tid >> 4), c = (tid & 15) * 8;
                    float v[8]; cs_read8(m, c, v);
                    *(u32x4*)(kvo + (size_t)(m0 + m) * 2048 + n0 + c) = pack8(v);
                }
            });
        }
    }
}

__device__ __forceinline__ int crow(int r, int hi) { return (r & 3) + 8 * (r >> 2) + 4 * hi; }
__device__ __forceinline__ void attn_task(const Params& p, int b, int h, int qb) {
    unsigned char* ws = p.ws;
    const int tid = opaque((int)threadIdx.x), lane = tid & 63, w = tid >> 6, lr = lane & 31, hi = lane >> 5;
    const u16* Q = (const u16*)(ws + WS_Q); const u16* KV = (const u16*)(ws + WS_KV); const u16* KR = (const u16*)(ws + WS_KROPE);
    const int t0 = b * SEQ, q0 = qb * 128, qrow = q0 + w * 32 + lr;
    bf16x8 qf[12];
#pragma unroll
    for (int s = 0; s < 12; ++s) qf[s] = *(const bf16x8*)(Q + (size_t)(t0 + qrow) * 1536 + h * 192 + s * 16 + hi * 8);
    f32x16 o[4];
#pragma unroll
    for (int i = 0; i < 4; ++i)
#pragma unroll
        for (int r = 0; r < 16; ++r) o[i][r] = 0.f;
    float m = -1e30f, l = 0.f;
    const float c2 = 0.07216878364870322f * 1.4426950408889634f;
    const int ntiles = (q0 + 128) >> 6;
    constexpr int VT = 24576;
    for (int jt = 0; jt < ntiles; ++jt) {
        const int j0 = jt * 64;
        __syncthreads();
#pragma unroll
        for (int i = 0; i < 4; ++i) {
            const int idx = tid + 256 * i, key = idx >> 4, c16 = idx & 15;
            const u32x4 v = *(const u32x4*)(KV + (size_t)(t0 + j0 + key) * 2048 + h * 256 + c16 * 8);
            *(u32x4*)(smem + (c16 >> 3) * 8192 + toff(key, c16 & 7)) = v;
        }
#pragma unroll
        for (int i = 0; i < 2; ++i) {
            const int idx = tid + 256 * i, key = idx >> 3, c8 = idx & 7;
            const u32x4 v = *(const u32x4*)(KR + (size_t)(t0 + j0 + key) * 64 + c8 * 8);
            *(u32x4*)(smem + 16384 + toff(key, c8)) = v;
        }
#pragma unroll
        for (int i = 0; i < 4; ++i) {
            const int idx = tid + 256 * i, key = idx >> 4, c16 = idx & 15;
            const u32x4 v = *(const u32x4*)(KV + (size_t)(t0 + j0 + key) * 2048 + h * 256 + 128 + c16 * 8);
            const unsigned wd[4] = {v.x, v.y, v.z, v.w};
            const int pos = (key & ~12) | ((key & 4) << 1) | ((key & 8) >> 1);
#pragma unroll
            for (int e = 0; e < 8; ++e) *(u16*)(smem + VT + toff_e(c16 * 8 + e, pos)) = (u16)((e & 1) ? (wd[e >> 1] >> 16) : (wd[e >> 1] & 0xffffu));
        }
        __syncthreads();
        f32x16 s0, s1;
#pragma unroll
        for (int r = 0; r < 16; ++r) { s0[r] = 0.f; s1[r] = 0.f; }
#pragma unroll
        for (int s = 0; s < 12; ++s) {
            const int kbk = s >> 2, c8 = 2 * (s & 3) + hi;
            const bf16x8 a0 = *(const bf16x8*)(smem + kbk * 8192 + toff(lr, c8)), a1 = *(const bf16x8*)(smem + kbk * 8192 + toff(32 + lr, c8));
            s0 = __builtin_amdgcn_mfma_f32_32x32x16_bf16(a0, qf[s], s0, 0, 0, 0);
            s1 = __builtin_amdgcn_mfma_f32_32x32x16_bf16(a1, qf[s], s1, 0, 0, 0);
        }
        if (j0 + 63 > q0 + w * 32) {
#pragma unroll
            for (int r = 0; r < 16; ++r) {
                if (j0 + crow(r, hi) > qrow) s0[r] = -INFINITY;
                if (j0 + 32 + crow(r, hi) > qrow) s1[r] = -INFINITY;
            }
        }
        float mx = s0[0];
#pragma unroll
        for (int r = 1; r < 16; ++r) mx = fmaxf(mx, s0[r]);
#pragma unroll
        for (int r = 0; r < 16; ++r) mx = fmaxf(mx, s1[r]);
        mx = fmaxf(mx, __shfl_xor(mx, 32));
        const float mn = fmaxf(m, mx), alpha = exp2f((m - mn) * c2);
        m = mn;
        float rs = 0.f;
#pragma unroll
        for (int r = 0; r < 16; ++r) { s0[r] = exp2f((s0[r] - mn) * c2); s1[r] = exp2f((s1[r] - mn) * c2); rs += s0[r] + s1[r]; }
        l = l * alpha + rs;
#pragma unroll
        for (int i = 0; i < 4; ++i)
#pragma unroll
            for (int r = 0; r < 16; ++r) o[i][r] *= alpha;
        bf16x8 pf[4];
#pragma unroll
        for (int ks = 0; ks < 4; ++ks) {
            u32x4 wv;
            if (ks < 2) { const int bs = 8 * (ks & 1); wv.x = pk2(s0[bs], s0[bs + 1]); wv.y = pk2(s0[bs + 2], s0[bs + 3]); wv.z = pk2(s0[bs + 4], s0[bs + 5]); wv.w = pk2(s0[bs + 6], s0[bs + 7]); }
            else { const int bs = 8 * (ks & 1); wv.x = pk2(s1[bs], s1[bs + 1]); wv.y = pk2(s1[bs + 2], s1[bs + 3]); wv.z = pk2(s1[bs + 4], s1[bs + 5]); wv.w = pk2(s1[bs + 6], s1[bs + 7]); }
            pf[ks] = __builtin_bit_cast(bf16x8, wv);
        }
#pragma unroll
        for (int ks = 0; ks < 4; ++ks) {
            const int c8 = 2 * ks + hi;
#pragma unroll
            for (int dvb = 0; dvb < 4; ++dvb) {
                const bf16x8 a = *(const bf16x8*)(smem + VT + toff(dvb * 32 + lr, c8));
                o[dvb] = __builtin_amdgcn_mfma_f32_32x32x16_bf16(a, pf[ks], o[dvb], 0, 0, 0);
            }
        }
    }
    l += __shfl_xor(l, 32);
    const float inv = 1.0f / l;
    __syncthreads();
    u16* Os = (u16*)smem;
#pragma unroll
    for (int dvb = 0; dvb < 4; ++dvb)
#pragma unroll
        for (int q = 0; q < 4; ++q) {
            const int dv = dvb * 32 + 8 * q + 4 * hi;
            u32x2 pk; pk.x = pk2(o[dvb][4 * q] * inv, o[dvb][4 * q + 1] * inv); pk.y = pk2(o[dvb][4 * q + 2] * inv, o[dvb][4 * q + 3] * inv);
            *(u32x2*)(Os + (w * 32 + lr) * 136 + dv) = pk;
        }
    __syncthreads();
    u16* O = (u16*)(ws + WS_O);
#pragma unroll
    for (int ps = 0; ps < 8; ++ps) {
        const int qq = ps * 16 + (tid >> 4), c = (tid & 15) * 8;
        *(u32x4*)(O + (size_t)(t0 + q0 + qq) * DM + h * 128 + c) = *(const u32x4*)(Os + qq * 136 + c);
    }
}
__device__ __forceinline__ void phase_attn(const Params& p, int bid, int nb) {
    for (int r = 0;; ++r) {
        const int idx = (r & 1) ? ((r + 1) * nb - 1 - bid) : (r * nb + bid);
        if (r * nb >= 1024) break;
        if (idx < 1024) { const int qb = 31 - (idx >> 5), bh = idx & 31; attn_task(p, bh >> 3, bh & 7, qb); }
    }
}

constexpr int NPHASES = 19;
template <int PH>
__device__ __forceinline__ void run_phase(const Params& p, int bid, int nb) {
    unsigned char* ws = p.ws;
    const int tid = threadIdx.x;
    if constexpr (PH == 0) phase_prep(p, bid, nb);
    else if constexpr (PH == 1) phase_inproj(p, bid, nb);
    else if constexpr (PH == 2) phase_mixA(p, bid, nb);
    else if constexpr (PH == 3) phase_scan(p, bid, nb);
    else if constexpr (PH == 4) phase_mixB(p, bid, nb);
    else if constexpr (PH == 5) phase_gemm_residual(p, (const u16*)(ws + WS_Y), HY_OUT, (const u16*)(ws + WS_WOUTT), HY_OUT, p.x, p.out, bid, nb);
    else if constexpr (PH == 6) rmsnorm_rows(p.out, p.norm_ffn, (u16*)(ws + WS_H), bid, nb, tid);
    else if constexpr (PH == 7) phase_gemm_f32<DM, 2048>((const u16*)(ws + WS_H), (const u16*)(ws + WS_WPQT), (float*)(ws + WS_SCORES), bid, nb);
    else if constexpr (PH == 8) phase_topk(p, bid, nb);
    else if constexpr (PH == 9) phase_peer<0>(p, 0, p.norm_mix + DM, bid, nb);
    else if constexpr (PH == 10) phase_gemm_f32<DM, MLA_DOWN_PAD>((const u16*)(ws + WS_H), (const u16*)(ws + WS_WDOWNT), (float*)(ws + WS_DOWN), bid, nb);
    else if constexpr (PH == 11) phase_mla_norm(p, bid, nb);
    else if constexpr (PH == 12) phase_mla_up(p, bid, nb);
    else if constexpr (PH == 13) phase_attn(p, bid, nb);
    else if constexpr (PH == 14) phase_gemm_residual(p, (const u16*)(ws + WS_O), DM, (const u16*)(ws + WS_WMOT), DM, p.out, p.out, bid, nb);
    else if constexpr (PH == 15) rmsnorm_rows(p.out, p.norm_ffn + DM, (u16*)(ws + WS_H), bid, nb, tid);
    else if constexpr (PH == 16) phase_gemm_f32<DM, 2048>((const u16*)(ws + WS_H), (const u16*)(ws + WS_WPQT) + (size_t)2048 * DM, (float*)(ws + WS_SCORES), bid, nb);
    else if constexpr (PH == 17) phase_topk(p, bid, nb);
    else if constexpr (PH == 18) phase_peer<1>(p, 1, p.final_norm, bid, nb);
}
template <int PH>
__global__ void __launch_bounds__(NTHREADS, 2) k_phase(Params p) { run_phase<PH>(p, blockIdx.x, gridDim.x); }

template <int PH>
static void launch_phase(const Params& p, int grid, hipStream_t stream) {
    static bool attr = false;
    if (!attr) { (void)hipFuncSetAttribute((const void*)k_phase<PH>, hipFuncAttributeMaxDynamicSharedMemorySize, LDS_BYTES); attr = true; }
    hipLaunchKernelGGL(k_phase<PH>, dim3(grid), dim3(NTHREADS), LDS_BYTES, stream, p);
}
template <int PH>
static void launch_all(const Params& p, int grid, hipStream_t stream) {
    launch_phase<PH>(p, grid, stream);
    if constexpr (PH + 1 < NPHASES) launch_all<PH + 1>(p, grid, stream);
}

extern "C" void kernel_launch(void* const* d_in, const int* in_sizes, int n_in, void* d_out, int out_size, void* d_ws, size_t ws_size, hipStream_t stream) {
    if (n_in != 20 || out_size != T * DM || ws_size < WS_END) { fprintf(stderr, "kernel_launch: unexpected shapes (n_in %d out %d ws %zu need %zu)\n", n_in, out_size, ws_size, (size_t)WS_END); return; }
    Params p{};
    const float** f = (const float**)&p;
    for (int i = 0; i < 20; ++i) f[i] = (const float*)d_in[i];
    p.out = (float*)d_out; p.ws = (unsigned char*)d_ws;
    launch_all<0>(p, 512, stream);
}
```

```cpp
#include <hip/hip_runtime.h>
#include <hip/hip_cooperative_groups.h>
#include <cstdint>
#include <cstdio>
namespace cg = cooperative_groups;

typedef unsigned short u16;
typedef short bf16x8 __attribute__((ext_vector_type(8)));
typedef float f32x16 __attribute__((ext_vector_type(16)));
typedef float f32x4 __attribute__((ext_vector_type(4)));
typedef float f32x2 __attribute__((ext_vector_type(2)));
typedef unsigned u32x4 __attribute__((ext_vector_type(4)));
typedef unsigned u32x2 __attribute__((ext_vector_type(2)));
typedef __bf16 bf16v2 __attribute__((ext_vector_type(2)));

constexpr int T = 16384, DM = 1024, SEQ = 4096;
constexpr int HY_IN = 5120, HY_OUT = 2048;
constexpr int MLA_DOWN = 704, MLA_DOWN_PAD = 768, MLA_QR = 384, MLA_KVR = 256;
constexpr int NEXP = 16384;
constexpr float EPS = 1e-6f;
constexpr int NTHREADS = 256;
constexpr int LDS_BYTES = 81920;

constexpr size_t al256(size_t x) { return (x + 255) & ~(size_t)255; }
constexpr size_t WS_WINT   = 0;
constexpr size_t WS_WOUTT  = WS_WINT   + (size_t)HY_IN * DM * 2;
constexpr size_t WS_WDOWNT = WS_WOUTT  + (size_t)DM * HY_OUT * 2;
constexpr size_t WS_WQUPT  = WS_WDOWNT + (size_t)MLA_DOWN_PAD * DM * 2;
constexpr size_t WS_WKVUPT = WS_WQUPT  + (size_t)1536 * MLA_QR * 2;
constexpr size_t WS_WMOT   = WS_WKVUPT + (size_t)2048 * MLA_KVR * 2;
constexpr size_t WS_WPQT   = WS_WMOT   + (size_t)DM * DM * 2;
constexpr size_t WS_ROPE_R = WS_WPQT   + (size_t)2 * 2048 * DM * 2;
constexpr size_t WS_ROPE_M = WS_ROPE_R + (size_t)SEQ * 64 * 8;
constexpr size_t WS_UBF    = WS_ROPE_M + (size_t)SEQ * 32 * 8;
constexpr size_t WS_VBF    = WS_UBF    + (size_t)2 * NEXP * DM * 2;
constexpr size_t WS_H      = WS_VBF    + (size_t)2 * NEXP * DM * 2;
constexpr size_t WS_PROJ   = WS_H      + (size_t)T * DM * 2;
constexpr size_t WS_Y      = WS_PROJ   + (size_t)T * HY_IN * 2;
constexpr size_t WS_SSQ    = WS_Y      + (size_t)T * HY_OUT * 2;
constexpr size_t WS_DST    = WS_SSQ    + (size_t)T * 8 * 4;
constexpr size_t WS_EXP    = WS_DST    + (size_t)512 * 256 * 128 * 4;
constexpr size_t WS_GATE   = WS_EXP    + (size_t)T * 128 * 2;
constexpr size_t WS_END    = WS_GATE   + (size_t)T * 128 * 4;
constexpr size_t WS_Q      = WS_PROJ;
constexpr size_t WS_KV     = WS_Q  + (size_t)T * 1536 * 2;
constexpr size_t WS_DOWN   = WS_KV + (size_t)T * 2048 * 2;
constexpr size_t WS_SCORES = WS_PROJ;
constexpr size_t WS_O      = WS_Y;
constexpr size_t WS_CQN    = WS_O    + (size_t)T * DM * 2;
constexpr size_t WS_CKVN   = WS_CQN  + (size_t)T * MLA_QR * 2;
constexpr size_t WS_KROPE  = WS_CKVN + (size_t)T * MLA_KVR * 2;
static_assert(WS_DOWN + (size_t)T * 768 * 4 <= WS_Y, "overlay");
static_assert(WS_KROPE + (size_t)T * 64 * 2 <= WS_SSQ, "overlay");

struct Params {
    const float *x, *norm_mix, *norm_ffn, *hy_w_in, *gm_v_norm, *gm_w_s, *gm_b_s, *ret_norm, *hy_w_out;
    const float *mla_w_down, *mla_q_norm, *mla_w_q_up, *mla_kv_norm, *mla_w_kv_up, *mla_w_out;
    const float *peer_w_q, *peer_sub_keys, *peer_u, *peer_v, *final_norm;
    float* out;
    unsigned char* ws;
};

extern __shared__ __attribute__((aligned(16))) unsigned char smem[];

__device__ __forceinline__ unsigned pk2(float lo, float hi) { unsigned r; asm volatile("v_cvt_pk_bf16_f32 %0, %1, %2" : "=v"(r) : "v"(lo), "v"(hi)); return r; }
__device__ __forceinline__ u16 f2bf(float f) { return (u16)(pk2(f, 0.f) & 0xffffu); }
__device__ __forceinline__ float bflo(unsigned u) { return __uint_as_float(u << 16); }
__device__ __forceinline__ float bfhi(unsigned u) { return __uint_as_float(u & 0xffff0000u); }
__device__ __forceinline__ float bf2f(u16 h) { return __uint_as_float((unsigned)h << 16); }
__device__ __forceinline__ u32x4 pack8(const float* v) { u32x4 w; w.x = pk2(v[0], v[1]); w.y = pk2(v[2], v[3]); w.z = pk2(v[4], v[5]); w.w = pk2(v[6], v[7]); return w; }
__device__ __forceinline__ void unpack8(u32x4 w, float* v) { v[0] = bflo(w.x); v[1] = bfhi(w.x); v[2] = bflo(w.y); v[3] = bfhi(w.y); v[4] = bflo(w.z); v[5] = bfhi(w.z); v[6] = bflo(w.w); v[7] = bfhi(w.w); }
__device__ __forceinline__ float gelu_f(float v) { return 0.5f * v * (1.0f + erff(v * 0.70710678118654752f)); }
__device__ __forceinline__ float silu_f(float v) { return v / (1.0f + __expf(-v)); }
__device__ __forceinline__ float wave_sum(float v) {
#pragma unroll
    for (int o = 32; o >= 1; o >>= 1) v += __shfl_xor(v, o);
    return v;
}

__device__ __forceinline__ int opaque(int v) { asm volatile("" : "+v"(v)); return v; }

__device__ __forceinline__ int toff(int r, int c8) { return r * 128 + ((c8 ^ ((r >> 1) & 7)) << 4); }
__device__ __forceinline__ int toff_e(int r, int k) { return toff(r, k >> 3) + (k & 7) * 2; }

template <int PT, int QT>
__device__ __forceinline__ void mma_kb(f32x16 (&acc)[PT][QT], int Ps, int prow0, int Qs, int qrow0, int lane) {
    const int lr = lane & 31, hi = lane >> 5;
#pragma unroll
    for (int s = 0; s < 4; ++s) {
        const int c8 = 2 * s + hi;
        bf16x8 a[PT], b[QT];
#pragma unroll
        for (int i = 0; i < PT; ++i) a[i] = *(const bf16x8*)(smem + Ps + toff(prow0 + i * 32 + lr, c8));
#pragma unroll
        for (int j = 0; j < QT; ++j) b[j] = *(const bf16x8*)(smem + Qs + toff(qrow0 + j * 32 + lr, c8));
#pragma unroll
        for (int i = 0; i < PT; ++i)
#pragma unroll
            for (int j = 0; j < QT; ++j) acc[i][j] = __builtin_amdgcn_mfma_f32_32x32x16_bf16(a[i], b[j], acc[i][j], 0, 0, 0);
    }
#pragma unroll
    for (int i = 0; i < PT; ++i)
#pragma unroll
        for (int j = 0; j < QT; ++j) asm volatile("" : "+v"(acc[i][j]));
}

template <int ROWS>
__device__ __forceinline__ void gload_nat(u32x4 (&r)[ROWS / 32], const u16* src, int ld, int tid) {
    tid = opaque(tid);
#pragma unroll
    for (int i = 0; i < ROWS / 32; ++i) { const int idx = tid + 256 * i, row = idx >> 3, c8 = idx & 7; r[i] = *(const u32x4*)(src + (size_t)row * ld + c8 * 8); }
}
template <int ROWS>
__device__ __forceinline__ void sstore_nat(int lds, const u32x4 (&r)[ROWS / 32], int tid) {
    tid = opaque(tid);
#pragma unroll
    for (int i = 0; i < ROWS / 32; ++i) { const int idx = tid + 256 * i, row = idx >> 3, c8 = idx & 7; *(u32x4*)(smem + lds + toff(row, c8)) = r[i]; }
}
template <int ROWS, bool SCALE>
__device__ __forceinline__ void load_tr(int lds, const u16* src, int ld, int tid, const float* kscale) {
    constexpr int CH = ROWS / 8;
    tid = opaque(tid);
#pragma unroll 2
    for (int i = 0; i < (64 * CH) / 256; ++i) {
        const int idx = tid + 256 * i, k = idx / CH, nc = idx % CH;
        const u32x4 v = *(const u32x4*)(src + (size_t)k * ld + nc * 8);
        const unsigned wd[4] = {v.x, v.y, v.z, v.w};
        float sc = 1.f; if (SCALE) sc = kscale[k];
#pragma unroll
        for (int e = 0; e < 8; ++e) {
            u16 h;
            if (SCALE) h = f2bf(((e & 1) ? bfhi(wd[e >> 1]) : bflo(wd[e >> 1])) * sc);
            else h = (u16)((e & 1) ? (wd[e >> 1] >> 16) : (wd[e >> 1] & 0xffffu));
            *(u16*)(smem + lds + toff_e(nc * 8 + e, k)) = h;
        }
    }
}

constexpr int CS_LD = 132;
__device__ __forceinline__ void stage_c22(const f32x16 (&acc)[2][2], int wm, int wn, int lane) {
    const int lr = lane & 31, hi = lane >> 5;
#pragma unroll
    for (int i = 0; i < 2; ++i)
#pragma unroll
        for (int j = 0; j < 2; ++j)
#pragma unroll
            for (int q = 0; q < 4; ++q) {
                const int n = wm * 64 + i * 32 + 8 * q + 4 * hi, m = wn * 64 + j * 32 + lr;
                f32x4 v = {acc[i][j][4 * q], acc[i][j][4 * q + 1], acc[i][j][4 * q + 2], acc[i][j][4 * q + 3]};
                *(f32x4*)(smem + (m * CS_LD + n) * 4) = v;
            }
}
__device__ __forceinline__ void cs_read8(int m, int c, float* v) {
    const f32x4 a = *(const f32x4*)(smem + (m * CS_LD + c) * 4), b = *(const f32x4*)(smem + (m * CS_LD + c + 4) * 4);
    v[0] = a[0]; v[1] = a[1]; v[2] = a[2]; v[3] = a[3]; v[4] = b[0]; v[5] = b[1]; v[6] = b[2]; v[7] = b[3];
}

template <class Epi>
__device__ __forceinline__ void gemm_tile(const u16* A, int lda, const u16* Bt, int ldb, int K, int m0, int n0, Epi&& epi) {
    const int tid = opaque((int)threadIdx.x), lane = tid & 63, w = tid >> 6, wm = w >> 1, wn = w & 1;
    f32x16 acc[2][2];
#pragma unroll
    for (int i = 0; i < 2; ++i)
#pragma unroll
        for (int j = 0; j < 2; ++j)
#pragma unroll
            for (int r = 0; r < 16; ++r) acc[i][j][r] = 0.f;
    const u16* Ap = A + (size_t)m0 * lda; const u16* Bp = Bt + (size_t)n0 * ldb;
    u32x4 ra[4], rb[4];
    gload_nat<128>(ra, Ap, lda, tid); gload_nat<128>(rb, Bp, ldb, tid);
    const int nk = K >> 6;
    for (int kb = 0; kb < nk; ++kb) {
        const int buf = (kb & 1) * 32768;
        sstore_nat<128>(buf, rb, tid); sstore_nat<128>(buf + 16384, ra, tid);
        __syncthreads();
        if (kb + 1 < nk) { gload_nat<128>(ra, Ap + (kb + 1) * 64, lda, tid); gload_nat<128>(rb, Bp + (kb + 1) * 64, ldb, tid); }
        mma_kb<2, 2>(acc, buf, wm * 64, buf + 16384, wn * 64, lane);
    }
    __syncthreads();
    stage_c22(acc, wm, wn, lane);
    __syncthreads();
    epi(m0, n0);
    __syncthreads();
}

__device__ __forceinline__ void convT_tile(const float* W, int K, int N, u16* Wt, int kt, int nt, int tid) {
    u16* tile = (u16*)smem;
    __syncthreads();
#pragma unroll
    for (int i = 0; i < 16; ++i) {
        const int k = i * 4 + (tid >> 6), n = tid & 63, gn = nt * 64 + n;
        const float v = (gn < N) ? W[(size_t)(kt * 64 + k) * N + gn] : 0.f;
        tile[n * 72 + k] = f2bf(v);
    }
    __syncthreads();
    const int n = tid >> 2, kc = (tid & 3) * 16;
    const u32x4 a = *(const u32x4*)(tile + n * 72 + kc), b = *(const u32x4*)(tile + n * 72 + kc + 8);
    u16* dst = Wt + (size_t)(nt * 64 + n) * K + kt * 64 + kc;
    *(u32x4*)dst = a; *(u32x4*)(dst + 8) = b;
}
__device__ __forceinline__ void convT_all(const float* W, int K, int N, int Npad, u16* Wt, int bid, int nb, int tid) {
    const int nkt = K / 64, nnt = Npad / 64;
    for (int j = bid; j < nkt * nnt; j += nb) convT_tile(W, K, N, Wt, j % nkt, j / nkt, tid);
}
__device__ __forceinline__ void rmsnorm_rows(const float* X, const float* g, u16* H, int bid, int nb, int tid) {
    const int lane = tid & 63, w = tid >> 6;
    for (int row = bid * 4 + w; row < T; row += nb * 4) {
        const float* xr = X + (size_t)row * DM;
        f32x4 v[4]; float ss = 0.f;
#pragma unroll
        for (int c = 0; c < 4; ++c) { v[c] = *(const f32x4*)(xr + c * 256 + lane * 4); ss += v[c][0] * v[c][0] + v[c][1] * v[c][1] + v[c][2] * v[c][2] + v[c][3] * v[c][3]; }
        ss = wave_sum(ss);
        const float r = rsqrtf(ss * (1.0f / DM) + EPS);
#pragma unroll
        for (int c = 0; c < 4; ++c) {
            const f32x4 gg = *(const f32x4*)(g + c * 256 + lane * 4);
            u32x2 o; o.x = pk2(v[c][0] * r * gg[0], v[c][1] * r * gg[1]); o.y = pk2(v[c][2] * r * gg[2], v[c][3] * r * gg[3]);
            *(u32x2*)(H + (size_t)row * DM + c * 256 + lane * 4) = o;
        }
    }
}
__device__ __forceinline__ void phase_prep(const Params& p, int bid, int nb) {
    const int tid = threadIdx.x;
    unsigned char* ws = p.ws;
    convT_all(p.hy_w_in, DM, HY_IN, HY_IN, (u16*)(ws + WS_WINT), bid, nb, tid);
    convT_all(p.hy_w_out, HY_OUT, DM, DM, (u16*)(ws + WS_WOUTT), bid, nb, tid);
    convT_all(p.mla_w_down, DM, MLA_DOWN, MLA_DOWN_PAD, (u16*)(ws + WS_WDOWNT), bid, nb, tid);
    convT_all(p.mla_w_q_up, MLA_QR, 1536, 1536, (u16*)(ws + WS_WQUPT), bid, nb, tid);
    convT_all(p.mla_w_kv_up, MLA_KVR, 2048, 2048, (u16*)(ws + WS_WKVUPT), bid, nb, tid);
    convT_all(p.mla_w_out, DM, DM, DM, (u16*)(ws + WS_WMOT), bid, nb, tid);
    __syncthreads();
    {
        float* Wq_s = (float*)smem; float* key_s = (float*)(smem + 64 * 129 * 4);
        for (int j = bid; j < 2 * 16 * 16 * 2; j += nb) {
            const int kh = j & 1, kt = (j >> 1) & 15, hp = (j >> 5) & 15, L = j >> 9;
            const float* Wq = p.peer_w_q + (size_t)L * DM * 2048 + (size_t)(kt * 64) * 2048 + hp * 128;
            const float* ky = p.peer_sub_keys + (size_t)L * 2 * 128 * 128 + (size_t)(hp & 1) * 128 * 128 + (size_t)(kh * 64) * 128;
            __syncthreads();
#pragma unroll 4
            for (int i = 0; i < 32; ++i) { const int idx = tid + 256 * i, row = idx >> 7, d = idx & 127; Wq_s[row * 129 + d] = Wq[(size_t)row * 2048 + d]; key_s[row * 129 + d] = ky[row * 128 + d]; }
            __syncthreads();
            const int tk = tid & 15, tkey = tid >> 4;
            float acc[4][4];
#pragma unroll
            for (int a = 0; a < 4; ++a)
#pragma unroll
                for (int b = 0; b < 4; ++b) acc[a][b] = 0.f;
            for (int d = 0; d < 128; ++d) {
                float wv[4], kv[4];
#pragma unroll
                for (int a = 0; a < 4; ++a) { wv[a] = Wq_s[(tk * 4 + a) * 129 + d]; kv[a] = key_s[(tkey * 4 + a) * 129 + d]; }
#pragma unroll
                for (int a = 0; a < 4; ++a)
#pragma unroll
                    for (int b = 0; b < 4; ++b) acc[a][b] += kv[a] * wv[b];
            }
            u16* dst = (u16*)(ws + WS_WPQT) + (size_t)L * 2048 * DM;
#pragma unroll
            for (int a = 0; a < 4; ++a) {
                u32x2 o; o.x = pk2(acc[a][0], acc[a][1]); o.y = pk2(acc[a][2], acc[a][3]);
                *(u32x2*)(dst + (size_t)(hp * 128 + kh * 64 + tkey * 4 + a) * DM + kt * 64 + tk * 4) = o;
            }
        }
    }
    {
        const size_t n8 = (size_t)2 * NEXP * DM / 8;
        for (int tb = 0; tb < 2; ++tb) {
            const float* src = tb ? p.peer_v : p.peer_u; u16* dst = (u16*)(ws + (tb ? WS_VBF : WS_UBF));
            for (size_t i = (size_t)bid * 256 + tid; i < n8; i += (size_t)nb * 256) {
                const f32x4 a = *(const f32x4*)(src + i * 8), b = *(const f32x4*)(src + i * 8 + 4);
                u32x4 o; o.x = pk2(a[0], a[1]); o.y = pk2(a[2], a[3]); o.z = pk2(b[0], b[1]); o.w = pk2(b[2], b[3]);
                *(u32x4*)(dst + i * 8) = o;
            }
        }
    }
    {
        f32x2* rr = (f32x2*)(ws + WS_ROPE_R); f32x2* rm = (f32x2*)(ws + WS_ROPE_M);
        for (int i = bid * 256 + tid; i < SEQ * 64; i += nb * 256) {
            const int s = i >> 6, d = i & 63; const float inv = 1.0f / powf(10000.0f, (float)d / 64.0f); const float ang = (float)s * inv;
            float sn, cs; sincosf(ang, &sn, &cs); rr[i] = (f32x2){cs, sn};
        }
        for (int i = bid * 256 + tid; i < SEQ * 32; i += nb * 256) {
            const int s = i >> 5, d = i & 31; const float inv = 1.0f / powf(10000.0f, (float)d / 32.0f); const float ang = (float)s * inv;
            float sn, cs; sincosf(ang, &sn, &cs); rm[i] = (f32x2){cs, sn};
        }
    }
    rmsnorm_rows(p.x, p.norm_mix, (u16*)(ws + WS_H), bid, nb, tid);
}

__device__ __forceinline__ void phase_inproj(const Params& p, int bid, int nb) {
    unsigned char* ws = p.ws;
    const u16* A = (const u16*)(ws + WS_H); const u16* Bt = (const u16*)(ws + WS_WINT);
    u16* proj = (u16*)(ws + WS_PROJ); float* ssq = (float*)(ws + WS_SSQ); const f32x2* rope = (const f32x2*)(ws + WS_ROPE_R);
    const int tid = threadIdx.x;
    constexpr int NT = HY_IN / 128;
    for (int t = bid; t < (T / 128) * NT; t += nb) {
        const int mt = t / NT, nt = t % NT;
        gemm_tile(A, DM, Bt, DM, DM, mt * 128, nt * 128, [&](int m0, int n0) {
            if (n0 >= 2048 && n0 < 3072) {
                const float sc = (n0 >= 2560) ? 0.08838834764831845f : 1.0f;
#pragma unroll
                for (int ps = 0; ps < 4; ++ps) {
                    const int m = ps * 32 + (tid >> 3), c = (tid & 7) * 8;
                    float x1[8], x2[8], y1[8], y2[8]; cs_read8(m, c, x1); cs_read8(m, c + 64, x2);
                    const f32x2* rp = rope + (size_t)((m0 + m) & (SEQ - 1)) * 64 + c;
#pragma unroll
                    for (int e = 0; e < 8; ++e) { const f32x2 cssn = rp[e]; y1[e] = (x1[e] * cssn[0] - x2[e] * cssn[1]) * sc; y2[e] = (x1[e] * cssn[1] + x2[e] * cssn[0]) * sc; }
                    u16* dst = proj + (size_t)(m0 + m) * HY_IN + n0 + c;
                    *(u32x4*)dst = pack8(y1); *(u32x4*)(dst + 64) = pack8(y2);
                }
            } else {
                const int mode = (n0 < 2048) ? 0 : ((n0 < 4096) ? 1 : 2);
#pragma unroll
                for (int ps = 0; ps < 8; ++ps) {
                    const int m = ps * 16 + (tid >> 4), c = (tid & 15) * 8;
                    float v[8]; cs_read8(m, c, v);
                    if (mode == 0) {
#pragma unroll
                        for (int e = 0; e < 8; ++e) v[e] = gelu_f(v[e]);
                        if (n0 >= 1024) {
                            float s = 0.f;
#pragma unroll
                            for (int e = 0; e < 8; ++e) s += v[e] * v[e];
                            s += __shfl_xor(s, 1); s += __shfl_xor(s, 2); s += __shfl_xor(s, 4); s += __shfl_xor(s, 8);
                            if ((tid & 15) == 0) ssq[(size_t)(m0 + m) * 8 + ((n0 - 1024) >> 7)] = s;
                        }
                    } else if (mode == 2) {
#pragma unroll
                        for (int e = 0; e < 8; ++e) v[e] = silu_f(v[e]);
                    }
                    *(u32x4*)(proj + (size_t)(m0 + m) * HY_IN + n0 + c) = pack8(v);
                }
            }
        });
    }
}

__device__ __forceinline__ float ret_log2gamma(int h) { return log2f(1.0f - exp2f(-5.0f - (float)h)); }
constexpr int YS_LD = 264;
__device__ __forceinline__ void zero4(f32x16 (&acc)[4][1]) {
#pragma unroll
    for (int i = 0; i < 4; ++i)
#pragma unroll
        for (int r = 0; r < 16; ++r) acc[i][0][r] = 0.f;
}

__device__ __forceinline__ void gmlp_task(const Params& p, int ci, int g, int dh) {
    unsigned char* ws = p.ws;
    const int tid = opaque((int)threadIdx.x), lane = tid & 63, w = tid >> 6, lr = lane & 31, hi = lane >> 5;
    const int m0 = ci * 128, col0 = g * 256 + dh * 128;
    const u16* proj = (const u16*)(ws + WS_PROJ); const float* ssq = (const float*)(ws + WS_SSQ);
    float* r_s = (float*)(smem + 49152);
    __syncthreads();
    if (tid < 128) { const float s = ssq[(size_t)(m0 + tid) * 8 + 2 * g] + ssq[(size_t)(m0 + tid) * 8 + 2 * g + 1]; r_s[tid] = rsqrtf(s * (1.0f / 256.0f) + EPS); }
    f32x16 acc[4][1]; zero4(acc);
    const float* Wg = p.gm_w_s + (size_t)g * 128 * 128;
    for (int kb = 0; kb < 2; ++kb) {
        __syncthreads();
        load_tr<128, false>(0, proj + (size_t)(m0 + kb * 64) * HY_IN + 1024 + col0, HY_IN, tid, nullptr);
#pragma unroll 2
        for (int i = 0; i < 8; ++i) {
            const int idx = tid + 256 * i, t = idx >> 4, c4 = idx & 15, s0 = kb * 64 + c4 * 4;
            const f32x4 wv = *(const f32x4*)(Wg + t * 128 + s0);
            float o[4];
#pragma unroll
            for (int e = 0; e < 4; ++e) o[e] = (s0 + e <= t) ? wv[e] * r_s[s0 + e] : 0.f;
            u32x2 pk; pk.x = pk2(o[0], o[1]); pk.y = pk2(o[2], o[3]);
            *(u32x2*)(smem + 16384 + toff_e(t, c4 * 4)) = pk;
        }
        __syncthreads();
        mma_kb<4, 1>(acc, 0, 0, 16384, w * 32, lane);
    }
    __syncthreads();
    const int t = w * 32 + lr;
    const float bs = p.gm_b_s[g * 128 + t];
    u16* Ys = (u16*)smem;
#pragma unroll
    for (int i = 0; i < 4; ++i)
#pragma unroll
        for (int q = 0; q < 4; ++q) {
            const int d = i * 32 + 8 * q + 4 * hi;
            const f32x4 gn = *(const f32x4*)(p.gm_v_norm + col0 + d);
            u32x2 pk; pk.x = pk2(acc[i][0][4 * q] * gn[0] + bs, acc[i][0][4 * q + 1] * gn[1] + bs); pk.y = pk2(acc[i][0][4 * q + 2] * gn[2] + bs, acc[i][0][4 * q + 3] * gn[3] + bs);
            *(u32x2*)(Ys + t * YS_LD + d) = pk;
        }
    __syncthreads();
    u16* y = (u16*)(ws + WS_Y);
#pragma unroll
    for (int ps = 0; ps < 8; ++ps) {
        const int tt = ps * 16 + (tid >> 4), c = (tid & 15) * 8;
        float mv[8], uv[8]; unpack8(*(const u32x4*)(Ys + tt * YS_LD + c), mv); unpack8(*(const u32x4*)(proj + (size_t)(m0 + tt) * HY_IN + col0 + c), uv);
#pragma unroll
        for (int e = 0; e < 8; ++e) mv[e] *= uv[e];
        *(u32x4*)(y + (size_t)(m0 + tt) * HY_OUT + col0 + c) = pack8(mv);
    }
}

__device__ __forceinline__ void ret_ds_task(const Params& p, int ci, int h, int eh) {
    unsigned char* ws = p.ws;
    const int tid = opaque((int)threadIdx.x), lane = tid & 63, w = tid >> 6, lr = lane & 31, hi = lane >> 5;
    const int m0 = ci * 128;
    const u16* proj = (const u16*)(ws + WS_PROJ);
    float* kd_s = (float*)(smem + 49152);
    const float l2g = ret_log2gamma(h);
    __syncthreads();
    if (tid < 128) kd_s[tid] = exp2f((float)(127 - tid) * l2g);
    f32x16 acc[4][1]; zero4(acc);
    for (int kb = 0; kb < 2; ++kb) {
        __syncthreads();
        load_tr<128, false>(0, proj + (size_t)(m0 + kb * 64) * HY_IN + 2560 + h * 128, HY_IN, tid, nullptr);
        load_tr<128, true>(16384, proj + (size_t)(m0 + kb * 64) * HY_IN + 3072 + h * 256 + eh * 128, HY_IN, tid, kd_s + kb * 64);
        __syncthreads();
        mma_kb<4, 1>(acc, 0, 0, 16384, w * 32, lane);
    }
    float* dst = (float*)(ws + WS_DST) + (size_t)(ci * 4 + h) * 256 * 128;
#pragma unroll
    for (int i = 0; i < 4; ++i)
#pragma unroll
        for (int q = 0; q < 4; ++q) {
            const int d = i * 32 + 8 * q + 4 * hi, e = eh * 128 + w * 32 + lr;
            f32x4 v = {acc[i][0][4 * q], acc[i][0][4 * q + 1], acc[i][0][4 * q + 2], acc[i][0][4 * q + 3]};
            *(f32x4*)(dst + (size_t)e * 128 + d) = v;
        }
}

__device__ __forceinline__ void phase_mixA(const Params& p, int bid, int nb) {
    for (int t = bid; t < 2048; t += nb) {
        const int ci = t >> 4, sub = t & 15;
        if (sub < 8) gmlp_task(p, ci, sub >> 1, sub & 1); else ret_ds_task(p, ci, (sub - 8) >> 1, sub & 1);
    }
}

__device__ __forceinline__ void phase_scan(const Params& p, int bid, int nb) {
    float* base = (float*)(p.ws + WS_DST);
    for (int i = bid * 256 + threadIdx.x; i < 4 * 4 * 256 * 128 / 4; i += nb * 256) {
        const int b = i >> 15, h = (i >> 13) & 3, rest = i & 8191;
        const float cd = exp2f(128.0f * ret_log2gamma(h));
        f32x4 s = {0.f, 0.f, 0.f, 0.f};
        float* ptr = base + ((size_t)(b * 32) * 4 + h) * 32768 + (size_t)rest * 4;
#pragma unroll 8
        for (int n = 0; n < 32; ++n) {
            f32x4* q = (f32x4*)(ptr + (size_t)n * 4 * 32768);
            const f32x4 tmp = *q; *q = s; s = s * cd + tmp;
        }
    }
}

__device__ __forceinline__ void ret_out_task(const Params& p, int ci, int h) {
    unsigned char* ws = p.ws;
    const int tid = opaque((int)threadIdx.x), lane = tid & 63, w = tid >> 6, lr = lane & 31, hi = lane >> 5;
    const int m0 = ci * 128;
    const u16* proj = (const u16*)(ws + WS_PROJ);
    const float l2g = ret_log2gamma(h);
    const int qi = w * 32 + lr;
    constexpr int RA = 0, RB = 16384, RC = 49152;
    __syncthreads();
    {
        u32x4 r0[4], r1[4];
        const u16* qp = proj + (size_t)m0 * HY_IN + 2048 + h * 128; const u16* kp = proj + (size_t)m0 * HY_IN + 2560 + h * 128;
        gload_nat<128>(r0, qp, HY_IN, tid); gload_nat<128>(r1, qp + 64, HY_IN, tid);
        sstore_nat<128>(RC, r0, tid); sstore_nat<128>(RC + 16384, r1, tid);
        gload_nat<128>(r0, kp, HY_IN, tid); gload_nat<128>(r1, kp + 64, HY_IN, tid);
        sstore_nat<128>(RB, r0, tid); sstore_nat<128>(RB + 16384, r1, tid);
    }
    __syncthreads();
    {
        f32x16 sc[4][1]; zero4(sc);
        mma_kb<4, 1>(sc, RB, 0, RC, w * 32, lane);
        mma_kb<4, 1>(sc, RB + 16384, 0, RC + 16384, w * 32, lane);
        __syncthreads();
#pragma unroll
        for (int i = 0; i < 4; ++i)
#pragma unroll
            for (int q = 0; q < 4; ++q) {
                const int j = i * 32 + 8 * q + 4 * hi;
                float o[4];
#pragma unroll
                for (int e = 0; e < 4; ++e) { const int df = qi - (j + e); o[e] = (df >= 0) ? sc[i][0][4 * q + e] * exp2f((float)df * l2g) : 0.f; }
                u32x2 pk; pk.x = pk2(o[0], o[1]); pk.y = pk2(o[2], o[3]);
                *(u32x2*)(smem + RB + (j >> 6) * 16384 + toff_e(qi, j & 63)) = pk;
            }
#pragma unroll 2
        for (int i = 0; i < 8; ++i) {
            const int idx = tid + 256 * i, row = idx >> 4, c16 = idx & 15;
            unsigned char* ptr = smem + RC + (c16 >> 3) * 16384 + toff(row, c16 & 7);
            float f[8]; unpack8(*(const u32x4*)ptr, f);
            const float qd = exp2f((float)(row + 1) * l2g);
#pragma unroll
            for (int e = 0; e < 8; ++e) f[e] *= qd;
            *(u32x4*)ptr = pack8(f);
        }
    }
    const float* st = (const float*)(ws + WS_DST) + (size_t)(ci * 4 + h) * 256 * 128;
    float ssq = 0.f;
    u16* ytmp = (u16*)(ws + WS_Y) + (size_t)(m0 + qi) * HY_OUT + 1024 + h * 256;
    f32x16 acc[4][1];
#pragma unroll
    for (int eh = 0; eh < 2; ++eh) {
        zero4(acc);
        for (int kb = 0; kb < 4; ++kb) {
            __syncthreads();
            if (kb < 2) {
                load_tr<128, false>(RA, proj + (size_t)(m0 + kb * 64) * HY_IN + 3072 + h * 256 + eh * 128, HY_IN, tid, nullptr);
            } else {
                const int d0 = (kb - 2) * 64, tq = opaque(tid);
#pragma unroll 2
                for (int i = 0; i < 8; ++i) {
                    const int idx = tq + 256 * i, row = idx >> 4, c4 = idx & 15;
                    const f32x4 v = *(const f32x4*)(st + (size_t)(eh * 128 + row) * 128 + d0 + c4 * 4);
                    u32x2 pk; pk.x = pk2(v[0], v[1]); pk.y = pk2(v[2], v[3]);
                    *(u32x2*)(smem + RA + toff_e(row, c4 * 4)) = pk;
                }
            }
            __syncthreads();
            mma_kb<4, 1>(acc, RA, 0, (kb < 2) ? (RB + kb * 16384) : (RC + (kb - 2) * 16384), w * 32, lane);
        }
#pragma unroll
        for (int i = 0; i < 4; ++i)
#pragma unroll
            for (int r = 0; r < 16; ++r) ssq += acc[i][0][r] * acc[i][0][r];
        if (eh == 0) {
#pragma unroll
            for (int i = 0; i < 4; ++i)
#pragma unroll
                for (int q = 0; q < 4; ++q) {
                    u32x2 pk; pk.x = pk2(acc[i][0][4 * q], acc[i][0][4 * q + 1]); pk.y = pk2(acc[i][0][4 * q + 2], acc[i][0][4 * q + 3]);
                    *(u32x2*)(ytmp + i * 32 + 8 * q + 4 * hi) = pk;
                }
        }
    }
    ssq += __shfl_xor(ssq, 32);
    const float rn = rsqrtf(ssq * (1.0f / 256.0f) + EPS);
    __syncthreads();
    u16* Ys = (u16*)smem;
#pragma unroll
    for (int i = 0; i < 4; ++i)
#pragma unroll
        for (int q = 0; q < 4; ++q) {
            const int e = i * 32 + 8 * q + 4 * hi;
            const f32x4 g0 = *(const f32x4*)(p.ret_norm + h * 256 + e), g1 = *(const f32x4*)(p.ret_norm + h * 256 + 128 + e);
            u32x2 pk; const u32x2 z = *(const u32x2*)(ytmp + e);
            pk.x = pk2(bflo(z.x) * rn * g0[0], bfhi(z.x) * rn * g0[1]); pk.y = pk2(bflo(z.y) * rn * g0[2], bfhi(z.y) * rn * g0[3]);
            *(u32x2*)(Ys + qi * YS_LD + e) = pk;
            pk.x = pk2(acc[i][0][4 * q] * rn * g1[0], acc[i][0][4 * q + 1] * rn * g1[1]); pk.y = pk2(acc[i][0][4 * q + 2] * rn * g1[2], acc[i][0][4 * q + 3] * rn * g1[3]);
            *(u32x2*)(Ys + qi * YS_LD + 128 + e) = pk;
        }
    __syncthreads();
    u16* y = (u16*)(ws + WS_Y);
#pragma unroll 4
    for (int ps = 0; ps < 16; ++ps) {
        const int tt = ps * 8 + (tid >> 5), c = (tid & 31) * 8;
        float mv[8], gv[8]; unpack8(*(const u32x4*)(Ys + tt * YS_LD + c), mv); unpack8(*(const u32x4*)(proj + (size_t)(m0 + tt) * HY_IN + 4096 + h * 256 + c), gv);
#pragma unroll
        for (int e = 0; e < 8; ++e) mv[e] *= gv[e];
        *(u32x4*)(y + (size_t)(m0 + tt) * HY_OUT + 1024 + h * 256 + c) = pack8(mv);
    }
}
__device__ __forceinline__ void phase_mixB(const Params& p, int bid, int nb) {
    for (int t = bid; t < 512; t += nb) ret_out_task(p, t >> 2, t & 3);
}

__device__ __forceinline__ void phase_gemm_residual(const Params& p, const u16* A, int lda, const u16* Bt, int K, const float* xsrc, float* xdst, int bid, int nb) {
    const int tid = threadIdx.x;
    constexpr int NT = DM / 128;
    for (int t = bid; t < (T / 128) * NT; t += nb) {
        const int mt = t / NT, nt = t % NT;
        gemm_tile(A, lda, Bt, K, K, mt * 128, nt * 128, [&](int m0, int n0) {
#pragma unroll
            for (int ps = 0; ps < 8; ++ps) {
                const int m = ps * 16 + (tid >> 4), c = (tid & 15) * 8;
                float v[8]; cs_read8(m, c, v);
                const size_t o = (size_t)(m0 + m) * DM + n0 + c;
                const f32x4 a = *(const f32x4*)(xsrc + o), b = *(const f32x4*)(xsrc + o + 4);
                f32x4 ra = {a[0] + v[0], a[1] + v[1], a[2] + v[2], a[3] + v[3]}, rb = {b[0] + v[4], b[1] + v[5], b[2] + v[6], b[3] + v[7]};
                *(f32x4*)(xdst + o) = ra; *(f32x4*)(xdst + o + 4) = rb;
            }
        });
    }
}
template <int K, int N>
__device__ __forceinline__ void phase_gemm_f32(const u16* A, const u16* Bt, float* C, int bid, int nb) {
    const int tid = threadIdx.x;
    constexpr int NT = N / 128, lda = K, ldc = N;
    for (int t = bid; t < (T / 128) * NT; t += nb) {
        const int mt = t / NT, nt = t % NT;
        gemm_tile(A, lda, Bt, K, K, mt * 128, nt * 128, [&](int m0, int n0) {
#pragma unroll
            for (int ps = 0; ps < 8; ++ps) {
                const int m = ps * 16 + (tid >> 4), c = (tid & 15) * 8;
                float v[8]; cs_read8(m, c, v);
                const size_t o = (size_t)(m0 + m) * ldc + n0 + c;
                f32x4 ra = {v[0], v[1], v[2], v[3]}, rb = {v[4], v[5], v[6], v[7]};
                *(f32x4*)(C + o) = ra; *(f32x4*)(C + o + 4) = rb;
            }
        });
    }
}

__device__ __forceinline__ void ins16(float (&L)[16], float e) {
#pragma unroll
    for (int i = 0; i < 16; ++i) { const float hi = fmaxf(L[i], e); e = fminf(L[i], e); L[i] = hi; }
}
__device__ __forceinline__ void phase_topk(const Params& p, int bid, int nb) {
    const int tid = threadIdx.x;
    const float* scores = (const float*)(p.ws + WS_SCORES);
    u16* experts = (u16*)(p.ws + WS_EXP); float* gates = (float*)(p.ws + WS_GATE);
    unsigned* la = (unsigned*)smem;
    for (int base = bid * 256; base < T * 8; base += nb * 256) {
        const int th = base + tid;
        const float* sp = scores + (size_t)th * 256;
        float a[16], b[16];
#pragma unroll
        for (int i = 0; i < 16; ++i) { a[i] = -INFINITY; b[i] = -INFINITY; }
        for (int k4 = 0; k4 < 32; ++k4) {
            const f32x4 v = *(const f32x4*)(sp + k4 * 4); const f32x4 u = *(const f32x4*)(sp + 128 + k4 * 4);
#pragma unroll
            for (int e = 0; e < 4; ++e) {
                ins16(a, __uint_as_float((__float_as_uint(v[e]) & ~127u) | (unsigned)(k4 * 4 + e)));
                ins16(b, __uint_as_float((__float_as_uint(u[e]) & ~127u) | (unsigned)(k4 * 4 + e)));
            }
        }
        __syncthreads();
#pragma unroll
        for (int i = 0; i < 16; ++i) { la[i * 256 + tid] = __float_as_uint(a[i]); la[(16 + i) * 256 + tid] = __float_as_uint(b[i]); }
        float c[16];
#pragma unroll
        for (int i = 0; i < 16; ++i) c[i] = -INFINITY;
#pragma unroll
        for (int i = 0; i < 16; ++i)
#pragma unroll
            for (int j = 0; j < 16; ++j)
                if ((i + 1) * (j + 1) <= 16) {
                    const float s = __uint_as_float(__float_as_uint(a[i]) & ~127u) + __uint_as_float(__float_as_uint(b[j]) & ~127u);
                    ins16(c, __uint_as_float((__float_as_uint(s) & ~255u) | (unsigned)(i * 16 + j)));
                }
        float bs[16]; unsigned ex[16]; float mx = -INFINITY;
#pragma unroll
        for (int k = 0; k < 16; ++k) {
            const unsigned code = __float_as_uint(c[k]) & 255u;
            const unsigned av = la[(code >> 4) * 256 + tid], bv = la[(16 + (code & 15)) * 256 + tid];
            bs[k] = __uint_as_float(av & ~127u) + __uint_as_float(bv & ~127u);
            ex[k] = (av & 127u) * 128u + (bv & 127u);
            mx = fmaxf(mx, bs[k]);
        }
        float sum = 0.f;
#pragma unroll
        for (int k = 0; k < 16; ++k) { bs[k] = __expf(bs[k] - mx); sum += bs[k]; }
        const float inv = 1.0f / sum;
        u32x4 e0, e1;
        e0.x = ex[0] | (ex[1] << 16); e0.y = ex[2] | (ex[3] << 16); e0.z = ex[4] | (ex[5] << 16); e0.w = ex[6] | (ex[7] << 16);
        e1.x = ex[8] | (ex[9] << 16); e1.y = ex[10] | (ex[11] << 16); e1.z = ex[12] | (ex[13] << 16); e1.w = ex[14] | (ex[15] << 16);
        *(u32x4*)(experts + (size_t)th * 16) = e0; *(u32x4*)(experts + (size_t)th * 16 + 8) = e1;
#pragma unroll
        for (int k4 = 0; k4 < 4; ++k4) { f32x4 g = {bs[4 * k4] * inv, bs[4 * k4 + 1] * inv, bs[4 * k4 + 2] * inv, bs[4 * k4 + 3] * inv}; *(f32x4*)(gates + (size_t)th * 16 + k4 * 4) = g; }
        __syncthreads();
    }
}

template <int MODE>
__device__ __forceinline__ void phase_peer(const Params& p, int L, const float* gnext, int bid, int nb) {
    const int tid = threadIdx.x, lane = tid & 63, w = tid >> 6;
    const u16* H = (const u16*)(p.ws + WS_H);
    const u16* U = (const u16*)(p.ws + WS_UBF) + (size_t)L * NEXP * DM; const u16* V = (const u16*)(p.ws + WS_VBF) + (size_t)L * NEXP * DM;
    const u16* experts = (const u16*)(p.ws + WS_EXP); const float* gates = (const float*)(p.ws + WS_GATE);
    for (int t = bid * 4 + w; t < T; t += nb * 4) {
        float xh[16];
        { const u16* hp = H + (size_t)t * DM + lane * 8; unpack8(*(const u32x4*)hp, xh); unpack8(*(const u32x4*)(hp + 512), xh + 8); }
        const unsigned e_lo = experts[(size_t)t * 128 + lane], e_hi = experts[(size_t)t * 128 + 64 + lane];
        const float g_lo = gates[(size_t)t * 128 + lane], g_hi = gates[(size_t)t * 128 + 64 + lane];
        float w_lo = 0.f, w_hi = 0.f;
#pragma unroll 1
        for (int eb = 0; eb < 128; eb += 8) {
            u32x4 r[8][2];
#pragma unroll
            for (int k = 0; k < 8; ++k) {
                const int e = eb + k;
                const unsigned ex = __builtin_amdgcn_readlane((e < 64) ? e_lo : e_hi, e & 63);
                const u16* up = U + (size_t)ex * DM + lane * 8;
                r[k][0] = *(const u32x4*)up; r[k][1] = *(const u32x4*)(up + 512);
            }
#pragma unroll
            for (int k = 0; k < 8; ++k) {
                float f[16]; unpack8(r[k][0], f); unpack8(r[k][1], f + 8);
                float d = 0.f;
#pragma unroll
                for (int i = 0; i < 16; ++i) d += f[i] * xh[i];
                d = wave_sum(d);
                const int e = eb + k;
                const float a = gelu_f(d);
                if (e < 64) { if (lane == e) w_lo = a * g_lo; } else { if (lane == e - 64) w_hi = a * g_hi; }
            }
        }
        float o[16];
#pragma unroll
        for (int i = 0; i < 16; ++i) o[i] = 0.f;
#pragma unroll 1
        for (int eb = 0; eb < 128; eb += 8) {
            u32x4 r[8][2]; float wv[8];
#pragma unroll
            for (int k = 0; k < 8; ++k) {
                const int e = eb + k;
                const unsigned ex = __builtin_amdgcn_readlane((e < 64) ? e_lo : e_hi, e & 63);
                wv[k] = __uint_as_float(__builtin_amdgcn_readlane(__float_as_uint((e < 64) ? w_lo : w_hi), e & 63));
                const u16* vp = V + (size_t)ex * DM + lane * 8;
                r[k][0] = *(const u32x4*)vp; r[k][1] = *(const u32x4*)(vp + 512);
            }
#pragma unroll
            for (int k = 0; k < 8; ++k) {
                float f[16]; unpack8(r[k][0], f); unpack8(r[k][1], f + 8);
#pragma unroll
                for (int i = 0; i < 16; ++i) o[i] += wv[k] * f[i];
            }
        }
        float* xr = p.out + (size_t)t * DM + lane * 8;
        float xv[16];
        { const f32x4 a = *(const f32x4*)xr, b = *(const f32x4*)(xr + 4), c = *(const f32x4*)(xr + 512), d = *(const f32x4*)(xr + 516);
          xv[0] = a[0]; xv[1] = a[1]; xv[2] = a[2]; xv[3] = a[3]; xv[4] = b[0]; xv[5] = b[1]; xv[6] = b[2]; xv[7] = b[3];
          xv[8] = c[0]; xv[9] = c[1]; xv[10] = c[2]; xv[11] = c[3]; xv[12] = d[0]; xv[13] = d[1]; xv[14] = d[2]; xv[15] = d[3]; }
        float ss = 0.f;
#pragma unroll
        for (int i = 0; i < 16; ++i) { xv[i] += o[i]; ss += xv[i] * xv[i]; }
        ss = wave_sum(ss);
        const float rn = rsqrtf(ss * (1.0f / DM) + EPS);
        float gv[16];
        { const float* gp = gnext + lane * 8; const f32x4 a = *(const f32x4*)gp, b = *(const f32x4*)(gp + 4), c = *(const f32x4*)(gp + 512), d = *(const f32x4*)(gp + 516);
          gv[0] = a[0]; gv[1] = a[1]; gv[2] = a[2]; gv[3] = a[3]; gv[4] = b[0]; gv[5] = b[1]; gv[6] = b[2]; gv[7] = b[3];
          gv[8] = c[0]; gv[9] = c[1]; gv[10] = c[2]; gv[11] = c[3]; gv[12] = d[0]; gv[13] = d[1]; gv[14] = d[2]; gv[15] = d[3]; }
        if (MODE == 0) {
            *(f32x4*)xr = (f32x4){xv[0], xv[1], xv[2], xv[3]}; *(f32x4*)(xr + 4) = (f32x4){xv[4], xv[5], xv[6], xv[7]};
            *(f32x4*)(xr + 512) = (f32x4){xv[8], xv[9], xv[10], xv[11]}; *(f32x4*)(xr + 516) = (f32x4){xv[12], xv[13], xv[14], xv[15]};
            float hv[16];
#pragma unroll
            for (int i = 0; i < 16; ++i) hv[i] = xv[i] * rn * gv[i];
            u16* hp = (u16*)(p.ws + WS_H) + (size_t)t * DM + lane * 8;
            *(u32x4*)hp = pack8(hv); *(u32x4*)(hp + 512) = pack8(hv + 8);
        } else {
#pragma unroll
            for (int i = 0; i < 16; ++i) xv[i] = xv[i] * rn * gv[i];
            *(f32x4*)xr = (f32x4){xv[0], xv[1], xv[2], xv[3]}; *(f32x4*)(xr + 4) = (f32x4){xv[4], xv[5], xv[6], xv[7]};
            *(f32x4*)(xr + 512) = (f32x4){xv[8], xv[9], xv[10], xv[11]}; *(f32x4*)(xr + 516) = (f32x4){xv[12], xv[13], xv[14], xv[15]};
        }
    }
}

__device__ __forceinline__ void phase_mla_norm(const Params& p, int bid, int nb) {
    const int tid = threadIdx.x, lane = tid & 63, w = tid >> 6;
    const float* down = (const float*)(p.ws + WS_DOWN);
    u16* cqn = (u16*)(p.ws + WS_CQN); u16* ckvn = (u16*)(p.ws + WS_CKVN); u16* kr = (u16*)(p.ws + WS_KROPE);
    const f32x2* rope = (const f32x2*)(p.ws + WS_ROPE_M);
    for (int t = bid * 4 + w; t < T; t += nb * 4) {
        const float* dr = down + (size_t)t * MLA_DOWN_PAD;
        float q[6], kv[4];
#pragma unroll
        for (int i = 0; i < 6; ++i) q[i] = dr[i * 64 + lane];
#pragma unroll
        for (int i = 0; i < 4; ++i) kv[i] = dr[384 + i * 64 + lane];
        const float rp = dr[640 + lane];
        float sq = 0.f, sk = 0.f;
#pragma unroll
        for (int i = 0; i < 6; ++i) sq += q[i] * q[i];
#pragma unroll
        for (int i = 0; i < 4; ++i) sk += kv[i] * kv[i];
        sq = wave_sum(sq); sk = wave_sum(sk);
        const float rq = rsqrtf(sq * (1.0f / MLA_QR) + EPS), rk = rsqrtf(sk * (1.0f / MLA_KVR) + EPS);
#pragma unroll
        for (int i = 0; i < 6; ++i) cqn[(size_t)t * MLA_QR + i * 64 + lane] = f2bf(q[i] * rq * p.mla_q_norm[i * 64 + lane]);
#pragma unroll
        for (int i = 0; i < 4; ++i) ckvn[(size_t)t * MLA_KVR + i * 64 + lane] = f2bf(kv[i] * rk * p.mla_kv_norm[i * 64 + lane]);
        const float other = __shfl_xor(rp, 32);
        const f32x2 cssn = rope[(size_t)(t & (SEQ - 1)) * 32 + (lane & 31)];
        const float res = (lane < 32) ? (rp * cssn[0] - other * cssn[1]) : (other * cssn[1] + rp * cssn[0]);
        kr[(size_t)t * 64 + lane] = f2bf(res);
    }
}

__device__ __forceinline__ void phase_mla_up(const Params& p, int bid, int nb) {
    const int tid = threadIdx.x;
    unsigned char* ws = p.ws;
    const f32x2* rope = (const f32x2*)(ws + WS_ROPE_M);
    u16* qo = (u16*)(ws + WS_Q); u16* kvo = (u16*)(ws + WS_KV);
    constexpr int NTQ = 1536 / 128, NTKV = 2048 / 128, NTT = NTQ + NTKV;
    for (int t = bid; t < (T / 128) * NTT; t += nb) {
        const int mt = t / NTT, nt = t % NTT;
        if (nt < NTQ) {
            gemm_tile((const u16*)(ws + WS_CQN), MLA_QR, (const u16*)(ws + WS_WQUPT), MLA_QR, MLA_QR, mt * 128, nt * 128, [&](int m0, int n0) {
#pragma unroll
                for (int ps = 0; ps < 8; ++ps) {
                    const int m = ps * 16 + (tid >> 4), c = (tid & 15) * 8;
                    const int within = (n0 + c) % 192;
                    u16* dst = qo + (size_t)(m0 + m) * 1536 + n0 + c;
                    if (within < 128) { float v[8]; cs_read8(m, c, v); *(u32x4*)dst = pack8(v); }
                    else if (within < 160) {
                        float x1[8], x2[8], y1[8], y2[8]; cs_read8(m, c, x1); cs_read8(m, c + 32, x2);
                        const f32x2* rp = rope + (size_t)((m0 + m) & (SEQ - 1)) * 32 + (within - 128);
#pragma unroll
                        for (int e = 0; e < 8; ++e) { const f32x2 cssn = rp[e]; y1[e] = x1[e] * cssn[0] - x2[e] * cssn[1]; y2[e] = x1[e] * cssn[1] + x2[e] * cssn[0]; }
                        *(u32x4*)dst = pack8(y1); *(u32x4*)(dst + 32) = pack8(y2);
                    }
                }
            });
        } else {
            gemm_tile((const u16*)(ws + WS_CKVN), MLA_KVR, (const u16*)(ws + WS_WKVUPT), MLA_KVR, MLA_KVR, mt * 128, (nt - NTQ) * 128, [&](int m0, int n0) {
#pragma unroll
                for (int ps = 0; ps < 8; ++ps) {
                    const int m = ps * 16 + (tid >> 4), c = (tid & 15) * 8;
                    float v[8]; cs_read8(m, c, v);
                    *(u32x4*)(kvo + (size_t)(m0 + m) * 2048 + n0 + c) = pack8(v);
                }
            });
        }
    }
}

__device__ __forceinline__ int crow(int r, int hi) { return (r & 3) + 8 * (r >> 2) + 4 * hi; }
__device__ __forceinline__ void attn_task(const Params& p, int b, int h, int qb) {
    unsigned char* ws = p.ws;
    const int tid = opaque((int)threadIdx.x), lane = tid & 63, w = tid >> 6, lr = lane & 31, hi = lane >> 5;
    const u16* Q = (const u16*)(ws + WS_Q); const u16* KV = (const u16*)(ws + WS_KV); const u16* KR = (const u16*)(ws + WS_KROPE);
    const int t0 = b * SEQ, q0 = qb * 128, qrow = q0 + w * 32 + lr;
    bf16x8 qf[12];
#pragma unroll
    for (int s = 0; s < 12; ++s) qf[s] = *(const bf16x8*)(Q + (size_t)(t0 + qrow) * 1536 + h * 192 + s * 16 + hi * 8);
    f32x16 o[4];
#pragma unroll
    for (int i = 0; i < 4; ++i)
#pragma unroll
        for (int r = 0; r < 16; ++r) o[i][r] = 0.f;
    float m = -1e30f, l = 0.f;
    const float c2 = 0.07216878364870322f * 1.4426950408889634f;
    const int ntiles = (q0 + 128) >> 6;
    constexpr int VT = 24576;
    for (int jt = 0; jt < ntiles; ++jt) {
        const int j0 = jt * 64;
        __syncthreads();
#pragma unroll
        for (int i = 0; i < 4; ++i) {
            const int idx = tid + 256 * i, key = idx >> 4, c16 = idx & 15;
            const u32x4 v = *(const u32x4*)(KV + (size_t)(t0 + j0 + key) * 2048 + h * 256 + c16 * 8);
            *(u32x4*)(smem + (c16 >> 3) * 8192 + toff(key, c16 & 7)) = v;
        }
#pragma unroll
        for (int i = 0; i < 2; ++i) {
            const int idx = tid + 256 * i, key = idx >> 3, c8 = idx & 7;
            const u32x4 v = *(const u32x4*)(KR + (size_t)(t0 + j0 + key) * 64 + c8 * 8);
            *(u32x4*)(smem + 16384 + toff(key, c8)) = v;
        }
#pragma unroll
        for (int i = 0; i < 4; ++i) {
            const int idx = tid + 256 * i, key = idx >> 4, c16 = idx & 15;
            const u32x4 v = *(const u32x4*)(KV + (size_t)(t0 + j0 + key) * 2048 + h * 256 + 128 + c16 * 8);
            const unsigned wd[4] = {v.x, v.y, v.z, v.w};
            const int pos = (key & ~12) | ((key & 4) << 1) | ((key & 8) >> 1);
#pragma unroll
            for (int e = 0; e < 8; ++e) *(u16*)(smem + VT + toff_e(c16 * 8 + e, pos)) = (u16)((e & 1) ? (wd[e >> 1] >> 16) : (wd[e >> 1] & 0xffffu));
        }
        __syncthreads();
        f32x16 s0, s1;
#pragma unroll
        for (int r = 0; r < 16; ++r) { s0[r] = 0.f; s1[r] = 0.f; }
#pragma unroll
        for (int s = 0; s < 12; ++s) {
            const int kbk = s >> 2, c8 = 2 * (s & 3) + hi;
            const bf16x8 a0 = *(const bf16x8*)(smem + kbk * 8192 + toff(lr, c8)), a1 = *(const bf16x8*)(smem + kbk * 8192 + toff(32 + lr, c8));
            s0 = __builtin_amdgcn_mfma_f32_32x32x16_bf16(a0, qf[s], s0, 0, 0, 0);
            s1 = __builtin_amdgcn_mfma_f32_32x32x16_bf16(a1, qf[s], s1, 0, 0, 0);
            if ((s & 3) == 3) __builtin_amdgcn_sched_barrier(0);
        }
        if (j0 + 63 > q0 + w * 32) {
#pragma unroll
            for (int r = 0; r < 16; ++r) {
                if (j0 + crow(r, hi) > qrow) s0[r] = -INFINITY;
                if (j0 + 32 + crow(r, hi) > qrow) s1[r] = -INFINITY;
            }
        }
        float mx = s0[0];
#pragma unroll
        for (int r = 1; r < 16; ++r) mx = fmaxf(mx, s0[r]);
#pragma unroll
        for (int r = 0; r < 16; ++r) mx = fmaxf(mx, s1[r]);
        mx = fmaxf(mx, __shfl_xor(mx, 32));
        const float mn = fmaxf(m, mx), alpha = exp2f((m - mn) * c2);
        m = mn;
        float rs = 0.f;
#pragma unroll
        for (int r = 0; r < 16; ++r) { s0[r] = exp2f((s0[r] - mn) * c2); s1[r] = exp2f((s1[r] - mn) * c2); rs += s0[r] + s1[r]; }
        l = l * alpha + rs;
#pragma unroll
        for (int i = 0; i < 4; ++i)
#pragma unroll
            for (int r = 0; r < 16; ++r) o[i][r] *= alpha;
        bf16x8 pf[4];
#pragma unroll
        for (int ks = 0; ks < 4; ++ks) {
            u32x4 wv;
            if (ks < 2) { const int bs = 8 * (ks & 1); wv.x = pk2(s0[bs], s0[bs + 1]); wv.y = pk2(s0[bs + 2], s0[bs + 3]); wv.z = pk2(s0[bs + 4], s0[bs + 5]); wv.w = pk2(s0[bs + 6], s0[bs + 7]); }
            else { const int bs = 8 * (ks & 1); wv.x = pk2(s1[bs], s1[bs + 1]); wv.y = pk2(s1[bs + 2], s1[bs + 3]); wv.z = pk2(s1[bs + 4], s1[bs + 5]); wv.w = pk2(s1[bs + 6], s1[bs + 7]); }
            pf[ks] = __builtin_bit_cast(bf16x8, wv);
        }
#pragma unroll
        for (int ks = 0; ks < 4; ++ks) {
            const int c8 = 2 * ks + hi;
#pragma unroll
            for (int dvb = 0; dvb < 4; ++dvb) {
                const bf16x8 a = *(const bf16x8*)(smem + VT + toff(dvb * 32 + lr, c8));
                o[dvb] = __builtin_amdgcn_mfma_f32_32x32x16_bf16(a, pf[ks], o[dvb], 0, 0, 0);
            }
            __builtin_amdgcn_sched_barrier(0);
        }
    }
    l += __shfl_xor(l, 32);
    const float inv = 1.0f / l;
    __syncthreads();
    u16* Os = (u16*)smem;
#pragma unroll
    for (int dvb = 0; dvb < 4; ++dvb)
#pragma unroll
        for (int q = 0; q < 4; ++q) {
            const int dv = dvb * 32 + 8 * q + 4 * hi;
            u32x2 pk; pk.x = pk2(o[dvb][4 * q] * inv, o[dvb][4 * q + 1] * inv); pk.y = pk2(o[dvb][4 * q + 2] * inv, o[dvb][4 * q + 3] * inv);
            *(u32x2*)(Os + (w * 32 + lr) * 136 + dv) = pk;
        }
    __syncthreads();
    u16* O = (u16*)(ws + WS_O);
#pragma unroll
    for (int ps = 0; ps < 8; ++ps) {
        const int qq = ps * 16 + (tid >> 4), c = (tid & 15) * 8;
        *(u32x4*)(O + (size_t)(t0 + q0 + qq) * DM + h * 128 + c) = *(const u32x4*)(Os + qq * 136 + c);
    }
}
__device__ __forceinline__ void phase_attn(const Params& p, int bid, int nb) {
    for (int r = 0;; ++r) {
        const int idx = (r & 1) ? ((r + 1) * nb - 1 - bid) : (r * nb + bid);
        if (r * nb >= 1024) break;
        if (idx < 1024) { const int qb = 31 - (idx >> 5), bh = idx & 31; attn_task(p, bh >> 3, bh & 7, qb); }
    }
}

constexpr int NPHASES = 19;
template <int PH>
__device__ __forceinline__ void run_phase(const Params& p, int bid, int nb) {
    unsigned char* ws = p.ws;
    const int tid = threadIdx.x;
    if constexpr (PH == 0) phase_prep(p, bid, nb);
    else if constexpr (PH == 1) phase_inproj(p, bid, nb);
    else if constexpr (PH == 2) phase_mixA(p, bid, nb);
    else if constexpr (PH == 3) phase_scan(p, bid, nb);
    else if constexpr (PH == 4) phase_mixB(p, bid, nb);
    else if constexpr (PH == 5) phase_gemm_residual(p, (const u16*)(ws + WS_Y), HY_OUT, (const u16*)(ws + WS_WOUTT), HY_OUT, p.x, p.out, bid, nb);
    else if constexpr (PH == 6) rmsnorm_rows(p.out, p.norm_ffn, (u16*)(ws + WS_H), bid, nb, tid);
    else if constexpr (PH == 7) phase_gemm_f32<DM, 2048>((const u16*)(ws + WS_H), (const u16*)(ws + WS_WPQT), (float*)(ws + WS_SCORES), bid, nb);
    else if constexpr (PH == 8) phase_topk(p, bid, nb);
    else if constexpr (PH == 9) phase_peer<0>(p, 0, p.norm_mix + DM, bid, nb);
    else if constexpr (PH == 10) phase_gemm_f32<DM, MLA_DOWN_PAD>((const u16*)(ws + WS_H), (const u16*)(ws + WS_WDOWNT), (float*)(ws + WS_DOWN), bid, nb);
    else if constexpr (PH == 11) phase_mla_norm(p, bid, nb);
    else if constexpr (PH == 12) phase_mla_up(p, bid, nb);
    else if constexpr (PH == 13) phase_attn(p, bid, nb);
    else if constexpr (PH == 14) phase_gemm_residual(p, (const u16*)(ws + WS_O), DM, (const u16*)(ws + WS_WMOT), DM, p.out, p.out, bid, nb);
    else if constexpr (PH == 15) rmsnorm_rows(p.out, p.norm_ffn + DM, (u16*)(ws + WS_H), bid, nb, tid);
    else if constexpr (PH == 16) phase_gemm_f32<DM, 2048>((const u16*)(ws + WS_H), (const u16*)(ws + WS_WPQT) + (size_t)2048 * DM, (float*)(ws + WS_SCORES), bid, nb);
    else if constexpr (PH == 17) phase_topk(p, bid, nb);
    else if constexpr (PH == 18) phase_peer<1>(p, 1, p.final_norm, bid, nb);
}
typedef const __attribute__((address_space(4))) unsigned long long* cptr64;
__device__ __forceinline__ void load_params(Params& r, cptr64 s) {
    unsigned long long* d = (unsigned long long*)&r;
#pragma unroll
    for (int i = 0; i < (int)(sizeof(Params) / 8); ++i) d[i] = s[i];
}
template <int PH>
__device__ __forceinline__ void run_from(cptr64 ka, cg::grid_group& grid) {
    {
        cptr64 q = ka; asm volatile("" : "+s"(q));
        Params lp; load_params(lp, q);
        run_phase<PH>(lp, (int)blockIdx.x, (int)gridDim.x);
    }
    if constexpr (PH + 1 < NPHASES) { grid.sync(); run_from<PH + 1>(ka, grid); }
}
__global__ void __launch_bounds__(NTHREADS, 2) k_mega(Params p_unused) {
    cg::grid_group grid = cg::this_grid();
    run_from<0>((cptr64)__builtin_amdgcn_kernarg_segment_ptr(), grid);
}

extern "C" void kernel_launch(void* const* d_in, const int* in_sizes, int n_in, void* d_out, int out_size, void* d_ws, size_t ws_size, hipStream_t stream) {
    if (n_in != 20 || out_size != T * DM || ws_size < WS_END) { fprintf(stderr, "kernel_launch: unexpected shapes (n_in %d out %d ws %zu need %zu)\n", n_in, out_size, ws_size, (size_t)WS_END); return; }
    static int grid_blocks = 0;
    if (!grid_blocks) {
        int dev = 0, cus = 0, per_cu = 0;
        (void)hipGetDevice(&dev);
        (void)hipDeviceGetAttribute(&cus, hipDeviceAttributeMultiprocessorCount, dev);
        if (hipFuncSetAttribute((const void*)k_mega, hipFuncAttributeMaxDynamicSharedMemorySize, LDS_BYTES) != hipSuccess) { fprintf(stderr, "kernel_launch: hipFuncSetAttribute failed\n"); return; }
        if (hipOccupancyMaxActiveBlocksPerMultiprocessor(&per_cu, (const void*)k_mega, NTHREADS, LDS_BYTES) != hipSuccess || per_cu < 1) { fprintf(stderr, "kernel_launch: occupancy query failed (%d)\n", per_cu); return; }
        if (per_cu > 2) per_cu = 2;
        grid_blocks = cus * per_cu;
        fprintf(stderr, "kernel_launch: %d CUs x %d blocks\n", cus, per_cu);
    }
    Params p{};
    const float** f = (const float**)&p;
    for (int i = 0; i < 20; ++i) f[i] = (const float*)d_in[i];
    p.out = (float*)d_out; p.ws = (unsigned char*)d_ws;
    void* args[] = {&p};
    hipError_t e = hipLaunchCooperativeKernel((const void*)k_mega, dim3(grid_blocks), dim3(NTHREADS), args, LDS_BYTES, stream);
    if (e != hipSuccess) fprintf(stderr, "cooperative launch failed: %s (grid %d)\n", hipGetErrorString(e), grid_blocks);
}
```

```cpp
#include <hip/hip_runtime.h>
#include <hip/hip_cooperative_groups.h>
#include <cstdint>
#include <cstdio>
namespace cg = cooperative_groups;

typedef unsigned short u16;
typedef short bf16x8 __attribute__((ext_vector_type(8)));
typedef float f32x16 __attribute__((ext_vector_type(16)));
typedef float f32x4 __attribute__((ext_vector_type(4)));
typedef float f32x2 __attribute__((ext_vector_type(2)));
typedef unsigned u32x4 __attribute__((ext_vector_type(4)));
typedef unsigned u32x2 __attribute__((ext_vector_type(2)));
typedef __bf16 bf16v2 __attribute__((ext_vector_type(2)));

constexpr int T = 16384, DM = 1024, SEQ = 4096;
constexpr int HY_IN = 5120, HY_OUT = 2048;
constexpr int MLA_DOWN = 704, MLA_DOWN_PAD = 768, MLA_QR = 384, MLA_KVR = 256;
constexpr int NEXP = 16384;
constexpr float EPS = 1e-6f;
constexpr int NTHREADS = 256;
constexpr int LDS_BYTES = 81920;

constexpr size_t al256(size_t x) { return (x + 255) & ~(size_t)255; }
constexpr size_t WS_WINT   = 0;
constexpr size_t WS_WOUTT  = WS_WINT   + (size_t)HY_IN * DM * 2;
constexpr size_t WS_WDOWNT = WS_WOUTT  + (size_t)DM * HY_OUT * 2;
constexpr size_t WS_WQUPT  = WS_WDOWNT + (size_t)MLA_DOWN_PAD * DM * 2;
constexpr size_t WS_WKVUPT = WS_WQUPT  + (size_t)1536 * MLA_QR * 2;
constexpr size_t WS_WMOT   = WS_WKVUPT + (size_t)2048 * MLA_KVR * 2;
constexpr size_t WS_WPQT   = WS_WMOT   + (size_t)DM * DM * 2;
constexpr size_t WS_ROPE_R = WS_WPQT   + (size_t)2 * 2048 * DM * 2;
constexpr size_t WS_ROPE_M = WS_ROPE_R + (size_t)SEQ * 64 * 8;
constexpr size_t WS_UBF    = WS_ROPE_M + (size_t)SEQ * 32 * 8;
constexpr size_t WS_VBF    = WS_UBF    + (size_t)2 * NEXP * DM * 2;
constexpr size_t WS_H      = WS_VBF    + (size_t)2 * NEXP * DM * 2;
constexpr size_t WS_PROJ   = WS_H      + (size_t)T * DM * 2;
constexpr size_t WS_Y      = WS_PROJ   + (size_t)T * HY_IN * 2;
constexpr size_t WS_SSQ    = WS_Y      + (size_t)T * HY_OUT * 2;
constexpr size_t WS_DST    = WS_SSQ    + (size_t)T * 8 * 4;
constexpr size_t WS_EXP    = WS_DST    + (size_t)512 * 256 * 128 * 4;
constexpr size_t WS_GATE   = WS_EXP    + (size_t)T * 128 * 2;
constexpr size_t WS_BAR    = WS_GATE   + (size_t)T * 128 * 4;
constexpr size_t WS_END    = WS_BAR    + 16384;
constexpr size_t WS_Q      = WS_PROJ;
constexpr size_t WS_KV     = WS_Q  + (size_t)T * 1536 * 2;
constexpr size_t WS_DOWN   = WS_KV + (size_t)T * 2048 * 2;
constexpr size_t WS_SCORES = WS_PROJ;
constexpr size_t WS_O      = WS_Y;
constexpr size_t WS_CQN    = WS_O    + (size_t)T * DM * 2;
constexpr size_t WS_CKVN   = WS_CQN  + (size_t)T * MLA_QR * 2;
constexpr size_t WS_KROPE  = WS_CKVN + (size_t)T * MLA_KVR * 2;
static_assert(WS_DOWN + (size_t)T * 768 * 4 <= WS_Y, "overlay");
static_assert(WS_KROPE + (size_t)T * 64 * 2 <= WS_SSQ, "overlay");

struct Params {
    const float *x, *norm_mix, *norm_ffn, *hy_w_in, *gm_v_norm, *gm_w_s, *gm_b_s, *ret_norm, *hy_w_out;
    const float *mla_w_down, *mla_q_norm, *mla_w_q_up, *mla_kv_norm, *mla_w_kv_up, *mla_w_out;
    const float *peer_w_q, *peer_sub_keys, *peer_u, *peer_v, *final_norm;
    float* out;
    unsigned char* ws;
};

extern __shared__ __attribute__((aligned(16))) unsigned char smem[];

__device__ __forceinline__ unsigned pk2(float lo, float hi) { unsigned r; asm volatile("v_cvt_pk_bf16_f32 %0, %1, %2" : "=v"(r) : "v"(lo), "v"(hi)); return r; }
__device__ __forceinline__ u16 f2bf(float f) { return (u16)(pk2(f, 0.f) & 0xffffu); }
__device__ __forceinline__ float bflo(unsigned u) { return __uint_as_float(u << 16); }
__device__ __forceinline__ float bfhi(unsigned u) { return __uint_as_float(u & 0xffff0000u); }
__device__ __forceinline__ float bf2f(u16 h) { return __uint_as_float((unsigned)h << 16); }
__device__ __forceinline__ u32x4 pack8(const float* v) { u32x4 w; w.x = pk2(v[0], v[1]); w.y = pk2(v[2], v[3]); w.z = pk2(v[4], v[5]); w.w = pk2(v[6], v[7]); return w; }
__device__ __forceinline__ void unpack8(u32x4 w, float* v) { v[0] = bflo(w.x); v[1] = bfhi(w.x); v[2] = bflo(w.y); v[3] = bfhi(w.y); v[4] = bflo(w.z); v[5] = bfhi(w.z); v[6] = bflo(w.w); v[7] = bfhi(w.w); }
__device__ __forceinline__ float gelu_f(float v) { return 0.5f * v * (1.0f + erff(v * 0.70710678118654752f)); }
__device__ __forceinline__ float silu_f(float v) { return v / (1.0f + __expf(-v)); }
__device__ __forceinline__ float wave_sum(float v) {
#pragma unroll
    for (int o = 32; o >= 1; o >>= 1) v += __shfl_xor(v, o);
    return v;
}

__device__ __forceinline__ int opaque(int v) { asm volatile("" : "+v"(v)); return v; }

__device__ __forceinline__ int toff(int r, int c8) { return r * 128 + ((c8 ^ ((r >> 1) & 7)) << 4); }
__device__ __forceinline__ int toff_e(int r, int k) { return toff(r, k >> 3) + (k & 7) * 2; }

template <int PT, int QT>
__device__ __forceinline__ void mma_kb(f32x16 (&acc)[PT][QT], int Ps, int prow0, int Qs, int qrow0, int lane) {
    const int lr = lane & 31, hi = lane >> 5;
#pragma unroll
    for (int s = 0; s < 4; ++s) {
        const int c8 = 2 * s + hi;
        bf16x8 a[PT], b[QT];
#pragma unroll
        for (int i = 0; i < PT; ++i) a[i] = *(const bf16x8*)(smem + Ps + toff(prow0 + i * 32 + lr, c8));
#pragma unroll
        for (int j = 0; j < QT; ++j) b[j] = *(const bf16x8*)(smem + Qs + toff(qrow0 + j * 32 + lr, c8));
#pragma unroll
        for (int i = 0; i < PT; ++i)
#pragma unroll
            for (int j = 0; j < QT; ++j) acc[i][j] = __builtin_amdgcn_mfma_f32_32x32x16_bf16(a[i], b[j], acc[i][j], 0, 0, 0);
    }
#pragma unroll
    for (int i = 0; i < PT; ++i)
#pragma unroll
        for (int j = 0; j < QT; ++j) asm volatile("" : "+v"(acc[i][j]));
}

template <int ROWS>
__device__ __forceinline__ void gload_nat(u32x4 (&r)[ROWS / 32], const u16* src, int ld, int tid) {
    tid = opaque(tid);
#pragma unroll
    for (int i = 0; i < ROWS / 32; ++i) { const int idx = tid + 256 * i, row = idx >> 3, c8 = idx & 7; r[i] = *(const u32x4*)(src + (size_t)row * ld + c8 * 8); }
}
template <int ROWS>
__device__ __forceinline__ void sstore_nat(int lds, const u32x4 (&r)[ROWS / 32], int tid) {
    tid = opaque(tid);
#pragma unroll
    for (int i = 0; i < ROWS / 32; ++i) { const int idx = tid + 256 * i, row = idx >> 3, c8 = idx & 7; *(u32x4*)(smem + lds + toff(row, c8)) = r[i]; }
}
template <int ROWS, bool SCALE>
__device__ __forceinline__ void load_tr(int lds, const u16* src, int ld, int tid, const float* kscale) {
    constexpr int CH = ROWS / 8;
    tid = opaque(tid);
#pragma unroll 2
    for (int i = 0; i < (64 * CH) / 256; ++i) {
        const int idx = tid + 256 * i, k = idx / CH, nc = idx % CH;
        const u32x4 v = *(const u32x4*)(src + (size_t)k * ld + nc * 8);
        const unsigned wd[4] = {v.x, v.y, v.z, v.w};
        float sc = 1.f; if (SCALE) sc = kscale[k];
#pragma unroll
        for (int e = 0; e < 8; ++e) {
            u16 h;
            if (SCALE) h = f2bf(((e & 1) ? bfhi(wd[e >> 1]) : bflo(wd[e >> 1])) * sc);
            else h = (u16)((e & 1) ? (wd[e >> 1] >> 16) : (wd[e >> 1] & 0xffffu));
            *(u16*)(smem + lds + toff_e(nc * 8 + e, k)) = h;
        }
    }
}

constexpr int CS_LD = 132;
__device__ __forceinline__ void stage_c22(const f32x16 (&acc)[2][2], int wm, int wn, int lane) {
    const int lr = lane & 31, hi = lane >> 5;
#pragma unroll
    for (int i = 0; i < 2; ++i)
#pragma unroll
        for (int j = 0; j < 2; ++j)
#pragma unroll
            for (int q = 0; q < 4; ++q) {
                const int n = wm * 64 + i * 32 + 8 * q + 4 * hi, m = wn * 64 + j * 32 + lr;
                f32x4 v = {acc[i][j][4 * q], acc[i][j][4 * q + 1], acc[i][j][4 * q + 2], acc[i][j][4 * q + 3]};
                *(f32x4*)(smem + (m * CS_LD + n) * 4) = v;
            }
}
__device__ __forceinline__ void cs_read8(int m, int c, float* v) {
    const f32x4 a = *(const f32x4*)(smem + (m * CS_LD + c) * 4), b = *(const f32x4*)(smem + (m * CS_LD + c + 4) * 4);
    v[0] = a[0]; v[1] = a[1]; v[2] = a[2]; v[3] = a[3]; v[4] = b[0]; v[5] = b[1]; v[6] = b[2]; v[7] = b[3];
}

template <class Epi>
__device__ __forceinline__ void gemm_tile(const u16* A, int lda, const u16* Bt, int ldb, int K, int m0, int n0, Epi&& epi) {
    const int tid = opaque((int)threadIdx.x), lane = tid & 63, w = tid >> 6, wm = w >> 1, wn = w & 1;
    f32x16 acc[2][2];
#pragma unroll
    for (int i = 0; i < 2; ++i)
#pragma unroll
        for (int j = 0; j < 2; ++j)
#pragma unroll
            for (int r = 0; r < 16; ++r) acc[i][j][r] = 0.f;
    const u16* Ap = A + (size_t)m0 * lda; const u16* Bp = Bt + (size_t)n0 * ldb;
    u32x4 ra[4], rb[4];
    gload_nat<128>(ra, Ap, lda, tid); gload_nat<128>(rb, Bp, ldb, tid);
    const int nk = K >> 6;
    for (int kb = 0; kb < nk; ++kb) {
        const int buf = (kb & 1) * 32768;
        sstore_nat<128>(buf, rb, tid); sstore_nat<128>(buf + 16384, ra, tid);
        __syncthreads();
        if (kb + 1 < nk) { gload_nat<128>(ra, Ap + (kb + 1) * 64, lda, tid); gload_nat<128>(rb, Bp + (kb + 1) * 64, ldb, tid); }
        mma_kb<2, 2>(acc, buf, wm * 64, buf + 16384, wn * 64, lane);
    }
    __syncthreads();
    stage_c22(acc, wm, wn, lane);
    __syncthreads();
    epi(m0, n0);
    __syncthreads();
}

__device__ __forceinline__ void convT_tile(const float* W, int K, int N, u16* Wt, int kt, int nt, int tid) {
    u16* tile = (u16*)smem;
    __syncthreads();
#pragma unroll
    for (int i = 0; i < 16; ++i) {
        const int k = i * 4 + (tid >> 6), n = tid & 63, gn = nt * 64 + n;
        const float v = (gn < N) ? W[(size_t)(kt * 64 + k) * N + gn] : 0.f;
        tile[n * 72 + k] = f2bf(v);
    }
    __syncthreads();
    const int n = tid >> 2, kc = (tid & 3) * 16;
    const u32x4 a = *(const u32x4*)(tile + n * 72 + kc), b = *(const u32x4*)(tile + n * 72 + kc + 8);
    u16* dst = Wt + (size_t)(nt * 64 + n) * K + kt * 64 + kc;
    *(u32x4*)dst = a; *(u32x4*)(dst + 8) = b;
}
__device__ __forceinline__ void convT_all(const float* W, int K, int N, int Npad, u16* Wt, int bid, int nb, int tid) {
    const int nkt = K / 64, nnt = Npad / 64;
    for (int j = bid; j < nkt * nnt; j += nb) convT_tile(W, K, N, Wt, j % nkt, j / nkt, tid);
}
__device__ __forceinline__ void rmsnorm_rows(const float* X, const float* g, u16* H, int bid, int nb, int tid) {
    const int lane = tid & 63, w = tid >> 6;
    for (int row = bid * 4 + w; row < T; row += nb * 4) {
        const float* xr = X + (size_t)row * DM;
        f32x4 v[4]; float ss = 0.f;
#pragma unroll
        for (int c = 0; c < 4; ++c) { v[c] = *(const f32x4*)(xr + c * 256 + lane * 4); ss += v[c][0] * v[c][0] + v[c][1] * v[c][1] + v[c][2] * v[c][2] + v[c][3] * v[c][3]; }
        ss = wave_sum(ss);
        const float r = rsqrtf(ss * (1.0f / DM) + EPS);
#pragma unroll
        for (int c = 0; c < 4; ++c) {
            const f32x4 gg = *(const f32x4*)(g + c * 256 + lane * 4);
            u32x2 o; o.x = pk2(v[c][0] * r * gg[0], v[c][1] * r * gg[1]); o.y = pk2(v[c][2] * r * gg[2], v[c][3] * r * gg[3]);
            *(u32x2*)(H + (size_t)row * DM + c * 256 + lane * 4) = o;
        }
    }
}
__device__ __forceinline__ void phase_prep(const Params& p, int bid, int nb) {
    const int tid = threadIdx.x;
    unsigned char* ws = p.ws;
    convT_all(p.hy_w_in, DM, HY_IN, HY_IN, (u16*)(ws + WS_WINT), bid, nb, tid);
    convT_all(p.hy_w_out, HY_OUT, DM, DM, (u16*)(ws + WS_WOUTT), bid, nb, tid);
    convT_all(p.mla_w_down, DM, MLA_DOWN, MLA_DOWN_PAD, (u16*)(ws + WS_WDOWNT), bid, nb, tid);
    convT_all(p.mla_w_q_up, MLA_QR, 1536, 1536, (u16*)(ws + WS_WQUPT), bid, nb, tid);
    convT_all(p.mla_w_kv_up, MLA_KVR, 2048, 2048, (u16*)(ws + WS_WKVUPT), bid, nb, tid);
    convT_all(p.mla_w_out, DM, DM, DM, (u16*)(ws + WS_WMOT), bid, nb, tid);
    __syncthreads();
    {
        float* Wq_s = (float*)smem; float* key_s = (float*)(smem + 64 * 129 * 4);
        for (int j = bid; j < 2 * 16 * 16 * 2; j += nb) {
            const int kh = j & 1, kt = (j >> 1) & 15, hp = (j >> 5) & 15, L = j >> 9;
            const float* Wq = p.peer_w_q + (size_t)L * DM * 2048 + (size_t)(kt * 64) * 2048 + hp * 128;
            const float* ky = p.peer_sub_keys + (size_t)L * 2 * 128 * 128 + (size_t)(hp & 1) * 128 * 128 + (size_t)(kh * 64) * 128;
            __syncthreads();
#pragma unroll 4
            for (int i = 0; i < 32; ++i) { const int idx = tid + 256 * i, row = idx >> 7, d = idx & 127; Wq_s[row * 129 + d] = Wq[(size_t)row * 2048 + d]; key_s[row * 129 + d] = ky[row * 128 + d]; }
            __syncthreads();
            const int tk = tid & 15, tkey = tid >> 4;
            float acc[4][4];
#pragma unroll
            for (int a = 0; a < 4; ++a)
#pragma unroll
                for (int b = 0; b < 4; ++b) acc[a][b] = 0.f;
            for (int d = 0; d < 128; ++d) {
                float wv[4], kv[4];
#pragma unroll
                for (int a = 0; a < 4; ++a) { wv[a] = Wq_s[(tk * 4 + a) * 129 + d]; kv[a] = key_s[(tkey * 4 + a) * 129 + d]; }
#pragma unroll
                for (int a = 0; a < 4; ++a)
#pragma unroll
                    for (int b = 0; b < 4; ++b) acc[a][b] += kv[a] * wv[b];
            }
            u16* dst = (u16*)(ws + WS_WPQT) + (size_t)L * 2048 * DM;
#pragma unroll
            for (int a = 0; a < 4; ++a) {
                u32x2 o; o.x = pk2(acc[a][0], acc[a][1]); o.y = pk2(acc[a][2], acc[a][3]);
                *(u32x2*)(dst + (size_t)(hp * 128 + kh * 64 + tkey * 4 + a) * DM + kt * 64 + tk * 4) = o;
            }
        }
    }
    {
        const size_t n8 = (size_t)2 * NEXP * DM / 8;
        for (int tb = 0; tb < 2; ++tb) {
            const float* src = tb ? p.peer_v : p.peer_u; u16* dst = (u16*)(ws + (tb ? WS_VBF : WS_UBF));
            for (size_t i = (size_t)bid * 256 + tid; i < n8; i += (size_t)nb * 256) {
                const f32x4 a = *(const f32x4*)(src + i * 8), b = *(const f32x4*)(src + i * 8 + 4);
                u32x4 o; o.x = pk2(a[0], a[1]); o.y = pk2(a[2], a[3]); o.z = pk2(b[0], b[1]); o.w = pk2(b[2], b[3]);
                *(u32x4*)(dst + i * 8) = o;
            }
        }
    }
    {
        f32x2* rr = (f32x2*)(ws + WS_ROPE_R); f32x2* rm = (f32x2*)(ws + WS_ROPE_M);
        for (int i = bid * 256 + tid; i < SEQ * 64; i += nb * 256) {
            const int s = i >> 6, d = i & 63; const float inv = 1.0f / powf(10000.0f, (float)d / 64.0f); const float ang = (float)s * inv;
            float sn, cs; sincosf(ang, &sn, &cs); rr[i] = (f32x2){cs, sn};
        }
        for (int i = bid * 256 + tid; i < SEQ * 32; i += nb * 256) {
            const int s = i >> 5, d = i & 31; const float inv = 1.0f / powf(10000.0f, (float)d / 32.0f); const float ang = (float)s * inv;
            float sn, cs; sincosf(ang, &sn, &cs); rm[i] = (f32x2){cs, sn};
        }
    }
    rmsnorm_rows(p.x, p.norm_mix, (u16*)(ws + WS_H), bid, nb, tid);
}

__device__ __forceinline__ void phase_inproj(const Params& p, int bid, int nb) {
    unsigned char* ws = p.ws;
    const u16* A = (const u16*)(ws + WS_H); const u16* Bt = (const u16*)(ws + WS_WINT);
    u16* proj = (u16*)(ws + WS_PROJ); float* ssq = (float*)(ws + WS_SSQ); const f32x2* rope = (const f32x2*)(ws + WS_ROPE_R);
    const int tid = threadIdx.x;
    constexpr int NT = HY_IN / 128;
    for (int t = bid; t < (T / 128) * NT; t += nb) {
        const int mt = t / NT, nt = t % NT;
        gemm_tile(A, DM, Bt, DM, DM, mt * 128, nt * 128, [&](int m0, int n0) {
            if (n0 >= 2048 && n0 < 3072) {
                const float sc = (n0 >= 2560) ? 0.08838834764831845f : 1.0f;
#pragma unroll
                for (int ps = 0; ps < 4; ++ps) {
                    const int m = ps * 32 + (tid >> 3), c = (tid & 7) * 8;
                    float x1[8], x2[8], y1[8], y2[8]; cs_read8(m, c, x1); cs_read8(m, c + 64, x2);
                    const f32x2* rp = rope + (size_t)((m0 + m) & (SEQ - 1)) * 64 + c;
#pragma unroll
                    for (int e = 0; e < 8; ++e) { const f32x2 cssn = rp[e]; y1[e] = (x1[e] * cssn[0] - x2[e] * cssn[1]) * sc; y2[e] = (x1[e] * cssn[1] + x2[e] * cssn[0]) * sc; }
                    u16* dst = proj + (size_t)(m0 + m) * HY_IN + n0 + c;
                    *(u32x4*)dst = pack8(y1); *(u32x4*)(dst + 64) = pack8(y2);
                }
            } else {
                const int mode = (n0 < 2048) ? 0 : ((n0 < 4096) ? 1 : 2);
#pragma unroll
                for (int ps = 0; ps < 8; ++ps) {
                    const int m = ps * 16 + (tid >> 4), c = (tid & 15) * 8;
                    float v[8]; cs_read8(m, c, v);
                    if (mode == 0) {
#pragma unroll
                        for (int e = 0; e < 8; ++e) v[e] = gelu_f(v[e]);
                        if (n0 >= 1024) {
                            float s = 0.f;
#pragma unroll
                            for (int e = 0; e < 8; ++e) s += v[e] * v[e];
                            s += __shfl_xor(s, 1); s += __shfl_xor(s, 2); s += __shfl_xor(s, 4); s += __shfl_xor(s, 8);
                            if ((tid & 15) == 0) ssq[(size_t)(m0 + m) * 8 + ((n0 - 1024) >> 7)] = s;
                        }
                    } else if (mode == 2) {
#pragma unroll
                        for (int e = 0; e < 8; ++e) v[e] = silu_f(v[e]);
                    }
                    *(u32x4*)(proj + (size_t)(m0 + m) * HY_IN + n0 + c) = pack8(v);
                }
            }
        });
    }
}

__device__ __forceinline__ float ret_log2gamma(int h) { return log2f(1.0f - exp2f(-5.0f - (float)h)); }
constexpr int YS_LD = 264;
__device__ __forceinline__ void zero4(f32x16 (&acc)[4][1]) {
#pragma unroll
    for (int i = 0; i < 4; ++i)
#pragma unroll
        for (int r = 0; r < 16; ++r) acc[i][0][r] = 0.f;
}

__device__ __forceinline__ void gmlp_task(const Params& p, int ci, int g, int dh) {
    unsigned char* ws = p.ws;
    const int tid = opaque((int)threadIdx.x), lane = tid & 63, w = tid >> 6, lr = lane & 31, hi = lane >> 5;
    const int m0 = ci * 128, col0 = g * 256 + dh * 128;
    const u16* proj = (const u16*)(ws + WS_PROJ); const float* ssq = (const float*)(ws + WS_SSQ);
    float* r_s = (float*)(smem + 49152);
    __syncthreads();
    if (tid < 128) { const float s = ssq[(size_t)(m0 + tid) * 8 + 2 * g] + ssq[(size_t)(m0 + tid) * 8 + 2 * g + 1]; r_s[tid] = rsqrtf(s * (1.0f / 256.0f) + EPS); }
    f32x16 acc[4][1]; zero4(acc);
    const float* Wg = p.gm_w_s + (size_t)g * 128 * 128;
    for (int kb = 0; kb < 2; ++kb) {
        __syncthreads();
        load_tr<128, false>(0, proj + (size_t)(m0 + kb * 64) * HY_IN + 1024 + col0, HY_IN, tid, nullptr);
#pragma unroll 2
        for (int i = 0; i < 8; ++i) {
            const int idx = tid + 256 * i, t = idx >> 4, c4 = idx & 15, s0 = kb * 64 + c4 * 4;
            const f32x4 wv = *(const f32x4*)(Wg + t * 128 + s0);
            float o[4];
#pragma unroll
            for (int e = 0; e < 4; ++e) o[e] = (s0 + e <= t) ? wv[e] * r_s[s0 + e] : 0.f;
            u32x2 pk; pk.x = pk2(o[0], o[1]); pk.y = pk2(o[2], o[3]);
            *(u32x2*)(smem + 16384 + toff_e(t, c4 * 4)) = pk;
        }
        __syncthreads();
        mma_kb<4, 1>(acc, 0, 0, 16384, w * 32, lane);
    }
    __syncthreads();
    const int t = w * 32 + lr;
    const float bs = p.gm_b_s[g * 128 + t];
    u16* Ys = (u16*)smem;
#pragma unroll
    for (int i = 0; i < 4; ++i)
#pragma unroll
        for (int q = 0; q < 4; ++q) {
            const int d = i * 32 + 8 * q + 4 * hi;
            const f32x4 gn = *(const f32x4*)(p.gm_v_norm + col0 + d);
            u32x2 pk; pk.x = pk2(acc[i][0][4 * q] * gn[0] + bs, acc[i][0][4 * q + 1] * gn[1] + bs); pk.y = pk2(acc[i][0][4 * q + 2] * gn[2] + bs, acc[i][0][4 * q + 3] * gn[3] + bs);
            *(u32x2*)(Ys + t * YS_LD + d) = pk;
        }
    __syncthreads();
    u16* y = (u16*)(ws + WS_Y);
#pragma unroll
    for (int ps = 0; ps < 8; ++ps) {
        const int tt = ps * 16 + (tid >> 4), c = (tid & 15) * 8;
        float mv[8], uv[8]; unpack8(*(const u32x4*)(Ys + tt * YS_LD + c), mv); unpack8(*(const u32x4*)(proj + (size_t)(m0 + tt) * HY_IN + col0 + c), uv);
#pragma unroll
        for (int e = 0; e < 8; ++e) mv[e] *= uv[e];
        *(u32x4*)(y + (size_t)(m0 + tt) * HY_OUT + col0 + c) = pack8(mv);
    }
}

__device__ __forceinline__ void ret_ds_task(const Params& p, int ci, int h, int eh) {
    unsigned char* ws = p.ws;
    const int tid = opaque((int)threadIdx.x), lane = tid & 63, w = tid >> 6, lr = lane & 31, hi = lane >> 5;
    const int m0 = ci * 128;
    const u16* proj = (const u16*)(ws + WS_PROJ);
    float* kd_s = (float*)(smem + 49152);
    const float l2g = ret_log2gamma(h);
    __syncthreads();
    if (tid < 128) kd_s[tid] = exp2f((float)(127 - tid) * l2g);
    f32x16 acc[4][1]; zero4(acc);
    for (int kb = 0; kb < 2; ++kb) {
        __syncthreads();
        load_tr<128, false>(0, proj + (size_t)(m0 + kb * 64) * HY_IN + 2560 + h * 128, HY_IN, tid, nullptr);
        load_tr<128, true>(16384, proj + (size_t)(m0 + kb * 64) * HY_IN + 3072 + h * 256 + eh * 128, HY_IN, tid, kd_s + kb * 64);
        __syncthreads();
        mma_kb<4, 1>(acc, 0, 0, 16384, w * 32, lane);
    }
    float* dst = (float*)(ws + WS_DST) + (size_t)(ci * 4 + h) * 256 * 128;
#pragma unroll
    for (int i = 0; i < 4; ++i)
#pragma unroll
        for (int q = 0; q < 4; ++q) {
            const int d = i * 32 + 8 * q + 4 * hi, e = eh * 128 + w * 32 + lr;
            f32x4 v = {acc[i][0][4 * q], acc[i][0][4 * q + 1], acc[i][0][4 * q + 2], acc[i][0][4 * q + 3]};
            *(f32x4*)(dst + (size_t)e * 128 + d) = v;
        }
}

__device__ __forceinline__ void phase_mixA(const Params& p, int bid, int nb) {
    for (int t = bid; t < 2048; t += nb) {
        const int ci = t >> 4, sub = t & 15;
        if (sub < 8) gmlp_task(p, ci, sub >> 1, sub & 1); else ret_ds_task(p, ci, (sub - 8) >> 1, sub & 1);
    }
}

__device__ __forceinline__ void phase_scan(const Params& p, int bid, int nb) {
    float* base = (float*)(p.ws + WS_DST);
    for (int i = bid * 256 + threadIdx.x; i < 4 * 4 * 256 * 128 / 4; i += nb * 256) {
        const int b = i >> 15, h = (i >> 13) & 3, rest = i & 8191;
        const float cd = exp2f(128.0f * ret_log2gamma(h));
        f32x4 s = {0.f, 0.f, 0.f, 0.f};
        float* ptr = base + ((size_t)(b * 32) * 4 + h) * 32768 + (size_t)rest * 4;
#pragma unroll 8
        for (int n = 0; n < 32; ++n) {
            f32x4* q = (f32x4*)(ptr + (size_t)n * 4 * 32768);
            const f32x4 tmp = *q; *q = s; s = s * cd + tmp;
        }
    }
}

__device__ __forceinline__ void ret_out_task(const Params& p, int ci, int h) {
    unsigned char* ws = p.ws;
    const int tid = opaque((int)threadIdx.x), lane = tid & 63, w = tid >> 6, lr = lane & 31, hi = lane >> 5;
    const int m0 = ci * 128;
    const u16* proj = (const u16*)(ws + WS_PROJ);
    const float l2g = ret_log2gamma(h);
    const int qi = w * 32 + lr;
    constexpr int RA = 0, RB = 16384, RC = 49152;
    __syncthreads();
    {
        u32x4 r0[4], r1[4];
        const u16* qp = proj + (size_t)m0 * HY_IN + 2048 + h * 128; const u16* kp = proj + (size_t)m0 * HY_IN + 2560 + h * 128;
        gload_nat<128>(r0, qp, HY_IN, tid); gload_nat<128>(r1, qp + 64, HY_IN, tid);
        sstore_nat<128>(RC, r0, tid); sstore_nat<128>(RC + 16384, r1, tid);
        gload_nat<128>(r0, kp, HY_IN, tid); gload_nat<128>(r1, kp + 64, HY_IN, tid);
        sstore_nat<128>(RB, r0, tid); sstore_nat<128>(RB + 16384, r1, tid);
    }
    __syncthreads();
    {
        f32x16 sc[4][1]; zero4(sc);
        mma_kb<4, 1>(sc, RB, 0, RC, w * 32, lane);
        mma_kb<4, 1>(sc, RB + 16384, 0, RC + 16384, w * 32, lane);
        __syncthreads();
#pragma unroll
        for (int i = 0; i < 4; ++i)
#pragma unroll
            for (int q = 0; q < 4; ++q) {
                const int j = i * 32 + 8 * q + 4 * hi;
                float o[4];
#pragma unroll
                for (int e = 0; e < 4; ++e) { const int df = qi - (j + e); o[e] = (df >= 0) ? sc[i][0][4 * q + e] * exp2f((float)df * l2g) : 0.f; }
                u32x2 pk; pk.x = pk2(o[0], o[1]); pk.y = pk2(o[2], o[3]);
                *(u32x2*)(smem + RB + (j >> 6) * 16384 + toff_e(qi, j & 63)) = pk;
            }
#pragma unroll 2
        for (int i = 0; i < 8; ++i) {
            const int idx = tid + 256 * i, row = idx >> 4, c16 = idx & 15;
            unsigned char* ptr = smem + RC + (c16 >> 3) * 16384 + toff(row, c16 & 7);
            float f[8]; unpack8(*(const u32x4*)ptr, f);
            const float qd = exp2f((float)(row + 1) * l2g);
#pragma unroll
            for (int e = 0; e < 8; ++e) f[e] *= qd;
            *(u32x4*)ptr = pack8(f);
        }
    }
    const float* st = (const float*)(ws + WS_DST) + (size_t)(ci * 4 + h) * 256 * 128;
    float ssq = 0.f;
    u16* ytmp = (u16*)(ws + WS_Y) + (size_t)(m0 + qi) * HY_OUT + 1024 + h * 256;
    f32x16 acc[4][1];
#pragma unroll
    for (int eh = 0; eh < 2; ++eh) {
        zero4(acc);
        for (int kb = 0; kb < 4; ++kb) {
            __syncthreads();
            if (kb < 2) {
                load_tr<128, false>(RA, proj + (size_t)(m0 + kb * 64) * HY_IN + 3072 + h * 256 + eh * 128, HY_IN, tid, nullptr);
            } else {
                const int d0 = (kb - 2) * 64, tq = opaque(tid);
#pragma unroll 2
                for (int i = 0; i < 8; ++i) {
                    const int idx = tq + 256 * i, row = idx >> 4, c4 = idx & 15;
                    const f32x4 v = *(const f32x4*)(st + (size_t)(eh * 128 + row) * 128 + d0 + c4 * 4);
                    u32x2 pk; pk.x = pk2(v[0], v[1]); pk.y = pk2(v[2], v[3]);
                    *(u32x2*)(smem + RA + toff_e(row, c4 * 4)) = pk;
                }
            }
            __syncthreads();
            mma_kb<4, 1>(acc, RA, 0, (kb < 2) ? (RB + kb * 16384) : (RC + (kb - 2) * 16384), w * 32, lane);
        }
#pragma unroll
        for (int i = 0; i < 4; ++i)
#pragma unroll
            for (int r = 0; r < 16; ++r) ssq += acc[i][0][r] * acc[i][0][r];
        if (eh == 0) {
#pragma unroll
            for (int i = 0; i < 4; ++i)
#pragma unroll
                for (int q = 0; q < 4; ++q) {
                    u32x2 pk; pk.x = pk2(acc[i][0][4 * q], acc[i][0][4 * q + 1]); pk.y = pk2(acc[i][0][4 * q + 2], acc[i][0][4 * q + 3]);
                    *(u32x2*)(ytmp + i * 32 + 8 * q + 4 * hi) = pk;
                }
        }
    }
    ssq += __shfl_xor(ssq, 32);
    const float rn = rsqrtf(ssq * (1.0f / 256.0f) + EPS);
    __syncthreads();
    u16* Ys = (u16*)smem;
#pragma unroll
    for (int i = 0; i < 4; ++i)
#pragma unroll
        for (int q = 0; q < 4; ++q) {
            const int e = i * 32 + 8 * q + 4 * hi;
            const f32x4 g0 = *(const f32x4*)(p.ret_norm + h * 256 + e), g1 = *(const f32x4*)(p.ret_norm + h * 256 + 128 + e);
            u32x2 pk; const u32x2 z = *(const u32x2*)(ytmp + e);
            pk.x = pk2(bflo(z.x) * rn * g0[0], bfhi(z.x) * rn * g0[1]); pk.y = pk2(bflo(z.y) * rn * g0[2], bfhi(z.y) * rn * g0[3]);
            *(u32x2*)(Ys + qi * YS_LD + e) = pk;
            pk.x = pk2(acc[i][0][4 * q] * rn * g1[0], acc[i][0][4 * q + 1] * rn * g1[1]); pk.y = pk2(acc[i][0][4 * q + 2] * rn * g1[2], acc[i][0][4 * q + 3] * rn * g1[3]);
            *(u32x2*)(Ys + qi * YS_LD + 128 + e) = pk;
        }
    __syncthreads();
    u16* y = (u16*)(ws + WS_Y);
#pragma unroll 4
    for (int ps = 0; ps < 16; ++ps) {
        const int tt = ps * 8 + (tid >> 5), c = (tid & 31) * 8;
        float mv[8], gv[8]; unpack8(*(const u32x4*)(Ys + tt * YS_LD + c), mv); unpack8(*(const u32x4*)(proj + (size_t)(m0 + tt) * HY_IN + 4096 + h * 256 + c), gv);
#pragma unroll
        for (int e = 0; e < 8; ++e) mv[e] *= gv[e];
        *(u32x4*)(y + (size_t)(m0 + tt) * HY_OUT + 1024 + h * 256 + c) = pack8(mv);
    }
}
__device__ __forceinline__ void phase_mixB(const Params& p, int bid, int nb) {
    for (int t = bid; t < 512; t += nb) ret_out_task(p, t >> 2, t & 3);
}

__device__ __forceinline__ void phase_gemm_residual(const Params& p, const u16* A, int lda, const u16* Bt, int K, const float* xsrc, float* xdst, int bid, int nb) {
    const int tid = threadIdx.x;
    constexpr int NT = DM / 128;
    for (int t = bid; t < (T / 128) * NT; t += nb) {
        const int mt = t / NT, nt = t % NT;
        gemm_tile(A, lda, Bt, K, K, mt * 128, nt * 128, [&](int m0, int n0) {
#pragma unroll
            for (int ps = 0; ps < 8; ++ps) {
                const int m = ps * 16 + (tid >> 4), c = (tid & 15) * 8;
                float v[8]; cs_read8(m, c, v);
                const size_t o = (size_t)(m0 + m) * DM + n0 + c;
                const f32x4 a = *(const f32x4*)(xsrc + o), b = *(const f32x4*)(xsrc + o + 4);
                f32x4 ra = {a[0] + v[0], a[1] + v[1], a[2] + v[2], a[3] + v[3]}, rb = {b[0] + v[4], b[1] + v[5], b[2] + v[6], b[3] + v[7]};
                *(f32x4*)(xdst + o) = ra; *(f32x4*)(xdst + o + 4) = rb;
            }
        });
    }
}
template <int K, int N>
__device__ __forceinline__ void phase_gemm_f32(const u16* A, const u16* Bt, float* C, int bid, int nb) {
    const int tid = threadIdx.x;
    constexpr int NT = N / 128, lda = K, ldc = N;
    for (int t = bid; t < (T / 128) * NT; t += nb) {
        const int mt = t / NT, nt = t % NT;
        gemm_tile(A, lda, Bt, K, K, mt * 128, nt * 128, [&](int m0, int n0) {
#pragma unroll
            for (int ps = 0; ps < 8; ++ps) {
                const int m = ps * 16 + (tid >> 4), c = (tid & 15) * 8;
                float v[8]; cs_read8(m, c, v);
                const size_t o = (size_t)(m0 + m) * ldc + n0 + c;
                f32x4 ra = {v[0], v[1], v[2], v[3]}, rb = {v[4], v[5], v[6], v[7]};
                *(f32x4*)(C + o) = ra; *(f32x4*)(C + o + 4) = rb;
            }
        });
    }
}

__device__ __forceinline__ void ins16(float (&L)[16], float e) {
#pragma unroll
    for (int i = 0; i < 16; ++i) { const float hi = fmaxf(L[i], e); e = fminf(L[i], e); L[i] = hi; }
}
__device__ __forceinline__ void phase_topk(const Params& p, int bid, int nb) {
    const int tid = threadIdx.x;
    const float* scores = (const float*)(p.ws + WS_SCORES);
    u16* experts = (u16*)(p.ws + WS_EXP); float* gates = (float*)(p.ws + WS_GATE);
    unsigned* la = (unsigned*)smem;
    for (int base = bid * 256; base < T * 8; base += nb * 256) {
        const int th = base + tid;
        const float* sp = scores + (size_t)th * 256;
        float a[16], b[16];
#pragma unroll
        for (int i = 0; i < 16; ++i) { a[i] = -INFINITY; b[i] = -INFINITY; }
        for (int k4 = 0; k4 < 32; ++k4) {
            const f32x4 v = *(const f32x4*)(sp + k4 * 4); const f32x4 u = *(const f32x4*)(sp + 128 + k4 * 4);
#pragma unroll
            for (int e = 0; e < 4; ++e) {
                ins16(a, __uint_as_float((__float_as_uint(v[e]) & ~127u) | (unsigned)(k4 * 4 + e)));
                ins16(b, __uint_as_float((__float_as_uint(u[e]) & ~127u) | (unsigned)(k4 * 4 + e)));
            }
        }
        __syncthreads();
#pragma unroll
        for (int i = 0; i < 16; ++i) { la[i * 256 + tid] = __float_as_uint(a[i]); la[(16 + i) * 256 + tid] = __float_as_uint(b[i]); }
        float c[16];
#pragma unroll
        for (int i = 0; i < 16; ++i) c[i] = -INFINITY;
#pragma unroll
        for (int i = 0; i < 16; ++i)
#pragma unroll
            for (int j = 0; j < 16; ++j)
                if ((i + 1) * (j + 1) <= 16) {
                    const float s = __uint_as_float(__float_as_uint(a[i]) & ~127u) + __uint_as_float(__float_as_uint(b[j]) & ~127u);
                    ins16(c, __uint_as_float((__float_as_uint(s) & ~255u) | (unsigned)(i * 16 + j)));
                }
        float bs[16]; unsigned ex[16]; float mx = -INFINITY;
#pragma unroll
        for (int k = 0; k < 16; ++k) {
            const unsigned code = __float_as_uint(c[k]) & 255u;
            const unsigned av = la[(code >> 4) * 256 + tid], bv = la[(16 + (code & 15)) * 256 + tid];
            bs[k] = __uint_as_float(av & ~127u) + __uint_as_float(bv & ~127u);
            ex[k] = (av & 127u) * 128u + (bv & 127u);
            mx = fmaxf(mx, bs[k]);
        }
        float sum = 0.f;
#pragma unroll
        for (int k = 0; k < 16; ++k) { bs[k] = __expf(bs[k] - mx); sum += bs[k]; }
        const float inv = 1.0f / sum;
        u32x4 e0, e1;
        e0.x = ex[0] | (ex[1] << 16); e0.y = ex[2] | (ex[3] << 16); e0.z = ex[4] | (ex[5] << 16); e0.w = ex[6] | (ex[7] << 16);
        e1.x = ex[8] | (ex[9] << 16); e1.y = ex[10] | (ex[11] << 16); e1.z = ex[12] | (ex[13] << 16); e1.w = ex[14] | (ex[15] << 16);
        *(u32x4*)(experts + (size_t)th * 16) = e0; *(u32x4*)(experts + (size_t)th * 16 + 8) = e1;
#pragma unroll
        for (int k4 = 0; k4 < 4; ++k4) { f32x4 g = {bs[4 * k4] * inv, bs[4 * k4 + 1] * inv, bs[4 * k4 + 2] * inv, bs[4 * k4 + 3] * inv}; *(f32x4*)(gates + (size_t)th * 16 + k4 * 4) = g; }
        __syncthreads();
    }
}

template <int MODE>
__device__ __forceinline__ void phase_peer(const Params& p, int L, const float* gnext, int bid, int nb) {
    const int tid = threadIdx.x, lane = tid & 63, w = tid >> 6;
    const u16* H = (const u16*)(p.ws + WS_H);
    const u16* U = (const u16*)(p.ws + WS_UBF) + (size_t)L * NEXP * DM; const u16* V = (const u16*)(p.ws + WS_VBF) + (size_t)L * NEXP * DM;
    const u16* experts = (const u16*)(p.ws + WS_EXP); const float* gates = (const float*)(p.ws + WS_GATE);
    for (int t = bid * 4 + w; t < T; t += nb * 4) {
        float xh[16];
        { const u16* hp = H + (size_t)t * DM + lane * 8; unpack8(*(const u32x4*)hp, xh); unpack8(*(const u32x4*)(hp + 512), xh + 8); }
        const unsigned e_lo = experts[(size_t)t * 128 + lane], e_hi = experts[(size_t)t * 128 + 64 + lane];
        const float g_lo = gates[(size_t)t * 128 + lane], g_hi = gates[(size_t)t * 128 + 64 + lane];
        float w_lo = 0.f, w_hi = 0.f;
#pragma unroll 1
        for (int eb = 0; eb < 128; eb += 8) {
            u32x4 r[8][2];
#pragma unroll
            for (int k = 0; k < 8; ++k) {
                const int e = eb + k;
                const unsigned ex = __builtin_amdgcn_readlane((e < 64) ? e_lo : e_hi, e & 63);
                const u16* up = U + (size_t)ex * DM + lane * 8;
                r[k][0] = *(const u32x4*)up; r[k][1] = *(const u32x4*)(up + 512);
            }
#pragma unroll
            for (int k = 0; k < 8; ++k) {
                float f[16]; unpack8(r[k][0], f); unpack8(r[k][1], f + 8);
                float d = 0.f;
#pragma unroll
                for (int i = 0; i < 16; ++i) d += f[i] * xh[i];
                d = wave_sum(d);
                const int e = eb + k;
                const float a = gelu_f(d);
                if (e < 64) { if (lane == e) w_lo = a * g_lo; } else { if (lane == e - 64) w_hi = a * g_hi; }
            }
        }
        float o[16];
#pragma unroll
        for (int i = 0; i < 16; ++i) o[i] = 0.f;
#pragma unroll 1
        for (int eb = 0; eb < 128; eb += 8) {
            u32x4 r[8][2]; float wv[8];
#pragma unroll
            for (int k = 0; k < 8; ++k) {
                const int e = eb + k;
                const unsigned ex = __builtin_amdgcn_readlane((e < 64) ? e_lo : e_hi, e & 63);
                wv[k] = __uint_as_float(__builtin_amdgcn_readlane(__float_as_uint((e < 64) ? w_lo : w_hi), e & 63));
                const u16* vp = V + (size_t)ex * DM + lane * 8;
                r[k][0] = *(const u32x4*)vp; r[k][1] = *(const u32x4*)(vp + 512);
            }
#pragma unroll
            for (int k = 0; k < 8; ++k) {
                float f[16]; unpack8(r[k][0], f); unpack8(r[k][1], f + 8);
#pragma unroll
                for (int i = 0; i < 16; ++i) o[i] += wv[k] * f[i];
            }
        }
        float* xr = p.out + (size_t)t * DM + lane * 8;
        float xv[16];
        { const f32x4 a = *(const f32x4*)xr, b = *(const f32x4*)(xr + 4), c = *(const f32x4*)(xr + 512), d = *(const f32x4*)(xr + 516);
          xv[0] = a[0]; xv[1] = a[1]; xv[2] = a[2]; xv[3] = a[3]; xv[4] = b[0]; xv[5] = b[1]; xv[6] = b[2]; xv[7] = b[3];
          xv[8] = c[0]; xv[9] = c[1]; xv[10] = c[2]; xv[11] = c[3]; xv[12] = d[0]; xv[13] = d[1]; xv[14] = d[2]; xv[15] = d[3]; }
        float ss = 0.f;
#pragma unroll
        for (int i = 0; i < 16; ++i) { xv[i] += o[i]; ss += xv[i] * xv[i]; }
        ss = wave_sum(ss);
        const float rn = rsqrtf(ss * (1.0f / DM) + EPS);
        float gv[16];
        { const float* gp = gnext + lane * 8; const f32x4 a = *(const f32x4*)gp, b = *(const f32x4*)(gp + 4), c = *(const f32x4*)(gp + 512), d = *(const f32x4*)(gp + 516);
          gv[0] = a[0]; gv[1] = a[1]; gv[2] = a[2]; gv[3] = a[3]; gv[4] = b[0]; gv[5] = b[1]; gv[6] = b[2]; gv[7] = b[3];
          gv[8] = c[0]; gv[9] = c[1]; gv[10] = c[2]; gv[11] = c[3]; gv[12] = d[0]; gv[13] = d[1]; gv[14] = d[2]; gv[15] = d[3]; }
        if (MODE == 0) {
            *(f32x4*)xr = (f32x4){xv[0], xv[1], xv[2], xv[3]}; *(f32x4*)(xr + 4) = (f32x4){xv[4], xv[5], xv[6], xv[7]};
            *(f32x4*)(xr + 512) = (f32x4){xv[8], xv[9], xv[10], xv[11]}; *(f32x4*)(xr + 516) = (f32x4){xv[12], xv[13], xv[14], xv[15]};
            float hv[16];
#pragma unroll
            for (int i = 0; i < 16; ++i) hv[i] = xv[i] * rn * gv[i];
            u16* hp = (u16*)(p.ws + WS_H) + (size_t)t * DM + lane * 8;
            *(u32x4*)hp = pack8(hv); *(u32x4*)(hp + 512) = pack8(hv + 8);
        } else {
#pragma unroll
            for (int i = 0; i < 16; ++i) xv[i] = xv[i] * rn * gv[i];
            *(f32x4*)xr = (f32x4){xv[0], xv[1], xv[2], xv[3]}; *(f32x4*)(xr + 4) = (f32x4){xv[4], xv[5], xv[6], xv[7]};
            *(f32x4*)(xr + 512) = (f32x4){xv[8], xv[9], xv[10], xv[11]}; *(f32x4*)(xr + 516) = (f32x4){xv[12], xv[13], xv[14], xv[15]};
        }
    }
}

__device__ __forceinline__ void phase_mla_norm(const Params& p, int bid, int nb) {
    const int tid = threadIdx.x, lane = tid & 63, w = tid >> 6;
    const float* down = (const float*)(p.ws + WS_DOWN);
    u16* cqn = (u16*)(p.ws + WS_CQN); u16* ckvn = (u16*)(p.ws + WS_CKVN); u16* kr = (u16*)(p.ws + WS_KROPE);
    const f32x2* rope = (const f32x2*)(p.ws + WS_ROPE_M);
    for (int t = bid * 4 + w; t < T; t += nb * 4) {
        const float* dr = down + (size_t)t * MLA_DOWN_PAD;
        float q[6], kv[4];
#pragma unroll
        for (int i = 0; i < 6; ++i) q[i] = dr[i * 64 + lane];
#pragma unroll
        for (int i = 0; i < 4; ++i) kv[i] = dr[384 + i * 64 + lane];
        const float rp = dr[640 + lane];
        float sq = 0.f, sk = 0.f;
#pragma unroll
        for (int i = 0; i < 6; ++i) sq += q[i] * q[i];
#pragma unroll
        for (int i = 0; i < 4; ++i) sk += kv[i] * kv[i];
        sq = wave_sum(sq); sk = wave_sum(sk);
        const float rq = rsqrtf(sq * (1.0f / MLA_QR) + EPS), rk = rsqrtf(sk * (1.0f / MLA_KVR) + EPS);
#pragma unroll
        for (int i = 0; i < 6; ++i) cqn[(size_t)t * MLA_QR + i * 64 + lane] = f2bf(q[i] * rq * p.mla_q_norm[i * 64 + lane]);
#pragma unroll
        for (int i = 0; i < 4; ++i) ckvn[(size_t)t * MLA_KVR + i * 64 + lane] = f2bf(kv[i] * rk * p.mla_kv_norm[i * 64 + lane]);
        const float other = __shfl_xor(rp, 32);
        const f32x2 cssn = rope[(size_t)(t & (SEQ - 1)) * 32 + (lane & 31)];
        const float res = (lane < 32) ? (rp * cssn[0] - other * cssn[1]) : (other * cssn[1] + rp * cssn[0]);
        kr[(size_t)t * 64 + lane] = f2bf(res);
    }
}

__device__ __forceinline__ void phase_mla_up(const Params& p, int bid, int nb) {
    const int tid = threadIdx.x;
    unsigned char* ws = p.ws;
    const f32x2* rope = (const f32x2*)(ws + WS_ROPE_M);
    u16* qo = (u16*)(ws + WS_Q); u16* kvo = (u16*)(ws + WS_KV);
    constexpr int NTQ = 1536 / 128, NTKV = 2048 / 128, NTT = NTQ + NTKV;
    for (int t = bid; t < (T / 128) * NTT; t += nb) {
        const int mt = t / NTT, nt = t % NTT;
        if (nt < NTQ) {
            gemm_tile((const u16*)(ws + WS_CQN), MLA_QR, (const u16*)(ws + WS_WQUPT), MLA_QR, MLA_QR, mt * 128, nt * 128, [&](int m0, int n0) {
#pragma unroll
                for (int ps = 0; ps < 8; ++ps) {
                    const int m = ps * 16 + (tid >> 4), c = (tid & 15) * 8;
                    const int within = (n0 + c) % 192;
                    u16* dst = qo + (size_t)(m0 + m) * 1536 + n0 + c;
                    if (within < 128) { float v[8]; cs_read8(m, c, v); *(u32x4*)dst = pack8(v); }
                    else if (within < 160) {
                        float x1[8], x2[8], y1[8], y2[8]; cs_read8(m, c, x1); cs_read8(m, c + 32, x2);
                        const f32x2* rp = rope + (size_t)((m0 + m) & (SEQ - 1)) * 32 + (within - 128);
#pragma unroll
                        for (int e = 0; e < 8; ++e) { const f32x2 cssn = rp[e]; y1[e] = x1[e] * cssn[0] - x2[e] * cssn[1]; y2[e] = x1[e] * cssn[1] + x2[e] * cssn[0]; }
                        *(u32x4*)dst = pack8(y1); *(u32x4*)(dst + 32) = pack8(y2);
                    }
                }
            });
        } else {
            gemm_tile((const u16*)(ws + WS_CKVN), MLA_KVR, (const u16*)(ws + WS_WKVUPT), MLA_KVR, MLA_KVR, mt * 128, (nt - NTQ) * 128, [&](int m0, int n0) {
#pragma unroll
                for (int ps = 0; ps < 8; ++ps) {
                    const int m = ps * 16 + (tid >> 4), c = (tid & 15) * 8;
                    float v[8]; cs_read8(m, c, v);
                    *(u32x4*)(kvo + (size_t)(m0 + m) * 2048 + n0 + c) = pack8(v);
                }
            });
        }
    }
}

__device__ __forceinline__ int crow(int r, int hi) { return (r & 3) + 8 * (r >> 2) + 4 * hi; }
__device__ __forceinline__ void attn_task(const Params& p, int b, int h, int qb) {
    unsigned char* ws = p.ws;
    const int tid = opaque((int)threadIdx.x), lane = tid & 63, w = tid >> 6, lr = lane & 31, hi = lane >> 5;
    const u16* Q = (const u16*)(ws + WS_Q); const u16* KV = (const u16*)(ws + WS_KV); const u16* KR = (const u16*)(ws + WS_KROPE);
    const int t0 = b * SEQ, q0 = qb * 128, qrow = q0 + w * 32 + lr;
    bf16x8 qf[12];
#pragma unroll
    for (int s = 0; s < 12; ++s) qf[s] = *(const bf16x8*)(Q + (size_t)(t0 + qrow) * 1536 + h * 192 + s * 16 + hi * 8);
    f32x16 o[4];
#pragma unroll
    for (int i = 0; i < 4; ++i)
#pragma unroll
        for (int r = 0; r < 16; ++r) o[i][r] = 0.f;
    float m = -1e30f, l = 0.f;
    const float c2 = 0.07216878364870322f * 1.4426950408889634f;
    const int ntiles = (q0 + 128) >> 6;
    constexpr int VT = 24576;
    for (int jt = 0; jt < ntiles; ++jt) {
        const int j0 = jt * 64;
        __syncthreads();
#pragma unroll
        for (int i = 0; i < 4; ++i) {
            const int idx = tid + 256 * i, key = idx >> 4, c16 = idx & 15;
            const u32x4 v = *(const u32x4*)(KV + (size_t)(t0 + j0 + key) * 2048 + h * 256 + c16 * 8);
            *(u32x4*)(smem + (c16 >> 3) * 8192 + toff(key, c16 & 7)) = v;
        }
#pragma unroll
        for (int i = 0; i < 2; ++i) {
            const int idx = tid + 256 * i, key = idx >> 3, c8 = idx & 7;
            const u32x4 v = *(const u32x4*)(KR + (size_t)(t0 + j0 + key) * 64 + c8 * 8);
            *(u32x4*)(smem + 16384 + toff(key, c8)) = v;
        }
#pragma unroll
        for (int i = 0; i < 4; ++i) {
            const int idx = tid + 256 * i, key = idx >> 4, c16 = idx & 15;
            const u32x4 v = *(const u32x4*)(KV + (size_t)(t0 + j0 + key) * 2048 + h * 256 + 128 + c16 * 8);
            const unsigned wd[4] = {v.x, v.y, v.z, v.w};
            const int pos = (key & ~12) | ((key & 4) << 1) | ((key & 8) >> 1);
#pragma unroll
            for (int e = 0; e < 8; ++e) *(u16*)(smem + VT + toff_e(c16 * 8 + e, pos)) = (u16)((e & 1) ? (wd[e >> 1] >> 16) : (wd[e >> 1] & 0xffffu));
        }
        __syncthreads();
        f32x16 s0, s1;
#pragma unroll
        for (int r = 0; r < 16; ++r) { s0[r] = 0.f; s1[r] = 0.f; }
#pragma unroll
        for (int s = 0; s < 12; ++s) {
            const int kbk = s >> 2, c8 = 2 * (s & 3) + hi;
            const bf16x8 a0 = *(const bf16x8*)(smem + kbk * 8192 + toff(lr, c8)), a1 = *(const bf16x8*)(smem + kbk * 8192 + toff(32 + lr, c8));
            s0 = __builtin_amdgcn_mfma_f32_32x32x16_bf16(a0, qf[s], s0, 0, 0, 0);
            s1 = __builtin_amdgcn_mfma_f32_32x32x16_bf16(a1, qf[s], s1, 0, 0, 0);
            if ((s & 3) == 3) __builtin_amdgcn_sched_barrier(0);
        }
        if (j0 + 63 > q0 + w * 32) {
#pragma unroll
            for (int r = 0; r < 16; ++r) {
                if (j0 + crow(r, hi) > qrow) s0[r] = -INFINITY;
                if (j0 + 32 + crow(r, hi) > qrow) s1[r] = -INFINITY;
            }
        }
        float mx = s0[0];
#pragma unroll
        for (int r = 1; r < 16; ++r) mx = fmaxf(mx, s0[r]);
#pragma unroll
        for (int r = 0; r < 16; ++r) mx = fmaxf(mx, s1[r]);
        mx = fmaxf(mx, __shfl_xor(mx, 32));
        const float mn = fmaxf(m, mx), alpha = exp2f((m - mn) * c2);
        m = mn;
        float rs = 0.f;
#pragma unroll
        for (int r = 0; r < 16; ++r) { s0[r] = exp2f((s0[r] - mn) * c2); s1[r] = exp2f((s1[r] - mn) * c2); rs += s0[r] + s1[r]; }
        l = l * alpha + rs;
#pragma unroll
        for (int i = 0; i < 4; ++i)
#pragma unroll
            for (int r = 0; r < 16; ++r) o[i][r] *= alpha;
        bf16x8 pf[4];
#pragma unroll
        for (int ks = 0; ks < 4; ++ks) {
            u32x4 wv;
            if (ks < 2) { const int bs = 8 * (ks & 1); wv.x = pk2(s0[bs], s0[bs + 1]); wv.y = pk2(s0[bs + 2], s0[bs + 3]); wv.z = pk2(s0[bs + 4], s0[bs + 5]); wv.w = pk2(s0[bs + 6], s0[bs + 7]); }
            else { const int bs = 8 * (ks & 1); wv.x = pk2(s1[bs], s1[bs + 1]); wv.y = pk2(s1[bs + 2], s1[bs + 3]); wv.z = pk2(s1[bs + 4], s1[bs + 5]); wv.w = pk2(s1[bs + 6], s1[bs + 7]); }
            pf[ks] = __builtin_bit_cast(bf16x8, wv);
        }
#pragma unroll
        for (int ks = 0; ks < 4; ++ks) {
            const int c8 = 2 * ks + hi;
#pragma unroll
            for (int dvb = 0; dvb < 4; ++dvb) {
                const bf16x8 a = *(const bf16x8*)(smem + VT + toff(dvb * 32 + lr, c8));
                o[dvb] = __builtin_amdgcn_mfma_f32_32x32x16_bf16(a, pf[ks], o[dvb], 0, 0, 0);
            }
            __builtin_amdgcn_sched_barrier(0);
        }
    }
    l += __shfl_xor(l, 32);
    const float inv = 1.0f / l;
    __syncthreads();
    u16* Os = (u16*)smem;
#pragma unroll
    for (int dvb = 0; dvb < 4; ++dvb)
#pragma unroll
        for (int q = 0; q < 4; ++q) {
            const int dv = dvb * 32 + 8 * q + 4 * hi;
            u32x2 pk; pk.x = pk2(o[dvb][4 * q] * inv, o[dvb][4 * q + 1] * inv); pk.y = pk2(o[dvb][4 * q + 2] * inv, o[dvb][4 * q + 3] * inv);
            *(u32x2*)(Os + (w * 32 + lr) * 136 + dv) = pk;
        }
    __syncthreads();
    u16* O = (u16*)(ws + WS_O);
#pragma unroll
    for (int ps = 0; ps < 8; ++ps) {
        const int qq = ps * 16 + (tid >> 4), c = (tid & 15) * 8;
        *(u32x4*)(O + (size_t)(t0 + q0 + qq) * DM + h * 128 + c) = *(const u32x4*)(Os + qq * 136 + c);
    }
}
__device__ __forceinline__ void phase_attn(const Params& p, int bid, int nb) {
    for (int r = 0;; ++r) {
        const int idx = (r & 1) ? ((r + 1) * nb - 1 - bid) : (r * nb + bid);
        if (r * nb >= 1024) break;
        if (idx < 1024) { const int qb = 31 - (idx >> 5), bh = idx & 31; attn_task(p, bh >> 3, bh & 7, qb); }
    }
}


#define XB_TMO      128
#define XB_XCNT(j)  (256  + 64 * (j))
#define XB_XSUB(j)  (1280 + 64 * (j))
#define XB_XGEN(j)  (2304 + 64 * (j))
#define XB_TOP      3328
#define XB_TOPGEN   3392
#define XCD_BAR_WORDS 3456
#define XB_SPIN_CAP (1u << 22)
#define LAS __attribute__((address_space(3)))
__device__ __forceinline__ unsigned xb_ld(unsigned* p)              { return __hip_atomic_load(p, __ATOMIC_RELAXED, __HIP_MEMORY_SCOPE_AGENT); }
__device__ __forceinline__ unsigned xb_add(unsigned* p, unsigned v) { return __hip_atomic_fetch_add(p, v, __ATOMIC_RELAXED, __HIP_MEMORY_SCOPE_AGENT); }
__device__ __forceinline__ unsigned xb_xcc_id() { return (unsigned)__builtin_amdgcn_s_getreg((3 << 11) | 20) & 0xFu; }
#define XB_SPIN(cond, bar) do { unsigned _sp = 0; while (cond) { __builtin_amdgcn_s_sleep(1); \
    if ((++_sp & 255u) == 0u) { if (xb_ld(&(bar)[XB_TMO])) break; if (_sp > XB_SPIN_CAP) { atomicAdd(&(bar)[XB_TMO], 1u); break; } } } } while (0)
__device__ __forceinline__ void xcd_barrier_complete(unsigned* bar, unsigned x, unsigned& nloc, unsigned& nx) {
    const unsigned G = gridDim.x;
    unsigned sum, cnt, mine, sp = 0u;
    for (;;) {
        sum = 0u; cnt = 0u; mine = 0u;
#pragma unroll
        for (unsigned j = 0; j < 16; ++j) { const unsigned c = xb_ld(&bar[XB_XCNT(j)]); sum += c; cnt += (c > 0u) ? 1u : 0u; mine = (j == x) ? c : mine; }
        if (sum == G) break;
        __builtin_amdgcn_s_sleep(1);
        if ((++sp & 255u) == 0u) { if (xb_ld(&bar[XB_TMO])) break; if (sp > XB_SPIN_CAP) { atomicAdd(&bar[XB_TMO], 1u); break; } }
    }
    nloc = mine > 0u ? mine : 1u; nx = cnt > 0u ? cnt : 1u;
}
__device__ __forceinline__ void xcd_barrier(unsigned* bar, unsigned nloc, unsigned nx) {
    asm volatile("s_waitcnt vmcnt(0)" ::: "memory");
    __syncthreads();
    if (threadIdx.x == 0) {
        const unsigned x = xb_xcc_id();
        __builtin_amdgcn_s_waitcnt(0);
        const unsigned old = xb_add(&bar[XB_XSUB(x)], 1u);
        const unsigned gen = old / nloc;
        if (old + 1u == (gen + 1u) * nloc) {
            __builtin_amdgcn_fence(__ATOMIC_RELEASE, "agent");
            asm volatile("s_waitcnt vmcnt(0)" ::: "memory");
            const unsigned og = xb_add(&bar[XB_TOP], 1u);
            const unsigned tg = og / nx;
            if (og + 1u == (tg + 1u) * nx) xb_add(&bar[XB_TOPGEN], 1u);
            else XB_SPIN(xb_ld(&bar[XB_TOPGEN]) == tg, bar);
            __builtin_amdgcn_fence(__ATOMIC_ACQUIRE, "agent");
            xb_add(&bar[XB_XGEN(x)], 1u);
            asm volatile("s_waitcnt vmcnt(0)" ::: "memory");
        } else {
            XB_SPIN(xb_ld(&bar[XB_XGEN(x)]) == gen, bar);
            __builtin_amdgcn_fence(__ATOMIC_ACQUIRE, "agent");
            asm volatile("s_waitcnt vmcnt(0)" ::: "memory");
        }
    }
    __syncthreads();
}

constexpr int NPHASES = 19;
template <int PH>
__device__ __forceinline__ void run_phase(const Params& p, int bid, int nb) {
    unsigned char* ws = p.ws;
    const int tid = threadIdx.x;
    if constexpr (PH == 0) phase_prep(p, bid, nb);
    else if constexpr (PH == 1) phase_inproj(p, bid, nb);
    else if constexpr (PH == 2) phase_mixA(p, bid, nb);
    else if constexpr (PH == 3) phase_scan(p, bid, nb);
    else if constexpr (PH == 4) phase_mixB(p, bid, nb);
    else if constexpr (PH == 5) phase_gemm_residual(p, (const u16*)(ws + WS_Y), HY_OUT, (const u16*)(ws + WS_WOUTT), HY_OUT, p.x, p.out, bid, nb);
    else if constexpr (PH == 6) rmsnorm_rows(p.out, p.norm_ffn, (u16*)(ws + WS_H), bid, nb, tid);
    else if constexpr (PH == 7) phase_gemm_f32<DM, 2048>((const u16*)(ws + WS_H), (const u16*)(ws + WS_WPQT), (float*)(ws + WS_SCORES), bid, nb);
    else if constexpr (PH == 8) phase_topk(p, bid, nb);
    else if constexpr (PH == 9) phase_peer<0>(p, 0, p.norm_mix + DM, bid, nb);
    else if constexpr (PH == 10) phase_gemm_f32<DM, MLA_DOWN_PAD>((const u16*)(ws + WS_H), (const u16*)(ws + WS_WDOWNT), (float*)(ws + WS_DOWN), bid, nb);
    else if constexpr (PH == 11) phase_mla_norm(p, bid, nb);
    else if constexpr (PH == 12) phase_mla_up(p, bid, nb);
    else if constexpr (PH == 13) phase_attn(p, bid, nb);
    else if constexpr (PH == 14) phase_gemm_residual(p, (const u16*)(ws + WS_O), DM, (const u16*)(ws + WS_WMOT), DM, p.out, p.out, bid, nb);
    else if constexpr (PH == 15) rmsnorm_rows(p.out, p.norm_ffn + DM, (u16*)(ws + WS_H), bid, nb, tid);
    else if constexpr (PH == 16) phase_gemm_f32<DM, 2048>((const u16*)(ws + WS_H), (const u16*)(ws + WS_WPQT) + (size_t)2048 * DM, (float*)(ws + WS_SCORES), bid, nb);
    else if constexpr (PH == 17) phase_topk(p, bid, nb);
    else if constexpr (PH == 18) phase_peer<1>(p, 1, p.final_norm, bid, nb);
}
typedef const __attribute__((address_space(4))) unsigned long long* cptr64;
__device__ __forceinline__ void load_params(Params& r, cptr64 s) {
    unsigned long long* d = (unsigned long long*)&r;
#pragma unroll
    for (int i = 0; i < (int)(sizeof(Params) / 8); ++i) d[i] = s[i];
}
template <int PH>
__device__ __forceinline__ void run_from(cptr64 ka, unsigned nloc, unsigned nx) {
    {
        cptr64 q = ka; asm volatile("" : "+s"(q));
        Params lp; load_params(lp, q);
        run_phase<PH>(lp, (int)blockIdx.x, (int)gridDim.x);
    }
    if constexpr (PH + 1 < NPHASES) {
        cptr64 q = ka; asm volatile("" : "+s"(q));
        xcd_barrier((unsigned*)((unsigned char*)q[21] + WS_BAR), nloc, nx);
        run_from<PH + 1>(ka, nloc, nx);
    }
}
__global__ void __launch_bounds__(NTHREADS, 2) k_mega(Params p_unused) {
    cg::grid_group grid = cg::this_grid();
    cptr64 ka = (cptr64)__builtin_amdgcn_kernarg_segment_ptr();
    unsigned* bar = (unsigned*)((unsigned char*)ka[21] + WS_BAR);
    if (threadIdx.x == 0) (void)xb_add(&bar[XB_XCNT(xb_xcc_id())], 1u);
    {
        cptr64 q = ka; asm volatile("" : "+s"(q));
        Params lp; load_params(lp, q);
        run_phase<0>(lp, (int)blockIdx.x, (int)gridDim.x);
    }
    grid.sync();
    unsigned nloc, nx;
    {
        const unsigned x = xb_xcc_id();
        unsigned cnt = 0u, mine = 0u;
#pragma unroll
        for (unsigned j = 0; j < 16; ++j) { const unsigned c = xb_ld(&bar[XB_XCNT(j)]); cnt += (c > 0u) ? 1u : 0u; mine = (j == x) ? c : mine; }
        nloc = __builtin_amdgcn_readfirstlane(mine > 0u ? mine : 1u); nx = __builtin_amdgcn_readfirstlane(cnt > 0u ? cnt : 1u);
    }
    run_from<1>(ka, nloc, nx);
}

extern "C" void kernel_launch(void* const* d_in, const int* in_sizes, int n_in, void* d_out, int out_size, void* d_ws, size_t ws_size, hipStream_t stream) {
    if (n_in != 20 || out_size != T * DM || ws_size < WS_END) { fprintf(stderr, "kernel_launch: unexpected shapes (n_in %d out %d ws %zu need %zu)\n", n_in, out_size, ws_size, (size_t)WS_END); return; }
    static int grid_blocks = 0;
    if (!grid_blocks) {
        int dev = 0, cus = 0, per_cu = 0;
        (void)hipGetDevice(&dev);
        (void)hipDeviceGetAttribute(&cus, hipDeviceAttributeMultiprocessorCount, dev);
        if (hipFuncSetAttribute((const void*)k_mega, hipFuncAttributeMaxDynamicSharedMemorySize, LDS_BYTES) != hipSuccess) { fprintf(stderr, "kernel_launch: hipFuncSetAttribute failed\n"); return; }
        if (hipOccupancyMaxActiveBlocksPerMultiprocessor(&per_cu, (const void*)k_mega, NTHREADS, LDS_BYTES) != hipSuccess || per_cu < 1) { fprintf(stderr, "kernel_launch: occupancy query failed (%d)\n", per_cu); return; }
        if (per_cu > 2) per_cu = 2;
        grid_blocks = cus * per_cu;
        fprintf(stderr, "kernel_launch: %d CUs x %d blocks\n", cus, per_cu);
    }
    Params p{};
    const float** f = (const float**)&p;
    for (int i = 0; i < 20; ++i) f[i] = (const float*)d_in[i];
    p.out = (float*)d_out; p.ws = (unsigned char*)d_ws;
    (void)hipMemsetAsync((unsigned char*)d_ws + WS_BAR, 0, 16384, stream);
    void* args[] = {&p};
    hipError_t e = hipLaunchCooperativeKernel((const void*)k_mega, dim3(grid_blocks), dim3(NTHREADS), args, LDS_BYTES, stream);
    if (e != hipSuccess) fprintf(stderr, "cooperative launch failed: %s (grid %d)\n", hipGetErrorString(e), grid_blocks);
}
```

```cpp
#include <hip/hip_runtime.h>
#include <hip/hip_cooperative_groups.h>
#include <cstdint>
#include <cstdio>
namespace cg = cooperative_groups;

typedef unsigned short u16;
typedef short bf16x8 __attribute__((ext_vector_type(8)));
typedef float f32x16 __attribute__((ext_vector_type(16)));
typedef float f32x4 __attribute__((ext_vector_type(4)));
typedef float f32x2 __attribute__((ext_vector_type(2)));
typedef unsigned u32x4 __attribute__((ext_vector_type(4)));
typedef unsigned u32x2 __attribute__((ext_vector_type(2)));
typedef __bf16 bf16v2 __attribute__((ext_vector_type(2)));

constexpr int T = 16384, DM = 1024, SEQ = 4096;
constexpr int HY_IN = 5120, HY_OUT = 2048;
constexpr int MLA_DOWN = 704, MLA_DOWN_PAD = 768, MLA_QR = 384, MLA_KVR = 256;
constexpr int NEXP = 16384;
constexpr float EPS = 1e-6f;
constexpr int NTHREADS = 512;
constexpr int LDS_BYTES = 81920;
constexpr int LDS_TOTAL = 2 * LDS_BYTES;

constexpr size_t al256(size_t x) { return (x + 255) & ~(size_t)255; }
constexpr size_t WS_WINT   = 0;
constexpr size_t WS_WOUTT  = WS_WINT   + (size_t)HY_IN * DM * 2;
constexpr size_t WS_WDOWNT = WS_WOUTT  + (size_t)DM * HY_OUT * 2;
constexpr size_t WS_WQUPT  = WS_WDOWNT + (size_t)MLA_DOWN_PAD * DM * 2;
constexpr size_t WS_WKVUPT = WS_WQUPT  + (size_t)1536 * MLA_QR * 2;
constexpr size_t WS_WMOT   = WS_WKVUPT + (size_t)2048 * MLA_KVR * 2;
constexpr size_t WS_WPQT   = WS_WMOT   + (size_t)DM * DM * 2;
constexpr size_t WS_ROPE_R = WS_WPQT   + (size_t)2 * 2048 * DM * 2;
constexpr size_t WS_ROPE_M = WS_ROPE_R + (size_t)SEQ * 64 * 8;
constexpr size_t WS_UBF    = WS_ROPE_M + (size_t)SEQ * 32 * 8;
constexpr size_t WS_VBF    = WS_UBF    + (size_t)2 * NEXP * DM;
constexpr size_t WS_USC    = WS_VBF    + (size_t)2 * NEXP * DM;
constexpr size_t WS_VSC    = WS_USC    + (size_t)2 * NEXP * 4;
constexpr size_t WS_H      = WS_VSC    + (size_t)2 * NEXP * 4;
constexpr size_t WS_PROJ   = WS_H      + (size_t)T * DM * 2;
constexpr size_t WS_Y      = WS_PROJ   + (size_t)T * HY_IN * 2;
constexpr size_t WS_SSQ    = WS_Y      + (size_t)T * HY_OUT * 2;
constexpr size_t WS_DST    = WS_SSQ    + (size_t)T * 8 * 4;
constexpr size_t WS_EXP    = WS_DST    + (size_t)512 * 256 * 128 * 4;
constexpr size_t WS_GATE   = WS_EXP    + (size_t)T * 128 * 2;
constexpr size_t WS_BAR    = WS_GATE   + (size_t)T * 128 * 4;
constexpr size_t WS_TS     = WS_BAR    + 16384;
constexpr size_t WS_AVT    = WS_TS     + 4096;
constexpr size_t WS_KT     = WS_AVT    + (size_t)T * 1024 * 2;
constexpr size_t WS_VTR    = WS_KT     + (size_t)T * 512 * 2;
constexpr size_t WS_END    = WS_VTR    + (size_t)T * 1024 * 2;
constexpr size_t WS_Q      = WS_PROJ;
constexpr size_t WS_KV     = WS_Q  + (size_t)T * 1536 * 2;
constexpr size_t WS_DOWN   = WS_KV + (size_t)T * 2048 * 2;
constexpr size_t WS_TK = WS_PROJ;
constexpr size_t WS_O      = WS_Y;
constexpr size_t WS_CQN    = WS_O    + (size_t)T * DM * 2;
constexpr size_t WS_CKVN   = WS_CQN  + (size_t)T * MLA_QR * 2;
constexpr size_t WS_KROPE  = WS_CKVN + (size_t)T * MLA_KVR * 2;
static_assert(WS_DOWN + (size_t)T * 768 * 4 <= WS_Y, "overlay");
static_assert(WS_KROPE + (size_t)T * 64 * 2 <= WS_SSQ, "overlay");

struct Params {
    const float *x, *norm_mix, *norm_ffn, *hy_w_in, *gm_v_norm, *gm_w_s, *gm_b_s, *ret_norm, *hy_w_out;
    const float *mla_w_down, *mla_q_norm, *mla_w_q_up, *mla_kv_norm, *mla_w_kv_up, *mla_w_out;
    const float *peer_w_q, *peer_sub_keys, *peer_u, *peer_v, *final_norm;
    float* out;
    unsigned char* ws;
};

extern __shared__ __attribute__((aligned(16))) unsigned char smem_raw[];
__device__ __forceinline__ int vhalf() { return __builtin_amdgcn_readfirstlane((int)(threadIdx.x >> 8)); }
#define smem (smem_raw + vhalf() * LDS_BYTES)

__device__ __forceinline__ unsigned pk2(float lo, float hi) { unsigned r; asm volatile("v_cvt_pk_bf16_f32 %0, %1, %2" : "=v"(r) : "v"(lo), "v"(hi)); return r; }
__device__ __forceinline__ u16 f2bf(float f) { return (u16)(pk2(f, 0.f) & 0xffffu); }
__device__ __forceinline__ float bflo(unsigned u) { return __uint_as_float(u << 16); }
__device__ __forceinline__ float bfhi(unsigned u) { return __uint_as_float(u & 0xffff0000u); }
__device__ __forceinline__ float bf2f(u16 h) { return __uint_as_float((unsigned)h << 16); }
__device__ __forceinline__ u32x4 pack8(const float* v) { u32x4 w; w.x = pk2(v[0], v[1]); w.y = pk2(v[2], v[3]); w.z = pk2(v[4], v[5]); w.w = pk2(v[6], v[7]); return w; }
__device__ __forceinline__ void unpack8(u32x4 w, float* v) { v[0] = bflo(w.x); v[1] = bfhi(w.x); v[2] = bflo(w.y); v[3] = bfhi(w.y); v[4] = bflo(w.z); v[5] = bfhi(w.z); v[6] = bflo(w.w); v[7] = bfhi(w.w); }
__device__ __forceinline__ float gelu_f(float v) {
    const float t = __builtin_amdgcn_rcpf(fabsf(v) * 0.2316418882f + 1.0f);
    float q = t * 0.5307027145f + (-0.7265760135f); q = q * t + 0.7107068705f; q = q * t + (-0.142248368f); q = q * t + 0.127414796f; q = q * t;
    const float m = v * (q * __builtin_amdgcn_exp2f(v * v * (-0.72134752044f)));
    return v < 0.f ? m : v - m;
}
__device__ __forceinline__ float silu_f(float v) { return v * __builtin_amdgcn_rcpf(1.0f + __builtin_amdgcn_exp2f(v * (-1.4426950408889634f))); }
__device__ __forceinline__ float wave_sum(float v) {
#pragma unroll
    for (int o = 32; o >= 1; o >>= 1) v += __shfl_xor(v, o);
    return v;
}

__device__ __forceinline__ int opaque(int v) { asm volatile("" : "+v"(v)); return v; }

__device__ __forceinline__ int toff(int r, int c8) { return r * 128 + ((c8 ^ ((r >> 1) & 7)) << 4); }
__device__ __forceinline__ int toff_e(int r, int k) { return toff(r, k >> 3) + (k & 7) * 2; }

template <int PT, int QT>
__device__ __forceinline__ void mma_kb(f32x16 (&acc)[PT][QT], int Ps, int prow0, int Qs, int qrow0, int lane) {
    const int lr = lane & 31, hi = lane >> 5;
    bf16x8 a[4][PT], b[4][QT];
#pragma unroll
    for (int s = 0; s < 4; ++s) {
        const int c8 = 2 * s + hi;
#pragma unroll
        for (int i = 0; i < PT; ++i) a[s][i] = *(const bf16x8*)(smem + Ps + toff(prow0 + i * 32 + lr, c8));
#pragma unroll
        for (int j = 0; j < QT; ++j) b[s][j] = *(const bf16x8*)(smem + Qs + toff(qrow0 + j * 32 + lr, c8));
    }
    __builtin_amdgcn_sched_barrier(0);
#pragma unroll
    for (int s = 0; s < 4; ++s)
#pragma unroll
        for (int i = 0; i < PT; ++i)
#pragma unroll
            for (int j = 0; j < QT; ++j) acc[i][j] = __builtin_amdgcn_mfma_f32_32x32x16_bf16(a[s][i], b[s][j], acc[i][j], 0, 0, 0);
#pragma unroll
    for (int i = 0; i < PT; ++i)
#pragma unroll
        for (int j = 0; j < QT; ++j) asm volatile("" : "+v"(acc[i][j]));
}

template <int ROWS>
__device__ __forceinline__ void gload_nat(u32x4 (&r)[ROWS / 32], const u16* src, int ld, int tid) {
    tid = opaque(tid);
#pragma unroll
    for (int i = 0; i < ROWS / 32; ++i) { const int idx = tid + 256 * i, row = idx >> 3, c8 = idx & 7; r[i] = *(const u32x4*)(src + (size_t)row * ld + c8 * 8); }
}
template <int ROWS>
__device__ __forceinline__ void sstore_nat(int lds, const u32x4 (&r)[ROWS / 32], int tid) {
    tid = opaque(tid);
#pragma unroll
    for (int i = 0; i < ROWS / 32; ++i) { const int idx = tid + 256 * i, row = idx >> 3, c8 = idx & 7; *(u32x4*)(smem + lds + toff(row, c8)) = r[i]; }
}
template <int ROWS, bool SCALE>
__device__ __forceinline__ void load_tr(int lds, const u16* src, int ld, int tid, const float* kscale) {
    constexpr int CH = ROWS / 8;
    tid = opaque(tid);
#pragma unroll 2
    for (int i = 0; i < (64 * CH) / 256; ++i) {
        const int idx = tid + 256 * i, k = idx / CH, nc = idx % CH;
        const u32x4 v = *(const u32x4*)(src + (size_t)k * ld + nc * 8);
        const unsigned wd[4] = {v.x, v.y, v.z, v.w};
        float sc = 1.f; if (SCALE) sc = kscale[k];
#pragma unroll
        for (int e = 0; e < 8; ++e) {
            u16 h;
            if (SCALE) h = f2bf(((e & 1) ? bfhi(wd[e >> 1]) : bflo(wd[e >> 1])) * sc);
            else h = (u16)((e & 1) ? (wd[e >> 1] >> 16) : (wd[e >> 1] & 0xffffu));
            *(u16*)(smem + lds + toff_e(nc * 8 + e, k)) = h;
        }
    }
}

constexpr int CS_LD = 132;
__device__ __forceinline__ void stage_c22(const f32x16 (&acc)[2][2], int wm, int wn, int lane) {
    const int lr = lane & 31, hi = lane >> 5;
#pragma unroll
    for (int i = 0; i < 2; ++i)
#pragma unroll
        for (int j = 0; j < 2; ++j)
#pragma unroll
            for (int q = 0; q < 4; ++q) {
                const int n = wm * 64 + i * 32 + 8 * q + 4 * hi, m = wn * 64 + j * 32 + lr;
                f32x4 v = {acc[i][j][4 * q], acc[i][j][4 * q + 1], acc[i][j][4 * q + 2], acc[i][j][4 * q + 3]};
                *(f32x4*)(smem + (m * CS_LD + n) * 4) = v;
            }
}
__device__ __forceinline__ void cs_read8(int m, int c, float* v) {
    const f32x4 a = *(const f32x4*)(smem + (m * CS_LD + c) * 4), b = *(const f32x4*)(smem + (m * CS_LD + c + 4) * 4);
    v[0] = a[0]; v[1] = a[1]; v[2] = a[2]; v[3] = a[3]; v[4] = b[0]; v[5] = b[1]; v[6] = b[2]; v[7] = b[3];
}

__device__ __forceinline__ void cs_store_transposed(u16* dst  , int tid) {
#pragma unroll
    for (int ps = 0; ps < 8; ++ps) {
        const int col = ps * 16 + (tid >> 4), tk8 = (tid & 15) * 8;
        float v[8];
#pragma unroll
        for (int e = 0; e < 8; ++e) v[e] = *(const float*)(smem + ((tk8 + e) * CS_LD + col) * 4);
        *(u32x4*)(dst + (size_t)col * 128 + tk8) = pack8(v);
    }
}
__device__ __forceinline__ void load_nat_colscale(int lds, const u16* src, int ld, int tid, const float* kscale) {
    tid = opaque(tid);
#pragma unroll 2
    for (int i = 0; i < 4; ++i) {
        const int idx = tid + 256 * i, row = idx >> 3, c8 = idx & 7;
        float f[8]; unpack8(*(const u32x4*)(src + (size_t)row * ld + c8 * 8), f);
#pragma unroll
        for (int e = 0; e < 8; ++e) f[e] *= kscale[c8 * 8 + e];
        *(u32x4*)(smem + lds + toff(row, c8)) = pack8(f);
    }
}
__device__ __forceinline__ void glds_tile128(int lds, const u16* src, int ld, int tid) {
    const int lane = tid & 63, w = tid >> 6;
#pragma unroll
    for (int i = 0; i < 4; ++i) {
        const int r0 = (w * 4 + i) * 8, r = r0 + (lane >> 3), c8 = (lane & 7) ^ ((r >> 1) & 7);
        __builtin_amdgcn_global_load_lds((const unsigned*)(src + (size_t)r * ld + c8 * 8), (unsigned*)(smem + lds + r0 * 128), 16, 0, 0);
    }
}

template <class Epi>
__device__ __forceinline__ void gemm_tile(const u16* A, int lda, const u16* Bt, int ldb, int K, int m0, int n0, Epi&& epi) {
    const int tid = opaque((int)threadIdx.x & 255), lane = tid & 63, w = tid >> 6, wm = w >> 1, wn = w & 1;
    f32x16 acc[2][2];
#pragma unroll
    for (int i = 0; i < 2; ++i)
#pragma unroll
        for (int j = 0; j < 2; ++j)
#pragma unroll
            for (int r = 0; r < 16; ++r) acc[i][j][r] = 0.f;
    const u16* Ap = A + (size_t)m0 * lda; const u16* Bp = Bt + (size_t)n0 * ldb;
    glds_tile128(0, Bp, ldb, tid); glds_tile128(16384, Ap, lda, tid);
    const int nk = K >> 6;
    for (int kb = 0; kb < nk; ++kb) {
        const int buf = (kb & 1) * 32768;
        asm volatile("s_waitcnt vmcnt(0)" ::: "memory");
        __syncthreads();
        if (kb + 1 < nk) { glds_tile128(buf ^ 32768, Bp + (kb + 1) * 64, ldb, tid); glds_tile128((buf ^ 32768) + 16384, Ap + (kb + 1) * 64, lda, tid); }
        mma_kb<2, 2>(acc, buf, wm * 64, buf + 16384, wn * 64, lane);
    }
    __syncthreads();
    stage_c22(acc, wm, wn, lane);
    __syncthreads();
    epi(m0, n0);
    __syncthreads();
}

__device__ __forceinline__ int toff32(int r, int c4) { return r * 64 + ((c4 ^ ((r >> 2) & 3)) << 4); }
template <int ROWS>
__device__ __forceinline__ void glds_rows32(int lds, const u16* src, int ld, int tid) {
    const int lane = tid & 63, w = tid >> 6;
#pragma unroll
    for (int i = 0; i < ROWS / 64; ++i) {
        const int r0 = (w * (ROWS / 64) + i) * 16, r = r0 + (lane >> 2), c4 = (lane & 3) ^ ((r >> 2) & 3);
        __builtin_amdgcn_global_load_lds((const unsigned*)(src + (size_t)r * ld + c4 * 8), (unsigned*)(smem + lds + r0 * 64), 16, 0, 0);
    }
}
__device__ __forceinline__ void glds_piece(int st, int piece, const u16* Bp, int ldb, const u16* Ap, int lda, int tid) {
    const int lane = tid & 63, w = tid >> 6;
    const bool isq = piece >= 4;
    const int r0 = isq ? (w * 2 + (piece - 4)) * 16 : (w * 4 + piece) * 16, r = r0 + (lane >> 2), c4 = (lane & 3) ^ ((r >> 2) & 3);
    const u16* src = isq ? Ap + (size_t)r * lda : Bp + (size_t)r * ldb;
    __builtin_amdgcn_global_load_lds((const unsigned*)(src + c4 * 8), (unsigned*)(smem + st + (isq ? 16384 : 0) + r0 * 64), 16, 0, 0);
}
constexpr int G2_STAGE = 24576;
template <int GM = 0, class Epi>
__device__ __forceinline__ void gemm_tile2(const u16* A, int lda, const u16* Bt, int ldb, int K, int m0, int n0, Epi&& epi) {
    const int tid = opaque((int)threadIdx.x & 255), lane = tid & 63, w = tid >> 6, wm = w >> 1, wn = w & 1, lr = lane & 31, hi = lane >> 5;
    f32x16 acc[4][2];
#pragma unroll
    for (int i = 0; i < 4; ++i)
#pragma unroll
        for (int j = 0; j < 2; ++j)
#pragma unroll
            for (int r = 0; r < 16; ++r) acc[i][j][r] = 0.f;
    const u16* Ap = A + (size_t)m0 * lda; const u16* Bp = Bt + (size_t)n0 * ldb;
    const int nk = K >> 5;
    glds_rows32<256>(0, Bp, ldb, tid); glds_rows32<128>(16384, Ap, lda, tid);
    glds_rows32<256>(G2_STAGE, Bp + 32, ldb, tid); glds_rows32<128>(G2_STAGE + 16384, Ap + 32, lda, tid);
    int st = 0, stn = 2 * G2_STAGE;
    for (int kb = 0; kb < nk; ++kb) {
        if (GM != 2 && kb + 1 < nk) asm volatile("s_waitcnt vmcnt(6)" ::: "memory"); else asm volatile("s_waitcnt vmcnt(0)" ::: "memory");
        __builtin_amdgcn_s_barrier();
        const bool refill = (GM != 2) && (kb + 2 < nk);
        bf16x8 a[2][4], b[2][2];
#pragma unroll
        for (int s = 0; s < 2; ++s) {
            const int c4 = 2 * s + hi;
#pragma unroll
            for (int i = 0; i < 4; ++i) a[s][i] = *(const bf16x8*)(smem + st + toff32(wm * 128 + i * 32 + lr, c4));
#pragma unroll
            for (int j = 0; j < 2; ++j) b[s][j] = *(const bf16x8*)(smem + st + 16384 + toff32(wn * 64 + j * 32 + lr, c4));
        }
        __builtin_amdgcn_sched_barrier(0);
#pragma unroll
        for (int s = 0; s < 2; ++s)
#pragma unroll
            for (int i = 0; i < 4; ++i) {
                if (GM == 1) { asm volatile("" :: "v"(a[s][i])); asm volatile("" :: "v"(b[s][0])); asm volatile("" :: "v"(b[s][1])); }
                else {
#pragma unroll
                    for (int j = 0; j < 2; ++j) acc[i][j] = __builtin_amdgcn_mfma_f32_32x32x16_bf16(a[s][i], b[s][j], acc[i][j], 0, 0, 0);
                }
                const int pc = s * 4 + i;
                if (pc < 6) { if (refill) glds_piece(stn, pc, Bp + (kb + 2) * 32, ldb, Ap + (kb + 2) * 32, lda, tid); __builtin_amdgcn_sched_barrier(0); }
            }
#pragma unroll
        for (int i = 0; i < 4; ++i)
#pragma unroll
            for (int j = 0; j < 2; ++j) asm volatile("" : "+v"(acc[i][j]));
        st = (st == 2 * G2_STAGE) ? 0 : st + G2_STAGE; stn = (stn == 2 * G2_STAGE) ? 0 : stn + G2_STAGE;
    }
#pragma unroll 1
    for (int h = 0; h < 2; ++h) {
        __syncthreads();
        if (wm == h) {
#pragma unroll
            for (int i = 0; i < 4; ++i)
#pragma unroll
                for (int j = 0; j < 2; ++j)
#pragma unroll
                    for (int q = 0; q < 4; ++q) {
                        const int n = i * 32 + 8 * q + 4 * hi, m = wn * 64 + j * 32 + lr;
                        f32x4 v = {acc[i][j][4 * q], acc[i][j][4 * q + 1], acc[i][j][4 * q + 2], acc[i][j][4 * q + 3]};
                        *(f32x4*)(smem + (m * CS_LD + n) * 4) = v;
                    }
        }
        __syncthreads();
        if (GM != 3) epi(m0, n0 + h * 128);
    }
    __syncthreads();
}

constexpr int G3_STAGE = 32768;
__device__ __forceinline__ void glds_piece3(int st, int i, const u16* Bp, int ldb, const u16* Ap, int lda, int lane, int w8) {
    const bool isq = i >= 2;
    const int r0 = (w8 * 2 + (i & 1)) * 16, r = r0 + (lane >> 2), c4 = (lane & 3) ^ ((r >> 2) & 3);
    const u16* src = isq ? Ap + (size_t)r * lda : Bp + (size_t)r * ldb;
    __builtin_amdgcn_global_load_lds((const unsigned*)(src + c4 * 8), (unsigned*)(smem_raw + st + (isq ? 16384 : 0) + r0 * 64), 16, 0, 0);
}
template <class Epi>
__device__ __forceinline__ void gemm_tile3(const u16* A, int lda, const u16* Bt, int ldb, int K, int m0, int n0, Epi&& epi) {
    const int t8 = opaque((int)threadIdx.x), lane = t8 & 63, w8 = t8 >> 6, wp = w8 & 1, wq = w8 >> 1, lr = lane & 31, hi = lane >> 5;
    f32x16 acc[4][2];
#pragma unroll
    for (int i = 0; i < 4; ++i)
#pragma unroll
        for (int j = 0; j < 2; ++j)
#pragma unroll
            for (int r = 0; r < 16; ++r) acc[i][j][r] = 0.f;
    const u16* Ap = A + (size_t)m0 * lda; const u16* Bp = Bt + (size_t)n0 * ldb;
    const int nk = K >> 5;
#pragma unroll
    for (int pk = 0; pk < 3; ++pk)
#pragma unroll
        for (int i = 0; i < 4; ++i) glds_piece3(pk * G3_STAGE, i, Bp + pk * 32, ldb, Ap + pk * 32, lda, lane, w8);
    bf16x8 a0[4], b0[2], a1[4], b1[2];
    auto frag_read = [&](bf16x8 (&a)[4], bf16x8 (&b)[2], int st, int s) {
        const int c4 = 2 * s + hi;
#pragma unroll
        for (int i = 0; i < 4; ++i) a[i] = *(const bf16x8*)(smem_raw + st + toff32(wp * 128 + i * 32 + lr, c4));
#pragma unroll
        for (int j = 0; j < 2; ++j) b[j] = *(const bf16x8*)(smem_raw + st + 16384 + toff32(wq * 64 + j * 32 + lr, c4));
    };
    auto mma_step = [&](bf16x8 (&a)[4], bf16x8 (&b)[2], bool refill, int stn, int kbn) {
#pragma unroll
        for (int i = 0; i < 4; ++i) {
#pragma unroll
            for (int j = 0; j < 2; ++j) acc[i][j] = __builtin_amdgcn_mfma_f32_32x32x16_bf16(a[i], b[j], acc[i][j], 0, 0, 0);
            if (refill) glds_piece3(stn, i, Bp + kbn * 32, ldb, Ap + kbn * 32, lda, lane, w8);
            __builtin_amdgcn_sched_barrier(0);
        }
    };
    asm volatile("s_waitcnt vmcnt(8)" ::: "memory");
    __builtin_amdgcn_s_barrier();
    frag_read(a0, b0, 0, 0);
    for (int kb = 0; kb < nk; ++kb) {
        const int st = (kb & 3) * G3_STAGE;
        frag_read(a1, b1, st, 1);
        __builtin_amdgcn_sched_barrier(0);
        mma_step(a0, b0, false, 0, 0);
        if (kb + 1 < nk) {
            if (kb + 2 < nk) asm volatile("s_waitcnt vmcnt(4)" ::: "memory"); else asm volatile("s_waitcnt vmcnt(0)" ::: "memory");
            __builtin_amdgcn_s_barrier();
            frag_read(a0, b0, ((kb + 1) & 3) * G3_STAGE, 0);
            __builtin_amdgcn_sched_barrier(0);
        }
        mma_step(a1, b1, kb + 3 < nk, ((kb + 3) & 3) * G3_STAGE, kb + 3);
    }
#pragma unroll
    for (int i = 0; i < 4; ++i)
#pragma unroll
        for (int j = 0; j < 2; ++j) asm volatile("" : "+v"(acc[i][j]));
    const int vh = wq >> 1;
#pragma unroll 1
    for (int h = 0; h < 2; ++h) {
        __syncthreads();
        if (wp == h) {
#pragma unroll
            for (int i = 0; i < 4; ++i)
#pragma unroll
                for (int j = 0; j < 2; ++j)
#pragma unroll
                    for (int q = 0; q < 4; ++q) {
                        const int n = i * 32 + 8 * q + 4 * hi, m = (wq & 1) * 64 + j * 32 + lr;
                        f32x4 v = {acc[i][j][4 * q], acc[i][j][4 * q + 1], acc[i][j][4 * q + 2], acc[i][j][4 * q + 3]};
                        *(f32x4*)(smem + (m * CS_LD + n) * 4) = v;
                    }
        }
        __syncthreads();
        epi(m0 + vh * 128, n0 + h * 128);
    }
    __syncthreads();
}
template <int NT>
__device__ __forceinline__ bool tile_map3(int it, int bid, int nb, int& mt, int& nt) {
    constexpr int PN = (NT % 4 == 0) ? 4 : (NT % 3 == 0) ? 3 : (NT % 2 == 0) ? 2 : 1;
    const int x = bid & 7, lb = bid >> 3, nlb = nb >> 3;
    const int j = it * nlb + lb;
    if (j >= 8 * NT) return false;
    const int patch = j / (8 * PN), within = j % (8 * PN);
    mt = x * 8 + (within & 7); nt = patch * PN + (within >> 3);
    return true;
}

template <int NT>
__device__ __forceinline__ bool tile_map(int it, int bid, int nb, int& mt, int& nt) {
    constexpr int PN = (NT % 8 == 0) ? 8 : (NT % 7 == 0) ? 7 : (NT % 6 == 0) ? 6 : (NT % 5 == 0) ? 5 : (NT % 4 == 0) ? 4 : (NT % 3 == 0) ? 3 : (NT % 2 == 0) ? 2 : 1;
    static_assert(NT % PN == 0, "tile_map: NT");
    const int x = bid & 7, lb = bid >> 3, nlb = nb >> 3;
    const int j = it * nlb + lb;
    if (j >= 16 * NT) return false;
    const int patch = j / (8 * PN), within = j % (8 * PN), pm = within & 7, pn = within >> 3;
    mt = x * 16 + (patch & 1) * 8 + pm; nt = (patch >> 1) * PN + pn;
    return true;
}

__device__ __forceinline__ void convT_tile(const float* W, int K, int N, u16* Wt, int kt, int nt, int tid) {
    u16* tile = (u16*)smem;
    __syncthreads();
#pragma unroll
    for (int i = 0; i < 16; ++i) {
        const int k = i * 4 + (tid >> 6), n = tid & 63, gn = nt * 64 + n;
        const float v = (gn < N) ? W[(size_t)(kt * 64 + k) * N + gn] : 0.f;
        tile[n * 72 + k] = f2bf(v);
    }
    __syncthreads();
    const int n = tid >> 2, kc = (tid & 3) * 16;
    const u32x4 a = *(const u32x4*)(tile + n * 72 + kc), b = *(const u32x4*)(tile + n * 72 + kc + 8);
    u16* dst = Wt + (size_t)(nt * 64 + n) * K + kt * 64 + kc;
    *(u32x4*)dst = a; *(u32x4*)(dst + 8) = b;
}
__device__ __forceinline__ void convT_all(const float* W, int K, int N, int Npad, u16* Wt, int bid, int nb, int tid) {
    const int nkt = K / 64, nnt = Npad / 64;
    for (int j = bid; j < nkt * nnt; j += nb) convT_tile(W, K, N, Wt, j % nkt, j / nkt, tid);
}
__device__ __forceinline__ void rmsnorm_rows(const float* X, const float* g, u16* H, int bid, int nb, int tid) {
    const int lane = tid & 63, w = tid >> 6;
    for (int row = bid * 4 + w; row < T; row += nb * 4) {
        const float* xr = X + (size_t)row * DM;
        f32x4 v[4]; float ss = 0.f;
#pragma unroll
        for (int c = 0; c < 4; ++c) { v[c] = *(const f32x4*)(xr + c * 256 + lane * 4); ss += v[c][0] * v[c][0] + v[c][1] * v[c][1] + v[c][2] * v[c][2] + v[c][3] * v[c][3]; }
        ss = wave_sum(ss);
        const float r = rsqrtf(ss * (1.0f / DM) + EPS);
#pragma unroll
        for (int c = 0; c < 4; ++c) {
            const f32x4 gg = *(const f32x4*)(g + c * 256 + lane * 4);
            u32x2 o; o.x = pk2(v[c][0] * r * gg[0], v[c][1] * r * gg[1]); o.y = pk2(v[c][2] * r * gg[2], v[c][3] * r * gg[3]);
            *(u32x2*)(H + (size_t)row * DM + c * 256 + lane * 4) = o;
        }
    }
}
__device__ __forceinline__ void phase_prep(const Params& p, int bid, int nb) {
    const int tid = opaque((int)threadIdx.x & 255);
    unsigned char* ws = p.ws;
    {
        constexpr int J0 = (DM / 64) * (HY_IN / 64), J1 = J0 + (HY_OUT / 64) * (DM / 64), J2 = J1 + (DM / 64) * (MLA_DOWN_PAD / 64), J3 = J2 + (MLA_QR / 64) * (1536 / 64),
                      J4 = J3 + (MLA_KVR / 64) * (2048 / 64), J5 = J4 + (DM / 64) * (DM / 64);
        for (int j = bid; j < J5; j += nb) {
            if (j < J0) convT_tile(p.hy_w_in, DM, HY_IN, (u16*)(ws + WS_WINT), j % (DM / 64), j / (DM / 64), tid);
            else if (j < J1) { const int q = j - J0; convT_tile(p.hy_w_out, HY_OUT, DM, (u16*)(ws + WS_WOUTT), q % (HY_OUT / 64), q / (HY_OUT / 64), tid); }
            else if (j < J2) { const int q = j - J1; convT_tile(p.mla_w_down, DM, MLA_DOWN, (u16*)(ws + WS_WDOWNT), q % (DM / 64), q / (DM / 64), tid); }
            else if (j < J3) { const int q = j - J2; convT_tile(p.mla_w_q_up, MLA_QR, 1536, (u16*)(ws + WS_WQUPT), q % (MLA_QR / 64), q / (MLA_QR / 64), tid); }
            else if (j < J4) { const int q = j - J3; convT_tile(p.mla_w_kv_up, MLA_KVR, 2048, (u16*)(ws + WS_WKVUPT), q % (MLA_KVR / 64), q / (MLA_KVR / 64), tid); }
            else { const int q = j - J4; convT_tile(p.mla_w_out, DM, DM, (u16*)(ws + WS_WMOT), q % (DM / 64), q / (DM / 64), tid); }
        }
    }
    __syncthreads();
    {
        float* Wq_s = (float*)smem; float* key_s = (float*)(smem + 64 * 129 * 4);
        for (int j = bid; j < 2 * 16 * 16 * 2; j += nb) {
            const int kh = j & 1, kt = (j >> 1) & 15, hp = (j >> 5) & 15, L = j >> 9;
            const float* Wq = p.peer_w_q + (size_t)L * DM * 2048 + (size_t)(kt * 64) * 2048 + hp * 128;
            const float* ky = p.peer_sub_keys + (size_t)L * 2 * 128 * 128 + (size_t)(hp & 1) * 128 * 128 + (size_t)(kh * 64) * 128;
            __syncthreads();
#pragma unroll 4
            for (int i = 0; i < 32; ++i) { const int idx = tid + 256 * i, row = idx >> 7, d = idx & 127; Wq_s[row * 129 + d] = Wq[(size_t)row * 2048 + d]; key_s[row * 129 + d] = ky[row * 128 + d]; }
            __syncthreads();
            const int tk = tid & 15, tkey = tid >> 4;
            float acc[4][4];
#pragma unroll
            for (int a = 0; a < 4; ++a)
#pragma unroll
                for (int b = 0; b < 4; ++b) acc[a][b] = 0.f;
            for (int d = 0; d < 128; ++d) {
                float wv[4], kv[4];
#pragma unroll
                for (int a = 0; a < 4; ++a) { wv[a] = Wq_s[(tk * 4 + a) * 129 + d]; kv[a] = key_s[(tkey * 4 + a) * 129 + d]; }
#pragma unroll
                for (int a = 0; a < 4; ++a)
#pragma unroll
                    for (int b = 0; b < 4; ++b) acc[a][b] += kv[a] * wv[b];
            }
            u16* dst = (u16*)(ws + WS_WPQT) + (size_t)L * 2048 * DM;
#pragma unroll
            for (int a = 0; a < 4; ++a) {
                u32x2 o; o.x = pk2(acc[a][0], acc[a][1]); o.y = pk2(acc[a][2], acc[a][3]);
                *(u32x2*)(dst + (size_t)(hp * 128 + kh * 64 + tkey * 4 + a) * DM + kt * 64 + tk * 4) = o;
            }
        }
    }
    {
        f32x2* rr = (f32x2*)(ws + WS_ROPE_R); f32x2* rm = (f32x2*)(ws + WS_ROPE_M);
        for (int i = bid * 256 + tid; i < SEQ * 64; i += nb * 256) {
            const int s = i >> 6, d = i & 63; const float inv = 1.0f / powf(10000.0f, (float)d / 64.0f); const float ang = (float)s * inv;
            float sn, cs; sincosf(ang, &sn, &cs); rr[i] = (f32x2){cs, sn};
        }
        for (int i = bid * 256 + tid; i < SEQ * 32; i += nb * 256) {
            const int s = i >> 5, d = i & 31; const float inv = 1.0f / powf(10000.0f, (float)d / 32.0f); const float ang = (float)s * inv;
            float sn, cs; sincosf(ang, &sn, &cs); rm[i] = (f32x2){cs, sn};
        }
    }
    rmsnorm_rows(p.x, p.norm_mix, (u16*)(ws + WS_H), bid, nb, tid);
}

__device__ __forceinline__ void convert_table_rows(const Params& p, int r0, int r1, int tid) {
    unsigned char* ws = p.ws;
    const int lane = tid & 63, w = tid >> 6;
    for (int row = r0 + w; row < r1; row += 4) {
        const int tb = row >= 2 * NEXP, rr = row - tb * 2 * NEXP;
        const float* srcp = (tb ? p.peer_v : p.peer_u) + (size_t)rr * DM + lane * 16;
        f32x4 v[4]; float am = 0.f;
#pragma unroll
        for (int c = 0; c < 4; ++c) { v[c] = *(const f32x4*)(srcp + c * 4); am = fmaxf(am, fmaxf(fmaxf(fabsf(v[c][0]), fabsf(v[c][1])), fmaxf(fabsf(v[c][2]), fabsf(v[c][3])))); }
#pragma unroll
        for (int o = 32; o >= 1; o >>= 1) am = fmaxf(am, __shfl_xor(am, o));
        am = fmaxf(am, 1e-30f);
        if (tb == 0) {
            const float sc = 384.0f / am;
            u32x4 o4;
#pragma unroll
            for (int c = 0; c < 4; ++c) {
                int pk = __builtin_amdgcn_cvt_pk_fp8_f32(v[c][0] * sc, v[c][1] * sc, 0, false);
                pk = __builtin_amdgcn_cvt_pk_fp8_f32(v[c][2] * sc, v[c][3] * sc, pk, true);
                o4[c] = (unsigned)pk;
            }
            *(u32x4*)(ws + WS_UBF + (size_t)rr * DM + lane * 16) = o4;
            if (lane == 0) ((float*)(ws + WS_USC))[rr] = am * (1.0f / 384.0f);
        } else {
            const float sc = 6.0f / am;
            unsigned p0 = 0u, p1 = 0u;
            p0 = __builtin_amdgcn_cvt_scalef32_pk_fp4_f32(p0, v[0][0] * sc, v[0][1] * sc, 1.0f, 0); p0 = __builtin_amdgcn_cvt_scalef32_pk_fp4_f32(p0, v[0][2] * sc, v[0][3] * sc, 1.0f, 1);
            p0 = __builtin_amdgcn_cvt_scalef32_pk_fp4_f32(p0, v[1][0] * sc, v[1][1] * sc, 1.0f, 2); p0 = __builtin_amdgcn_cvt_scalef32_pk_fp4_f32(p0, v[1][2] * sc, v[1][3] * sc, 1.0f, 3);
            p1 = __builtin_amdgcn_cvt_scalef32_pk_fp4_f32(p1, v[2][0] * sc, v[2][1] * sc, 1.0f, 0); p1 = __builtin_amdgcn_cvt_scalef32_pk_fp4_f32(p1, v[2][2] * sc, v[2][3] * sc, 1.0f, 1);
            p1 = __builtin_amdgcn_cvt_scalef32_pk_fp4_f32(p1, v[3][0] * sc, v[3][1] * sc, 1.0f, 2); p1 = __builtin_amdgcn_cvt_scalef32_pk_fp4_f32(p1, v[3][2] * sc, v[3][3] * sc, 1.0f, 3);
            *(u32x2*)(ws + WS_VBF + (size_t)rr * (DM / 2) + lane * 8) = (u32x2){p0, p1};
            if (lane == 0) ((float*)(ws + WS_VSC))[rr] = am * (1.0f / 6.0f);
        }
    }
}

template <int GM = 0>
__device__ __forceinline__ void phase_inproj(const Params& p, int rbid, int rnb) {
    const int bid = rbid * 2 + vhalf(), nb = rnb * 2;
    unsigned char* ws = p.ws;
    const u16* A = (const u16*)(ws + WS_H); const u16* Bt = (const u16*)(ws + WS_WINT);
    u16* proj = (u16*)(ws + WS_PROJ); float* ssq = (float*)(ws + WS_SSQ); const f32x2* rope = (const f32x2*)(ws + WS_ROPE_R);
    const int tid = opaque((int)threadIdx.x & 255);
    constexpr int NT = HY_IN / 256;
    const int rpb = (4 * NEXP + nb - 1) / nb, nslices = (8 * NT * 8 + rnb - 1) / rnb, rps = (rpb + nslices - 1) / nslices;
    for (int it = 0;; ++it) {
        const bool late = bid >= (nb >> 1);
        if (GM == 0 && !late && it < nslices) { const int rb = bid * rpb, r0 = rb + it * rps, r1 = min(min(r0 + rps, rb + rpb), 4 * NEXP); convert_table_rows(p, r0, r1, tid); }
        if (GM == 0 && late && it >= 1 && it <= nslices) { const int rb = bid * rpb, r0 = rb + (it - 1) * rps, r1 = min(min(r0 + rps, rb + rpb), 4 * NEXP); convert_table_rows(p, r0, r1, tid); }
        int mt, nt; if (!tile_map3<NT>(it, rbid, rnb, mt, nt)) break;
        gemm_tile3(A, DM, Bt, DM, DM, mt * 256, nt * 256, [&](int m0, int n0) {
            const int tid = opaque((int)threadIdx.x & 255);
            const int chunk = m0 >> 7;
            if (n0 >= 2048 && n0 < 3072) {
                const bool isk = n0 >= 2560;
                const float sc = isk ? 0.08838834764831845f : 1.0f;
#pragma unroll
                for (int ps = 0; ps < 4; ++ps) {
                    const int m = ps * 32 + (tid >> 3), c = (tid & 7) * 8;
                    float x1[8], x2[8], y1[8], y2[8]; cs_read8(m, c, x1); cs_read8(m, c + 64, x2);
                    const f32x2* rp = rope + (size_t)((m0 + m) & (SEQ - 1)) * 64 + c;
#pragma unroll
                    for (int e = 0; e < 8; ++e) { const f32x2 cssn = rp[e]; y1[e] = (x1[e] * cssn[0] - x2[e] * cssn[1]) * sc; y2[e] = (x1[e] * cssn[1] + x2[e] * cssn[0]) * sc; }
                    u16* dst = proj + (size_t)(m0 + m) * HY_IN + n0 + c;
                    *(u32x4*)dst = pack8(y1); *(u32x4*)(dst + 64) = pack8(y2);
                    if (isk) {
                        *(f32x4*)(smem + (m * CS_LD + c) * 4) = (f32x4){y1[0], y1[1], y1[2], y1[3]}; *(f32x4*)(smem + (m * CS_LD + c + 4) * 4) = (f32x4){y1[4], y1[5], y1[6], y1[7]};
                        *(f32x4*)(smem + (m * CS_LD + c + 64) * 4) = (f32x4){y2[0], y2[1], y2[2], y2[3]}; *(f32x4*)(smem + (m * CS_LD + c + 68) * 4) = (f32x4){y2[4], y2[5], y2[6], y2[7]};
                    }
                }
                if (isk) { __syncthreads(); cs_store_transposed((u16*)(ws + WS_KT) + ((size_t)chunk * 512 + (n0 - 2560)) * 128, tid); }
            } else if (n0 >= 3072 && n0 < 4096) {
                cs_store_transposed((u16*)(ws + WS_VTR) + ((size_t)chunk * 1024 + (n0 - 3072)) * 128, tid);
            } else if (n0 >= 1024 && n0 < 2048) {
#pragma unroll
                for (int ps = 0; ps < 8; ++ps) {
                    const int m = ps * 16 + (tid >> 4), c = (tid & 15) * 8;
                    float v[8]; cs_read8(m, c, v);
                    float s = 0.f;
#pragma unroll
                    for (int e = 0; e < 8; ++e) { v[e] = gelu_f(v[e]); s += v[e] * v[e]; }
                    s += __shfl_xor(s, 1); s += __shfl_xor(s, 2); s += __shfl_xor(s, 4); s += __shfl_xor(s, 8);
                    if ((tid & 15) == 0) ssq[(size_t)(m0 + m) * 8 + ((n0 - 1024) >> 7)] = s;
                    *(f32x4*)(smem + (m * CS_LD + c) * 4) = (f32x4){v[0], v[1], v[2], v[3]}; *(f32x4*)(smem + (m * CS_LD + c + 4) * 4) = (f32x4){v[4], v[5], v[6], v[7]};
                }
                __syncthreads();
                cs_store_transposed((u16*)(ws + WS_AVT) + ((size_t)chunk * 1024 + (n0 - 1024)) * 128, tid);
            } else {
                const bool is_gate = n0 >= 4096;
#pragma unroll
                for (int ps = 0; ps < 8; ++ps) {
                    const int m = ps * 16 + (tid >> 4), c = (tid & 15) * 8;
                    float v[8]; cs_read8(m, c, v);
#pragma unroll
                    for (int e = 0; e < 8; ++e) v[e] = is_gate ? silu_f(v[e]) : gelu_f(v[e]);
                    *(u32x4*)(proj + (size_t)(m0 + m) * HY_IN + n0 + c) = pack8(v);
                }
            }
        });
    }
}

__device__ __forceinline__ float ret_log2gamma(int h) { return log2f(1.0f - exp2f(-5.0f - (float)h)); }
constexpr int YS_LD = 264;
__device__ __forceinline__ void zero4(f32x16 (&acc)[4][1]) {
#pragma unroll
    for (int i = 0; i < 4; ++i)
#pragma unroll
        for (int r = 0; r < 16; ++r) acc[i][0][r] = 0.f;
}

__device__ __forceinline__ void gmlp_task(const Params& p, int ci, int g, int dh) {
    unsigned char* ws = p.ws;
    const int tid = opaque((int)threadIdx.x & 255), lane = tid & 63, w = tid >> 6, lr = lane & 31, hi = lane >> 5;
    const int m0 = ci * 128, col0 = g * 256 + dh * 128;
    const u16* proj = (const u16*)(ws + WS_PROJ); const float* ssq = (const float*)(ws + WS_SSQ);
    float* r_s = (float*)(smem + 49152);
    __syncthreads();
    if (tid < 128) { const float s = ssq[(size_t)(m0 + tid) * 8 + 2 * g] + ssq[(size_t)(m0 + tid) * 8 + 2 * g + 1]; r_s[tid] = rsqrtf(s * (1.0f / 256.0f) + EPS); }
    f32x16 acc[4][1]; zero4(acc);
    const float* Wg = p.gm_w_s + (size_t)g * 128 * 128;
    for (int kb = 0; kb < 2; ++kb) {
        __syncthreads();
        { u32x4 rr[4]; gload_nat<128>(rr, (const u16*)(ws + WS_AVT) + ((size_t)ci * 1024 + col0) * 128 + kb * 64, 128, tid); sstore_nat<128>(0, rr, tid); }
#pragma unroll 2
        for (int i = 0; i < 8; ++i) {
            const int idx = tid + 256 * i, t = idx >> 4, c4 = idx & 15, s0 = kb * 64 + c4 * 4;
            const f32x4 wv = *(const f32x4*)(Wg + t * 128 + s0);
            float o[4];
#pragma unroll
            for (int e = 0; e < 4; ++e) o[e] = (s0 + e <= t) ? wv[e] * r_s[s0 + e] : 0.f;
            u32x2 pk; pk.x = pk2(o[0], o[1]); pk.y = pk2(o[2], o[3]);
            *(u32x2*)(smem + 16384 + toff_e(t, c4 * 4)) = pk;
        }
        __syncthreads();
        mma_kb<4, 1>(acc, 0, 0, 16384, w * 32, lane);
    }
    __syncthreads();
    const int t = w * 32 + lr;
    const float bs = p.gm_b_s[g * 128 + t];
    u16* Ys = (u16*)smem;
#pragma unroll
    for (int i = 0; i < 4; ++i)
#pragma unroll
        for (int q = 0; q < 4; ++q) {
            const int d = i * 32 + 8 * q + 4 * hi;
            const f32x4 gn = *(const f32x4*)(p.gm_v_norm + col0 + d);
            u32x2 pk; pk.x = pk2(acc[i][0][4 * q] * gn[0] + bs, acc[i][0][4 * q + 1] * gn[1] + bs); pk.y = pk2(acc[i][0][4 * q + 2] * gn[2] + bs, acc[i][0][4 * q + 3] * gn[3] + bs);
            *(u32x2*)(Ys + t * YS_LD + d) = pk;
        }
    __syncthreads();
    u16* y = (u16*)(ws + WS_Y);
#pragma unroll
    for (int ps = 0; ps < 8; ++ps) {
        const int tt = ps * 16 + (tid >> 4), c = (tid & 15) * 8;
        float mv[8], uv[8]; unpack8(*(const u32x4*)(Ys + tt * YS_LD + c), mv); unpack8(*(const u32x4*)(proj + (size_t)(m0 + tt) * HY_IN + col0 + c), uv);
#pragma unroll
        for (int e = 0; e < 8; ++e) mv[e] *= uv[e];
        *(u32x4*)(y + (size_t)(m0 + tt) * HY_OUT + col0 + c) = pack8(mv);
    }
}

__device__ __forceinline__ void ret_ds_task(const Params& p, int ci, int h, int eh) {
    unsigned char* ws = p.ws;
    const int tid = opaque((int)threadIdx.x & 255), lane = tid & 63, w = tid >> 6, lr = lane & 31, hi = lane >> 5;
    const int m0 = ci * 128;
    const u16* proj = (const u16*)(ws + WS_PROJ);
    float* kd_s = (float*)(smem + 49152);
    const float l2g = ret_log2gamma(h);
    __syncthreads();
    if (tid < 128) kd_s[tid] = exp2f((float)(127 - tid) * l2g);
    f32x16 acc[4][1]; zero4(acc);
    for (int kb = 0; kb < 2; ++kb) {
        __syncthreads();
        { u32x4 rr[4]; gload_nat<128>(rr, (const u16*)(ws + WS_KT) + ((size_t)ci * 512 + h * 128) * 128 + kb * 64, 128, tid); sstore_nat<128>(0, rr, tid); }
        load_nat_colscale(16384, (const u16*)(ws + WS_VTR) + ((size_t)ci * 1024 + h * 256 + eh * 128) * 128 + kb * 64, 128, tid, kd_s + kb * 64);
        __syncthreads();
        mma_kb<4, 1>(acc, 0, 0, 16384, w * 32, lane);
    }
    float* dst = (float*)(ws + WS_DST) + (size_t)(ci * 4 + h) * 256 * 128;
#pragma unroll
    for (int i = 0; i < 4; ++i)
#pragma unroll
        for (int q = 0; q < 4; ++q) {
            const int d = i * 32 + 8 * q + 4 * hi, e = eh * 128 + w * 32 + lr;
            f32x4 v = {acc[i][0][4 * q], acc[i][0][4 * q + 1], acc[i][0][4 * q + 2], acc[i][0][4 * q + 3]};
            *(f32x4*)(dst + (size_t)e * 128 + d) = v;
        }
}

__device__ __forceinline__ void phase_mixA(const Params& p, int bid, int nb) {
    for (int t = bid; t < 2048; t += nb) {
        const int ci = t >> 4, sub = (t + ((t / nb) << 3)) & 15;
        if (sub < 8) gmlp_task(p, ci, sub >> 1, sub & 1); else ret_ds_task(p, ci, (sub - 8) >> 1, sub & 1);
    }
}

__device__ __forceinline__ void phase_scan(const Params& p, int bid, int nb) {
    float* base = (float*)(p.ws + WS_DST);
    for (int i = bid * 256 + opaque((int)threadIdx.x & 255); i < 4 * 4 * 256 * 128 / 4; i += nb * 256) {
        const int b = i >> 15, h = (i >> 13) & 3, rest = i & 8191;
        const float cd = exp2f(128.0f * ret_log2gamma(h));
        f32x4 s = {0.f, 0.f, 0.f, 0.f};
        float* ptr = base + ((size_t)(b * 32) * 4 + h) * 32768 + (size_t)rest * 4;
#pragma unroll 8
        for (int n = 0; n < 32; ++n) {
            f32x4* q = (f32x4*)(ptr + (size_t)n * 4 * 32768);
            const f32x4 tmp = *q; *q = s; s = s * cd + tmp;
        }
    }
}

__device__ __forceinline__ void ret_out_task(const Params& p, int ci, int h) {
    unsigned char* ws = p.ws;
    const int tid = opaque((int)threadIdx.x & 255), lane = tid & 63, w = tid >> 6, lr = lane & 31, hi = lane >> 5;
    const int m0 = ci * 128;
    const u16* proj = (const u16*)(ws + WS_PROJ);
    const float l2g = ret_log2gamma(h);
    const int qi = w * 32 + lr;
    constexpr int RA = 0, RB = 16384, RC = 49152;
    __syncthreads();
    {
        u32x4 r0[4], r1[4];
        const u16* qp = proj + (size_t)m0 * HY_IN + 2048 + h * 128; const u16* kp = proj + (size_t)m0 * HY_IN + 2560 + h * 128;
        gload_nat<128>(r0, qp, HY_IN, tid); gload_nat<128>(r1, qp + 64, HY_IN, tid);
        sstore_nat<128>(RC, r0, tid); sstore_nat<128>(RC + 16384, r1, tid);
        gload_nat<128>(r0, kp, HY_IN, tid); gload_nat<128>(r1, kp + 64, HY_IN, tid);
        sstore_nat<128>(RB, r0, tid); sstore_nat<128>(RB + 16384, r1, tid);
    }
    __syncthreads();
    {
        f32x16 sc[4][1]; zero4(sc);
        mma_kb<4, 1>(sc, RB, 0, RC, w * 32, lane);
        mma_kb<4, 1>(sc, RB + 16384, 0, RC + 16384, w * 32, lane);
        __syncthreads();
#pragma unroll
        for (int i = 0; i < 4; ++i)
#pragma unroll
            for (int q = 0; q < 4; ++q) {
                const int j = i * 32 + 8 * q + 4 * hi;
                float o[4];
#pragma unroll
                for (int e = 0; e < 4; ++e) { const int df = qi - (j + e); o[e] = (df >= 0) ? sc[i][0][4 * q + e] * exp2f((float)df * l2g) : 0.f; }
                u32x2 pk; pk.x = pk2(o[0], o[1]); pk.y = pk2(o[2], o[3]);
                *(u32x2*)(smem + RB + (j >> 6) * 16384 + toff_e(qi, j & 63)) = pk;
            }
#pragma unroll 2
        for (int i = 0; i < 8; ++i) {
            const int idx = tid + 256 * i, row = idx >> 4, c16 = idx & 15;
            unsigned char* ptr = smem + RC + (c16 >> 3) * 16384 + toff(row, c16 & 7);
            float f[8]; unpack8(*(const u32x4*)ptr, f);
            const float qd = exp2f((float)(row + 1) * l2g);
#pragma unroll
            for (int e = 0; e < 8; ++e) f[e] *= qd;
            *(u32x4*)ptr = pack8(f);
        }
    }
    const float* st = (const float*)(ws + WS_DST) + (size_t)(ci * 4 + h) * 256 * 128;
    float ssq = 0.f;
    u16* ytmp = (u16*)(ws + WS_Y) + (size_t)(m0 + qi) * HY_OUT + 1024 + h * 256;
    f32x16 acc[4][1];
#pragma unroll
    for (int eh = 0; eh < 2; ++eh) {
        zero4(acc);
        for (int kb = 0; kb < 4; ++kb) {
            __syncthreads();
            if (kb < 2) {
                { u32x4 rr[4]; gload_nat<128>(rr, (const u16*)(ws + WS_VTR) + ((size_t)ci * 1024 + h * 256 + eh * 128) * 128 + kb * 64, 128, tid); sstore_nat<128>(RA, rr, tid); }
            } else {
                const int d0 = (kb - 2) * 64, tq = opaque(tid);
#pragma unroll 2
                for (int i = 0; i < 8; ++i) {
                    const int idx = tq + 256 * i, row = idx >> 4, c4 = idx & 15;
                    const f32x4 v = *(const f32x4*)(st + (size_t)(eh * 128 + row) * 128 + d0 + c4 * 4);
                    u32x2 pk; pk.x = pk2(v[0], v[1]); pk.y = pk2(v[2], v[3]);
                    *(u32x2*)(smem + RA + toff_e(row, c4 * 4)) = pk;
                }
            }
            __syncthreads();
            mma_kb<4, 1>(acc, RA, 0, (kb < 2) ? (RB + kb * 16384) : (RC + (kb - 2) * 16384), w * 32, lane);
        }
#pragma unroll
        for (int i = 0; i < 4; ++i)
#pragma unroll
            for (int r = 0; r < 16; ++r) ssq += acc[i][0][r] * acc[i][0][r];
        if (eh == 0) {
#pragma unroll
            for (int i = 0; i < 4; ++i)
#pragma unroll
                for (int q = 0; q < 4; ++q) {
                    u32x2 pk; pk.x = pk2(acc[i][0][4 * q], acc[i][0][4 * q + 1]); pk.y = pk2(acc[i][0][4 * q + 2], acc[i][0][4 * q + 3]);
                    *(u32x2*)(ytmp + i * 32 + 8 * q + 4 * hi) = pk;
                }
        }
    }
    ssq += __shfl_xor(ssq, 32);
    const float rn = rsqrtf(ssq * (1.0f / 256.0f) + EPS);
    __syncthreads();
    u16* Ys = (u16*)smem;
#pragma unroll
    for (int i = 0; i < 4; ++i)
#pragma unroll
        for (int q = 0; q < 4; ++q) {
            const int e = i * 32 + 8 * q + 4 * hi;
            const f32x4 g0 = *(const f32x4*)(p.ret_norm + h * 256 + e), g1 = *(const f32x4*)(p.ret_norm + h * 256 + 128 + e);
            u32x2 pk; const u32x2 z = *(const u32x2*)(ytmp + e);
            pk.x = pk2(bflo(z.x) * rn * g0[0], bfhi(z.x) * rn * g0[1]); pk.y = pk2(bflo(z.y) * rn * g0[2], bfhi(z.y) * rn * g0[3]);
            *(u32x2*)(Ys + qi * YS_LD + e) = pk;
            pk.x = pk2(acc[i][0][4 * q] * rn * g1[0], acc[i][0][4 * q + 1] * rn * g1[1]); pk.y = pk2(acc[i][0][4 * q + 2] * rn * g1[2], acc[i][0][4 * q + 3] * rn * g1[3]);
            *(u32x2*)(Ys + qi * YS_LD + 128 + e) = pk;
        }
    __syncthreads();
    u16* y = (u16*)(ws + WS_Y);
#pragma unroll 4
    for (int ps = 0; ps < 16; ++ps) {
        const int tt = ps * 8 + (tid >> 5), c = (tid & 31) * 8;
        float mv[8], gv[8]; unpack8(*(const u32x4*)(Ys + tt * YS_LD + c), mv); unpack8(*(const u32x4*)(proj + (size_t)(m0 + tt) * HY_IN + 4096 + h * 256 + c), gv);
#pragma unroll
        for (int e = 0; e < 8; ++e) mv[e] *= gv[e];
        *(u32x4*)(y + (size_t)(m0 + tt) * HY_OUT + 1024 + h * 256 + c) = pack8(mv);
    }
}
__device__ __forceinline__ void phase_mixB(const Params& p, int bid, int nb) {
    for (int t = bid; t < 512; t += nb) ret_out_task(p, t >> 2, t & 3);
}

__device__ __forceinline__ void phase_gemm_residual(const Params& p, const u16* A, int lda, const u16* Bt, int K, const float* xsrc, float* xdst, const float* g, u16* hb, float* ssq2, int bid, int nb) {
    constexpr int NT = DM / 256;
    for (int it = 0;; ++it) {
        int mt, nt; if (!tile_map3<NT>(it, bid, nb, mt, nt)) break;
        gemm_tile3(A, lda, Bt, K, K, mt * 256, nt * 256, [&](int m0, int n0) {
            const int tid = opaque((int)threadIdx.x & 255);
#pragma unroll
            for (int ps = 0; ps < 8; ++ps) {
                const int m = ps * 16 + (tid >> 4), c = (tid & 15) * 8;
                float v[8]; cs_read8(m, c, v);
                const size_t o = (size_t)(m0 + m) * DM + n0 + c;
                const f32x4 a = *(const f32x4*)(xsrc + o), b = *(const f32x4*)(xsrc + o + 4);
                v[0] += a[0]; v[1] += a[1]; v[2] += a[2]; v[3] += a[3]; v[4] += b[0]; v[5] += b[1]; v[6] += b[2]; v[7] += b[3];
                *(f32x4*)(xdst + o) = (f32x4){v[0], v[1], v[2], v[3]}; *(f32x4*)(xdst + o + 4) = (f32x4){v[4], v[5], v[6], v[7]};
                float s = 0.f;
#pragma unroll
                for (int e = 0; e < 8; ++e) s += v[e] * v[e];
                s += __shfl_xor(s, 1); s += __shfl_xor(s, 2); s += __shfl_xor(s, 4); s += __shfl_xor(s, 8);
                if ((tid & 15) == 0) ssq2[(size_t)(m0 + m) * 8 + (n0 >> 7)] = s;
                const f32x4 ga = *(const f32x4*)(g + n0 + c), gb = *(const f32x4*)(g + n0 + c + 4);
                v[0] *= ga[0]; v[1] *= ga[1]; v[2] *= ga[2]; v[3] *= ga[3]; v[4] *= gb[0]; v[5] *= gb[1]; v[6] *= gb[2]; v[7] *= gb[3];
                *(u32x4*)(hb + o) = pack8(v);
            }
        });
    }
}
template <int K, int N>
__device__ __forceinline__ void phase_gemm_f32(const u16* A, const u16* Bt, float* C, int bid, int nb) {
    const int tid = opaque((int)threadIdx.x & 255);
    constexpr int NT = N / 256, lda = K, ldc = N;
    for (int it = 0;; ++it) {
        int mt, nt; if (!tile_map3<NT>(it, bid, nb, mt, nt)) break;
        gemm_tile3(A, lda, Bt, K, K, mt * 256, nt * 256, [&](int m0, int n0) {
            const int tid = opaque((int)threadIdx.x & 255);
#pragma unroll
            for (int ps = 0; ps < 8; ++ps) {
                const int m = ps * 16 + (tid >> 4), c = (tid & 15) * 8;
                float v[8]; cs_read8(m, c, v);
                const size_t o = (size_t)(m0 + m) * ldc + n0 + c;
                f32x4 ra = {v[0], v[1], v[2], v[3]}, rb = {v[4], v[5], v[6], v[7]};
                *(f32x4*)(C + o) = ra; *(f32x4*)(C + o + 4) = rb;
            }
        });
    }
}

__device__ __forceinline__ void ce_desc(float& a, float& b) { const float hi = fmaxf(a, b), lo = fminf(a, b); a = hi; b = lo; }
__device__ __forceinline__ void sort16_desc(float (&v)[16]) {
#pragma unroll
    for (int k = 2; k <= 16; k <<= 1)
#pragma unroll
        for (int j = k >> 1; j > 0; j >>= 1)
#pragma unroll
            for (int i = 0; i < 16; ++i) { const int l = i ^ j; if (l > i) { if ((i & k) == 0) ce_desc(v[i], v[l]); else ce_desc(v[l], v[i]); } }
}
__device__ __forceinline__ void merge16_desc(float (&A)[16], const float (&B)[16]) {
#pragma unroll
    for (int i = 0; i < 16; ++i) A[i] = fmaxf(A[i], B[15 - i]);
#pragma unroll
    for (int j = 8; j > 0; j >>= 1)
#pragma unroll
        for (int i = 0; i < 16; ++i) { const int l = i ^ j; if (l > i) ce_desc(A[i], A[l]); }
}
__device__ __forceinline__ void ins16(float (&L)[16], float e) {
#pragma unroll
    for (int i = 0; i < 16; ++i) { const float hi = fmaxf(L[i], e); e = fminf(L[i], e); L[i] = hi; }
}
__device__ __forceinline__ float row_rscale(const float* ssq2, int t) {
    const f32x4 a = *(const f32x4*)(ssq2 + (size_t)t * 8), b = *(const f32x4*)(ssq2 + (size_t)t * 8 + 4);
    return rsqrtf(((a[0] + a[1]) + (a[2] + a[3]) + (b[0] + b[1]) + (b[2] + b[3])) * (1.0f / DM) + EPS);
}
constexpr int TKA_OFF = 67584;
__device__ __forceinline__ void phase_scores_top16(const Params& p, int L, int bid, int nb) {
    const u16* A = (const u16*)(p.ws + WS_H); const u16* Bt = (const u16*)(p.ws + WS_WPQT) + (size_t)L * 2048 * DM;
    u16* experts = (u16*)(p.ws + WS_EXP); float* gates = (float*)(p.ws + WS_GATE);
    constexpr int NT = 2048 / 256;
    for (int it = 0;; ++it) {
        int mt, nt; if (!tile_map3<NT>(it, bid, nb, mt, nt)) break;
        gemm_tile3(A, DM, Bt, DM, DM, mt * 256, nt * 256, [&](int m0, int n0) {
            const int tid = opaque((int)threadIdx.x & 255);
            const int m = tid >> 1, half = tid & 1;
            float Lst[16];
#pragma unroll
            for (int g = 0; g < 4; ++g) {
                float v[16];
#pragma unroll
                for (int c = 0; c < 4; ++c) {
                    const f32x4 x = *(const f32x4*)(smem + (m * CS_LD + half * 64 + g * 16 + c * 4) * 4);
#pragma unroll
                    for (int e = 0; e < 4; ++e) v[c * 4 + e] = __uint_as_float((__float_as_uint(x[e]) & ~127u) | (unsigned)(half * 64 + g * 16 + c * 4 + e));
                }
                sort16_desc(v);
                if (g == 0) {
#pragma unroll
                    for (int i = 0; i < 16; ++i) Lst[i] = v[i];
                } else merge16_desc(Lst, v);
            }
            float P[16];
#pragma unroll
            for (int i = 0; i < 16; ++i) P[i] = __shfl_xor(Lst[i], 1);
            merge16_desc(Lst, P);
            float* la = (float*)(smem + TKA_OFF);
            if (((n0 >> 7) & 1) == 0) {
                if (half == 0) {
#pragma unroll
                    for (int i = 0; i < 16; ++i) la[i * 128 + m] = Lst[i];
                }
            } else {
                __syncthreads();
                float* lb = (float*)smem;
                if (half == 0) {
#pragma unroll
                    for (int i = 0; i < 16; ++i) lb[i * 128 + m] = Lst[i];
                }
                __syncthreads();
                if (tid < 128) {
                    const int tkn = tid;
                    float a[16];
#pragma unroll
                    for (int i = 0; i < 16; ++i) a[i] = la[i * 128 + tkn];
                    float bq[16];
#pragma unroll
                    for (int i = 0; i < 16; ++i) bq[i] = lb[i * 128 + tkn];
                    float c[16];
#pragma unroll
                    for (int i = 0; i < 16; ++i) c[i] = -INFINITY;
#pragma unroll
                    for (int i = 0; i < 16; ++i)
#pragma unroll
                        for (int j = 0; j < 16; ++j)
                            if ((i + 1) * (j + 1) <= 16) {
                                const float s = __uint_as_float(__float_as_uint(a[i]) & ~127u) + __uint_as_float(__float_as_uint(bq[j]) & ~127u);
                                ins16(c, __uint_as_float((__float_as_uint(s) & ~255u) | (unsigned)(i * 16 + j)));
                            }
                    const int t = m0 + tkn, th = t * 8 + (n0 >> 8);
                    const float rs = row_rscale((const float*)(p.ws + WS_SSQ), t);
                    float bs[16]; unsigned ex[16]; float mx = -INFINITY;
#pragma unroll
                    for (int k = 0; k < 16; ++k) {
                        const unsigned code = __float_as_uint(c[k]) & 255u;
                        const unsigned av = __float_as_uint(la[(code >> 4) * 128 + tkn]), bv = __float_as_uint(lb[(code & 15) * 128 + tkn]);
                        bs[k] = (__uint_as_float(av & ~127u) + __uint_as_float(bv & ~127u)) * rs;
                        ex[k] = (av & 127u) * 128u + (bv & 127u);
                        mx = fmaxf(mx, bs[k]);
                    }
                    float sum = 0.f;
#pragma unroll
                    for (int k = 0; k < 16; ++k) { bs[k] = __expf(bs[k] - mx); sum += bs[k]; }
                    const float inv = 1.0f / sum;
                    u32x4 e0, e1;
                    e0.x = ex[0] | (ex[1] << 16); e0.y = ex[2] | (ex[3] << 16); e0.z = ex[4] | (ex[5] << 16); e0.w = ex[6] | (ex[7] << 16);
                    e1.x = ex[8] | (ex[9] << 16); e1.y = ex[10] | (ex[11] << 16); e1.z = ex[12] | (ex[13] << 16); e1.w = ex[14] | (ex[15] << 16);
                    *(u32x4*)(experts + (size_t)th * 16) = e0; *(u32x4*)(experts + (size_t)th * 16 + 8) = e1;
#pragma unroll
                    for (int k4 = 0; k4 < 4; ++k4) { f32x4 g = {bs[4 * k4] * inv, bs[4 * k4 + 1] * inv, bs[4 * k4 + 2] * inv, bs[4 * k4 + 3] * inv}; *(f32x4*)(gates + (size_t)th * 16 + k4 * 4) = g; }
                }
            }
        });
    }
}

__device__ __forceinline__ void fp4x16_to_f32(const u32x2 r, float* f) {
#define FP4_PAIR(D, B) { const f32x2 pr = __builtin_amdgcn_cvt_scalef32_pk_f32_fp4(r[D], 1.0f, B); f[((D) * 4 + (B)) * 2] = pr[0]; f[((D) * 4 + (B)) * 2 + 1] = pr[1]; }
    FP4_PAIR(0, 0) FP4_PAIR(0, 1) FP4_PAIR(0, 2) FP4_PAIR(0, 3) FP4_PAIR(1, 0) FP4_PAIR(1, 1) FP4_PAIR(1, 2) FP4_PAIR(1, 3)
#undef FP4_PAIR
}
__device__ __forceinline__ float folded_sum8(const float (&d)[8], int lane) {
    float d4[4], d2[2], d1;
#pragma unroll
    for (int k = 0; k < 4; ++k) { const bool up = (lane & 32) != 0; const float keep = up ? d[k + 4] : d[k], send = up ? d[k] : d[k + 4]; d4[k] = keep + __shfl_xor(send, 32); }
#pragma unroll
    for (int k = 0; k < 2; ++k) { const bool up = (lane & 16) != 0; const float keep = up ? d4[k + 2] : d4[k], send = up ? d4[k] : d4[k + 2]; d2[k] = keep + __shfl_xor(send, 16); }
    { const bool up = (lane & 8) != 0; const float keep = up ? d2[1] : d2[0], send = up ? d2[0] : d2[1]; d1 = keep + __shfl_xor(send, 8); }
    d1 += __shfl_xor(d1, 4); d1 += __shfl_xor(d1, 2); d1 += __shfl_xor(d1, 1);
    return d1;
}
__device__ __forceinline__ void fp8x16_to_f32(const u32x4 r, float* f) {
#pragma unroll
    for (int c = 0; c < 4; ++c) {
        const f32x2 lo = __builtin_amdgcn_cvt_pk_f32_fp8((int)r[c], false), hi = __builtin_amdgcn_cvt_pk_f32_fp8((int)r[c], true);
        f[4 * c] = lo[0]; f[4 * c + 1] = lo[1]; f[4 * c + 2] = hi[0]; f[4 * c + 3] = hi[1];
    }
}
__device__ __forceinline__ void sort128(unsigned& k_lo, unsigned& k_hi, int lane) {
#pragma unroll
    for (int k = 2; k <= 128; k <<= 1)
#pragma unroll
        for (int j = k >> 1; j > 0; j >>= 1) {
            if (j == 64) { const unsigned lo = min(k_lo, k_hi), hi2 = max(k_lo, k_hi); k_lo = lo; k_hi = hi2; }
            else {
                const unsigned o_lo = __shfl_xor(k_lo, j), o_hi = __shfl_xor(k_hi, j);
                const bool upper = (lane & j) != 0;
                const bool asc_lo = (k == 128) ? true : ((lane & k) == 0), asc_hi = (k == 128) ? true : (((lane + 64) & k) == 0);
                k_lo = (upper != asc_lo) ? min(k_lo, o_lo) : max(k_lo, o_lo);
                k_hi = (upper != asc_hi) ? min(k_hi, o_hi) : max(k_hi, o_hi);
            }
        }
}
template <int MODE>
__device__ __forceinline__ void phase_peer(const Params& p, int L, const float* gnext, int bid, int nb) {
    const int tid = opaque((int)threadIdx.x & 255), lane = tid & 63, w = tid >> 6;
    const u16* H = (const u16*)(p.ws + WS_H);
    const unsigned char* U = p.ws + WS_UBF + (size_t)L * NEXP * DM; const unsigned char* V = p.ws + WS_VBF + (size_t)L * NEXP * (DM / 2);
    const float* Usc = (const float*)(p.ws + WS_USC) + (size_t)L * NEXP; const float* Vsc = (const float*)(p.ws + WS_VSC) + (size_t)L * NEXP;
    const u16* experts = (const u16*)(p.ws + WS_EXP); const float* gates = (const float*)(p.ws + WS_GATE);
    const int srcl = (((lane & 7) >> 2) & 1) * 32 + (((lane & 7) >> 1) & 1) * 16 + (lane & 1) * 8;
    constexpr int TP = 4;
    for (int tb = (bid * 4 + w) * TP; tb < T; tb += nb * 4 * TP) {
        unsigned k_lo[TP], k_hi[TP]; float w_lo[TP], w_hi[TP];
#pragma unroll
        for (int tk = 0; tk < TP; ++tk) {
            const int t = tb + tk;
            k_lo[tk] = ((unsigned)experts[(size_t)t * 128 + lane] << 7) | (unsigned)lane; k_hi[tk] = ((unsigned)experts[(size_t)t * 128 + 64 + lane] << 7) | (unsigned)(64 + lane);
            sort128(k_lo[tk], k_hi[tk], opaque(lane));
            w_lo[tk] = 0.f; w_hi[tk] = 0.f;
            __builtin_amdgcn_sched_barrier(0);
        }
#pragma unroll 1
        for (int eb = 0; eb < 128; eb += 16) {
#pragma unroll
            for (int tk = 0; tk < TP; ++tk) {
                u32x4 ru[16];
#pragma unroll
                for (int k = 0; k < 16; ++k) {
                    const int e = eb + k;
                    const unsigned ex = __builtin_amdgcn_readlane((e < 64) ? k_lo[tk] : k_hi[tk], e & 63) >> 7;
                    ru[k] = *(const u32x4*)(U + (size_t)ex * DM + lane * 16);
                }
                float xh[16];
                { const u16* hp = H + (size_t)(tb + tk) * DM + lane * 16; unpack8(*(const u32x4*)hp, xh); unpack8(*(const u32x4*)(hp + 8), xh + 8); }
                float dA[8], dB[8];
#pragma unroll
                for (int k = 0; k < 16; ++k) {
                    asm volatile("" : "+v"(ru[k]));
                    float s = 0.f;
                    if (MODE == 3) { s = __uint_as_float(ru[k][0]); } else {
                    float f[16]; fp8x16_to_f32(ru[k], f);
#pragma unroll
                    for (int i = 0; i < 16; ++i) s += f[i] * xh[i];
                    }
                    asm volatile("" : "+v"(s));
                    if (k < 8) dA[k] = s; else dB[k - 8] = s;
                }
                const float sA = folded_sum8(dA, lane), sB = folded_sum8(dB, lane);
                const float vA = __shfl(sA, srcl), vB = __shfl(sB, srcl);
                const int j = (lane & 63) - (eb & 63);
                const float val = ((j & 8) != 0) ? vB : vA;
                if (j >= 0 && j < 16) { if (eb < 64) w_lo[tk] = val; else w_hi[tk] = val; }
                __builtin_amdgcn_sched_barrier(0);
            }
        }
#pragma unroll
        for (int tk = 0; tk < TP; ++tk) {
            const int t = tb + tk;
            const float rs = row_rscale((const float*)(p.ws + WS_SSQ), t);
            const unsigned e0 = k_lo[tk] >> 7, e1 = k_hi[tk] >> 7;
            w_lo[tk] = gelu_f(w_lo[tk] * rs * Usc[e0]) * gates[(size_t)t * 128 + (k_lo[tk] & 127u)] * Vsc[e0];
            w_hi[tk] = gelu_f(w_hi[tk] * rs * Usc[e1]) * gates[(size_t)t * 128 + (k_hi[tk] & 127u)] * Vsc[e1];
        }
        float o[TP][16];
#pragma unroll
        for (int tk = 0; tk < TP; ++tk)
#pragma unroll
            for (int i = 0; i < 16; ++i) o[tk][i] = 0.f;
#pragma unroll 1
        for (int eb = 0; eb < 128; eb += 32) {
#pragma unroll
            for (int tk = 0; tk < TP; ++tk) {
                u32x2 rv[32]; float wk[32];
#pragma unroll
                for (int k = 0; k < 32; ++k) {
                    const int e = eb + k;
                    const unsigned ex = __builtin_amdgcn_readlane((e < 64) ? k_lo[tk] : k_hi[tk], e & 63) >> 7;
                    wk[k] = __uint_as_float(__builtin_amdgcn_readlane(__float_as_uint((e < 64) ? w_lo[tk] : w_hi[tk]), e & 63));
                    rv[k] = *(const u32x2*)(V + (size_t)ex * (DM / 2) + lane * 8);
                }
#pragma unroll
                for (int k = 0; k < 32; ++k) {
                    asm volatile("" : "+v"(rv[k]));
                    if (MODE == 3) { o[tk][k & 15] += __uint_as_float(rv[k][0]); } else {
                    float f[16]; fp4x16_to_f32(rv[k], f);
#pragma unroll
                    for (int i = 0; i < 16; ++i) o[tk][i] += wk[k] * f[i];
                    }
                    asm volatile("" : "+v"(o[tk][0]), "+v"(o[tk][1]), "+v"(o[tk][2]), "+v"(o[tk][3]), "+v"(o[tk][4]), "+v"(o[tk][5]), "+v"(o[tk][6]), "+v"(o[tk][7]),
                                      "+v"(o[tk][8]), "+v"(o[tk][9]), "+v"(o[tk][10]), "+v"(o[tk][11]), "+v"(o[tk][12]), "+v"(o[tk][13]), "+v"(o[tk][14]), "+v"(o[tk][15]));
                }
            }
        }
#pragma unroll
        for (int tk = 0; tk < TP; ++tk) {
            const int t = tb + tk;
            float* xr = ((MODE >= 2) ? (float*)(p.ws + WS_PROJ) : p.out) + (size_t)t * DM + lane * 16;
            if (MODE >= 2) {
#pragma unroll
                for (int c = 0; c < 4; ++c) *(f32x4*)(xr + 4 * c) = (f32x4){o[tk][4 * c], o[tk][4 * c + 1], o[tk][4 * c + 2], o[tk][4 * c + 3]};
                continue;
            }
            float xv[16];
#pragma unroll
            for (int c = 0; c < 4; ++c) { const f32x4 a = *(const f32x4*)(xr + 4 * c); xv[4 * c] = a[0]; xv[4 * c + 1] = a[1]; xv[4 * c + 2] = a[2]; xv[4 * c + 3] = a[3]; }
            float ss = 0.f;
#pragma unroll
            for (int i = 0; i < 16; ++i) { xv[i] += o[tk][i]; ss += xv[i] * xv[i]; }
            ss = wave_sum(ss);
            const float rn = rsqrtf(ss * (1.0f / DM) + EPS);
            float gv[16];
#pragma unroll
            for (int c = 0; c < 4; ++c) { const f32x4 a = *(const f32x4*)(gnext + lane * 16 + 4 * c); gv[4 * c] = a[0]; gv[4 * c + 1] = a[1]; gv[4 * c + 2] = a[2]; gv[4 * c + 3] = a[3]; }
            if (MODE == 0) {
#pragma unroll
                for (int c = 0; c < 4; ++c) *(f32x4*)(xr + 4 * c) = (f32x4){xv[4 * c], xv[4 * c + 1], xv[4 * c + 2], xv[4 * c + 3]};
                float hv[16];
#pragma unroll
                for (int i = 0; i < 16; ++i) hv[i] = xv[i] * rn * gv[i];
                u16* hp = (u16*)(p.ws + WS_H) + (size_t)t * DM + lane * 16;
                *(u32x4*)hp = pack8(hv); *(u32x4*)(hp + 8) = pack8(hv + 8);
            } else {
#pragma unroll
                for (int c = 0; c < 4; ++c) *(f32x4*)(xr + 4 * c) = (f32x4){xv[4 * c] * rn * gv[4 * c], xv[4 * c + 1] * rn * gv[4 * c + 1], xv[4 * c + 2] * rn * gv[4 * c + 2], xv[4 * c + 3] * rn * gv[4 * c + 3]};
            }
        }
    }
}

__device__ __forceinline__ void phase_mla_norm(const Params& p, int bid, int nb) {
    const int tid = opaque((int)threadIdx.x & 255), lane = tid & 63, w = tid >> 6;
    const float* down = (const float*)(p.ws + WS_DOWN);
    u16* cqn = (u16*)(p.ws + WS_CQN); u16* ckvn = (u16*)(p.ws + WS_CKVN); u16* kr = (u16*)(p.ws + WS_KROPE);
    const f32x2* rope = (const f32x2*)(p.ws + WS_ROPE_M);
    for (int t = bid * 4 + w; t < T; t += nb * 4) {
        const float* dr = down + (size_t)t * MLA_DOWN_PAD;
        float q[6], kv[4];
#pragma unroll
        for (int i = 0; i < 6; ++i) q[i] = dr[i * 64 + lane];
#pragma unroll
        for (int i = 0; i < 4; ++i) kv[i] = dr[384 + i * 64 + lane];
        const float rp = dr[640 + lane];
        float sq = 0.f, sk = 0.f;
#pragma unroll
        for (int i = 0; i < 6; ++i) sq += q[i] * q[i];
#pragma unroll
        for (int i = 0; i < 4; ++i) sk += kv[i] * kv[i];
        sq = wave_sum(sq); sk = wave_sum(sk);
        const float rq = rsqrtf(sq * (1.0f / MLA_QR) + EPS), rk = rsqrtf(sk * (1.0f / MLA_KVR) + EPS);
#pragma unroll
        for (int i = 0; i < 6; ++i) cqn[(size_t)t * MLA_QR + i * 64 + lane] = f2bf(q[i] * rq * p.mla_q_norm[i * 64 + lane]);
#pragma unroll
        for (int i = 0; i < 4; ++i) ckvn[(size_t)t * MLA_KVR + i * 64 + lane] = f2bf(kv[i] * rk * p.mla_kv_norm[i * 64 + lane]);
        const float other = __shfl_xor(rp, 32);
        const f32x2 cssn = rope[(size_t)(t & (SEQ - 1)) * 32 + (lane & 31)];
        const float res = (lane < 32) ? (rp * cssn[0] - other * cssn[1]) : (other * cssn[1] + rp * cssn[0]);
        kr[(size_t)t * 64 + lane] = f2bf(res);
    }
}

__device__ __forceinline__ void phase_mla_up(const Params& p, int bid, int nb) {
    const int tid = opaque((int)threadIdx.x & 255);
    unsigned char* ws = p.ws;
    const f32x2* rope = (const f32x2*)(ws + WS_ROPE_M);
    u16* qo = (u16*)(ws + WS_Q); u16* kvo = (u16*)(ws + WS_KV);
    constexpr int NTQ = 1536 / 256, NTKV = 2048 / 256, NTT = NTQ + NTKV;
    for (int it = 0;; ++it) {
        int mt, nt; if (!tile_map3<NTT>(it, bid, nb, mt, nt)) break;
        if (nt < NTQ) {
            gemm_tile3((const u16*)(ws + WS_CQN), MLA_QR, (const u16*)(ws + WS_WQUPT), MLA_QR, MLA_QR, mt * 256, nt * 256, [&](int m0, int n0) {
            const int tid = opaque((int)threadIdx.x & 255);
#pragma unroll
                for (int ps = 0; ps < 8; ++ps) {
                    const int m = ps * 16 + (tid >> 4), c = (tid & 15) * 8;
                    const int within = (n0 + c) % 192;
                    u16* dst = qo + (size_t)(m0 + m) * 1536 + n0 + c;
                    if (within < 128) { float v[8]; cs_read8(m, c, v); *(u32x4*)dst = pack8(v); }
                    else if (within < 160) {
                        float x1[8], x2[8], y1[8], y2[8]; cs_read8(m, c, x1); cs_read8(m, c + 32, x2);
                        const f32x2* rp = rope + (size_t)((m0 + m) & (SEQ - 1)) * 32 + (within - 128);
#pragma unroll
                        for (int e = 0; e < 8; ++e) { const f32x2 cssn = rp[e]; y1[e] = x1[e] * cssn[0] - x2[e] * cssn[1]; y2[e] = x1[e] * cssn[1] + x2[e] * cssn[0]; }
                        *(u32x4*)dst = pack8(y1); *(u32x4*)(dst + 32) = pack8(y2);
                    }
                }
            });
        } else {
            gemm_tile3((const u16*)(ws + WS_CKVN), MLA_KVR, (const u16*)(ws + WS_WKVUPT), MLA_KVR, MLA_KVR, mt * 256, (nt - NTQ) * 256, [&](int m0, int n0) {
            const int tid = opaque((int)threadIdx.x & 255);
                const int head = n0 >> 8;
                if (((n0 >> 7) & 1) == 0) {
#pragma unroll
                    for (int ps = 0; ps < 8; ++ps) {
                        const int m = ps * 16 + (tid >> 4), c = (tid & 15) * 8;
                        float v[8]; cs_read8(m, c, v);
                        *(u32x4*)(kvo + (size_t)(m0 + m) * 1024 + head * 128 + c) = pack8(v);
                    }
                } else {
                    u16* vT = kvo + (size_t)T * 1024 + ((size_t)((m0 >> 12) * 8 + head) * 128) * SEQ + (m0 & (SEQ - 1));
#pragma unroll
                    for (int ps = 0; ps < 8; ++ps) {
                        const int dv = ps * 16 + (tid >> 4), tk8 = (tid & 15) * 8;
                        float v[8];
#pragma unroll
                        for (int e = 0; e < 8; ++e) v[e] = *(const float*)(smem + ((tk8 + e) * CS_LD + dv) * 4);
                        *(u32x4*)(vT + (size_t)dv * SEQ + tk8) = pack8(v);
                    }
                }
            });
        }
    }
}

__device__ __forceinline__ int crow(int r, int hi) { return (r & 3) + 8 * (r >> 2) + 4 * hi; }
template <int ROWS, bool PERM>
__device__ __forceinline__ void glds_rows(int lds, const u16* src, size_t ld, int tid) {
    const int lane = tid & 63, w = tid >> 6;
#pragma unroll
    for (int i = 0; i < ROWS / 32; ++i) {
        const int r0 = (w * (ROWS / 32) + i) * 8, r = r0 + (lane >> 3), c8 = (lane & 7) ^ ((r >> 1) & 7);
        const int sr = PERM ? ((r & ~12) | ((r & 4) << 1) | ((r & 8) >> 1)) : r;
        __builtin_amdgcn_global_load_lds((const unsigned*)(src + (size_t)sr * ld + c8 * 8), (unsigned*)(smem + lds + r0 * 128), 16, 0, 0);
    }
}
constexpr int ATT_STAGE = 40960;
__device__ __forceinline__ void attn_task(const Params& p, int b, int h, int qb) {
    unsigned char* ws = p.ws;
    const int tid = opaque((int)threadIdx.x & 255), lane = tid & 63, w = tid >> 6, lr = lane & 31, hi = lane >> 5;
    const u16* Q = (const u16*)(ws + WS_Q); const u16* KN = (const u16*)(ws + WS_KV); const u16* KR = (const u16*)(ws + WS_KROPE);
    const u16* VT = KN + (size_t)T * 1024 + (size_t)((b * 8 + h) * 128) * SEQ;
    const int t0 = b * SEQ, q0 = qb * 128, qrow = q0 + w * 32 + lr;
    const int ntiles = (q0 + 128) >> 6;
    __syncthreads();
    bf16x8 qf[12];
#pragma unroll
    for (int s = 0; s < 12; ++s) qf[s] = *(const bf16x8*)(Q + (size_t)(t0 + qrow) * 1536 + h * 192 + s * 16 + hi * 8);
    auto fill = [&](int jt, int st) {
        const int j0 = jt * 64;
        glds_rows<64, true>(st, KN + (size_t)(t0 + j0) * 1024 + h * 128, 1024, tid);
        glds_rows<64, true>(st + 8192, KN + (size_t)(t0 + j0) * 1024 + h * 128 + 64, 1024, tid);
        glds_rows<64, true>(st + 16384, KR + (size_t)(t0 + j0) * 64, 64, tid);
        glds_rows<128, false>(st + 24576, VT + j0, SEQ, tid);
    };
    fill(0, 0);
    f32x16 o[4];
#pragma unroll
    for (int i = 0; i < 4; ++i)
#pragma unroll
        for (int r = 0; r < 16; ++r) o[i][r] = 0.f;
    float m = -1e30f, l = 0.f;
    const float c2 = 0.07216878364870322f * 1.4426950408889634f;
    for (int jt = 0; jt < ntiles; ++jt) {
        const int j0 = jt * 64, st = (jt & 1) * ATT_STAGE;
        asm volatile("s_waitcnt vmcnt(0)" ::: "memory");
        __syncthreads();
        if (jt + 1 < ntiles) fill(jt + 1, st ^ ATT_STAGE);
        f32x16 s0, s1;
#pragma unroll
        for (int r = 0; r < 16; ++r) { s0[r] = 0.f; s1[r] = 0.f; }
#pragma unroll
        for (int kbk = 0; kbk < 3; ++kbk) {
            bf16x8 a0[4], a1[4];
#pragma unroll
            for (int s = 0; s < 4; ++s) { const int c8 = 2 * s + hi; a0[s] = *(const bf16x8*)(smem + st + kbk * 8192 + toff(lr, c8)); a1[s] = *(const bf16x8*)(smem + st + kbk * 8192 + toff(32 + lr, c8)); }
            __builtin_amdgcn_sched_barrier(0);
#pragma unroll
            for (int s = 0; s < 4; ++s) {
                s0 = __builtin_amdgcn_mfma_f32_32x32x16_bf16(a0[s], qf[kbk * 4 + s], s0, 0, 0, 0);
                s1 = __builtin_amdgcn_mfma_f32_32x32x16_bf16(a1[s], qf[kbk * 4 + s], s1, 0, 0, 0);
            }
            __builtin_amdgcn_sched_barrier(0);
        }
        if (j0 + 63 > q0 + w * 32) {
#pragma unroll
            for (int r = 0; r < 16; ++r) {
                const int ko = 16 * (r >> 3) + 8 * hi + 4 * ((r >> 2) & 1) + (r & 3);
                if (j0 + ko > qrow) s0[r] = -INFINITY;
                if (j0 + 32 + ko > qrow) s1[r] = -INFINITY;
            }
        }
        float mx = s0[0];
#pragma unroll
        for (int r = 1; r < 16; ++r) mx = fmaxf(mx, s0[r]);
#pragma unroll
        for (int r = 0; r < 16; ++r) mx = fmaxf(mx, s1[r]);
        mx = fmaxf(mx, __shfl_xor(mx, 32));
        const float mn = fmaxf(m, mx), alpha = __builtin_amdgcn_exp2f((m - mn) * c2), nmc = -mn * c2;
        m = mn;
        float rs = 0.f;
#pragma unroll
        for (int r = 0; r < 16; ++r) { s0[r] = __builtin_amdgcn_exp2f(fmaf(s0[r], c2, nmc)); s1[r] = __builtin_amdgcn_exp2f(fmaf(s1[r], c2, nmc)); rs += s0[r] + s1[r]; }
        l = l * alpha + rs;
#pragma unroll
        for (int i = 0; i < 4; ++i)
#pragma unroll
            for (int r = 0; r < 16; ++r) o[i][r] *= alpha;
        bf16x8 pf[4];
#pragma unroll
        for (int ks = 0; ks < 4; ++ks) {
            u32x4 wv; const int bs = 8 * (ks & 1);
            if (ks < 2) { wv.x = pk2(s0[bs], s0[bs + 1]); wv.y = pk2(s0[bs + 2], s0[bs + 3]); wv.z = pk2(s0[bs + 4], s0[bs + 5]); wv.w = pk2(s0[bs + 6], s0[bs + 7]); }
            else { wv.x = pk2(s1[bs], s1[bs + 1]); wv.y = pk2(s1[bs + 2], s1[bs + 3]); wv.z = pk2(s1[bs + 4], s1[bs + 5]); wv.w = pk2(s1[bs + 6], s1[bs + 7]); }
            pf[ks] = __builtin_bit_cast(bf16x8, wv);
        }
#pragma unroll
        for (int kh = 0; kh < 2; ++kh) {
            bf16x8 av[2][4];
#pragma unroll
            for (int k2 = 0; k2 < 2; ++k2)
#pragma unroll
                for (int dvb = 0; dvb < 4; ++dvb) av[k2][dvb] = *(const bf16x8*)(smem + st + 24576 + toff(dvb * 32 + lr, 2 * (kh * 2 + k2) + hi));
            __builtin_amdgcn_sched_barrier(0);
#pragma unroll
            for (int k2 = 0; k2 < 2; ++k2)
#pragma unroll
                for (int dvb = 0; dvb < 4; ++dvb) o[dvb] = __builtin_amdgcn_mfma_f32_32x32x16_bf16(av[k2][dvb], pf[kh * 2 + k2], o[dvb], 0, 0, 0);
            __builtin_amdgcn_sched_barrier(0);
        }
    }
    l += __shfl_xor(l, 32);
    const float inv = 1.0f / l;
    __syncthreads();
    u16* Os = (u16*)smem;
#pragma unroll
    for (int dvb = 0; dvb < 4; ++dvb)
#pragma unroll
        for (int q = 0; q < 4; ++q) {
            const int dv = dvb * 32 + 8 * q + 4 * hi;
            u32x2 pk; pk.x = pk2(o[dvb][4 * q] * inv, o[dvb][4 * q + 1] * inv); pk.y = pk2(o[dvb][4 * q + 2] * inv, o[dvb][4 * q + 3] * inv);
            *(u32x2*)(Os + (w * 32 + lr) * 136 + dv) = pk;
        }
    __syncthreads();
    u16* O = (u16*)(ws + WS_O);
#pragma unroll
    for (int ps = 0; ps < 8; ++ps) {
        const int qq = ps * 16 + (tid >> 4), c = (tid & 15) * 8;
        *(u32x4*)(O + (size_t)(t0 + q0 + qq) * DM + h * 128 + c) = *(const u32x4*)(Os + qq * 136 + c);
    }
}
__device__ __forceinline__ void phase_attn(const Params& p, int bid, int nb) {
    const int x = bid & 7, lb = bid >> 3, nlb = nb >> 3, vh = vhalf();
    for (int it = 0;; ++it) {
        const int c = it * nlb + lb;
        if (c >= 64) break;
        const int bh = x * 4 + (c >> 5) * 2 + vh, q = c & 31, qb = (it & 1) ? q : 31 - q;
        attn_task(p, bh >> 3, bh & 7, qb);
    }
}

#define XB_TMO      128
#define XB_XCNT(j)  (256  + 64 * (j))
#define XB_XSUB(j)  (1280 + 64 * (j))
#define XB_XGEN(j)  (2304 + 64 * (j))
#define XB_TOP      3328
#define XB_TOPGEN   3392
#define XCD_BAR_WORDS 3456
#define XB_SPIN_CAP (1u << 22)
#define LAS __attribute__((address_space(3)))
__device__ __forceinline__ unsigned xb_ld(unsigned* p)              { return __hip_atomic_load(p, __ATOMIC_RELAXED, __HIP_MEMORY_SCOPE_AGENT); }
__device__ __forceinline__ unsigned xb_add(unsigned* p, unsigned v) { return __hip_atomic_fetch_add(p, v, __ATOMIC_RELAXED, __HIP_MEMORY_SCOPE_AGENT); }
__device__ __forceinline__ unsigned xb_xcc_id() { return (unsigned)__builtin_amdgcn_s_getreg((3 << 11) | 20) & 0xFu; }
#define XB_SPIN(cond, bar) do { unsigned _sp = 0; while (cond) { __builtin_amdgcn_s_sleep(1); \
    if ((++_sp & 255u) == 0u) { if (xb_ld(&(bar)[XB_TMO])) break; if (_sp > XB_SPIN_CAP) { atomicAdd(&(bar)[XB_TMO], 1u); break; } } } } while (0)
__device__ __forceinline__ void xcd_barrier_complete(unsigned* bar, unsigned x, unsigned& nloc, unsigned& nx) {
    const unsigned G = gridDim.x;
    unsigned sum, cnt, mine, sp = 0u;
    for (;;) {
        sum = 0u; cnt = 0u; mine = 0u;
#pragma unroll
        for (unsigned j = 0; j < 16; ++j) { const unsigned c = xb_ld(&bar[XB_XCNT(j)]); sum += c; cnt += (c > 0u) ? 1u : 0u; mine = (j == x) ? c : mine; }
        if (sum == G) break;
        __builtin_amdgcn_s_sleep(1);
        if ((++sp & 255u) == 0u) { if (xb_ld(&bar[XB_TMO])) break; if (sp > XB_SPIN_CAP) { atomicAdd(&bar[XB_TMO], 1u); break; } }
    }
    nloc = mine > 0u ? mine : 1u; nx = cnt > 0u ? cnt : 1u;
}
__device__ __forceinline__ void xcd_barrier(unsigned* bar, unsigned nloc, unsigned nx) {
    asm volatile("s_waitcnt vmcnt(0)" ::: "memory");
    __syncthreads();
    if (threadIdx.x == 0) {
        const unsigned x = xb_xcc_id();
        __builtin_amdgcn_s_waitcnt(0);
        const unsigned old = xb_add(&bar[XB_XSUB(x)], 1u);
        const unsigned gen = old / nloc;
        if (old + 1u == (gen + 1u) * nloc) {
            __builtin_amdgcn_fence(__ATOMIC_RELEASE, "agent");
            asm volatile("s_waitcnt vmcnt(0)" ::: "memory");
            const unsigned og = xb_add(&bar[XB_TOP], 1u);
            const unsigned tg = og / nx;
            if (og + 1u == (tg + 1u) * nx) xb_add(&bar[XB_TOPGEN], 1u);
            else XB_SPIN(xb_ld(&bar[XB_TOPGEN]) == tg, bar);
            __builtin_amdgcn_fence(__ATOMIC_ACQUIRE, "agent");
            xb_add(&bar[XB_XGEN(x)], 1u);
            asm volatile("s_waitcnt vmcnt(0)" ::: "memory");
        } else {
            XB_SPIN(xb_ld(&bar[XB_XGEN(x)]) == gen, bar);
            __builtin_amdgcn_fence(__ATOMIC_ACQUIRE, "agent");
            asm volatile("s_waitcnt vmcnt(0)" ::: "memory");
        }
    }
    __syncthreads();
}

constexpr int NPHASES = 15;
template <int PH>
__device__ __forceinline__ void run_phase(const Params& p, int rbid, int rnb) {
    unsigned char* ws = p.ws;
    u16* hb = (u16*)(ws + WS_H); float* ssq2 = (float*)(ws + WS_SSQ);
    constexpr bool REAL = (PH == 1 || PH == 5 || PH == 6 || PH == 8 || PH == 10 || PH == 11 || PH == 12 || PH == 13);
    const int bid = REAL ? rbid : rbid * 2 + vhalf(), nb = REAL ? rnb : rnb * 2;
    if constexpr (PH == 0) phase_prep(p, bid, nb);
    else if constexpr (PH == 1) phase_inproj(p, bid, nb);
    else if constexpr (PH == 2) phase_mixA(p, bid, nb);
    else if constexpr (PH == 3) phase_scan(p, bid, nb);
    else if constexpr (PH == 4) phase_mixB(p, bid, nb);
    else if constexpr (PH == 5) phase_gemm_residual(p, (const u16*)(ws + WS_Y), HY_OUT, (const u16*)(ws + WS_WOUTT), HY_OUT, p.x, p.out, p.norm_ffn, hb, ssq2, bid, nb);
    else if constexpr (PH == 6) phase_scores_top16(p, 0, bid, nb);
    else if constexpr (PH == 7) phase_peer<0>(p, 0, p.norm_mix + DM, bid, nb);
    else if constexpr (PH == 8) phase_gemm_f32<DM, MLA_DOWN_PAD>((const u16*)(ws + WS_H), (const u16*)(ws + WS_WDOWNT), (float*)(ws + WS_DOWN), bid, nb);
    else if constexpr (PH == 9) phase_mla_norm(p, bid, nb);
    else if constexpr (PH == 10) phase_mla_up(p, bid, nb);
    else if constexpr (PH == 11) phase_attn(p, bid, nb);
    else if constexpr (PH == 12) phase_gemm_residual(p, (const u16*)(ws + WS_O), DM, (const u16*)(ws + WS_WMOT), DM, p.out, p.out, p.norm_ffn + DM, hb, ssq2, bid, nb);
    else if constexpr (PH == 13) phase_scores_top16(p, 1, bid, nb);
    else if constexpr (PH == 14) phase_peer<1>(p, 1, p.final_norm, bid, nb);
}

typedef const __attribute__((address_space(4))) unsigned long long* cptr64;
typedef __attribute__((address_space(1))) unsigned char* gptr8;
__device__ __forceinline__ void load_params(Params& r, cptr64 s) {
    const float** f = (const float**)&r;
#pragma unroll
    for (int i = 0; i < 20; ++i) f[i] = (const float*)(gptr8)s[i];
    r.out = (float*)(gptr8)s[20]; r.ws = (unsigned char*)(gptr8)s[21];
}
#ifdef PROBE_A_LO
__device__ __forceinline__ void probe_stamp(cptr64 ka, int k) {
    if (blockIdx.x == 0 && threadIdx.x == 0) { unsigned long long* ts = (unsigned long long*)((unsigned char*)ka[21] + WS_TS); __hip_atomic_store(&ts[k], (unsigned long long)__builtin_amdgcn_s_memrealtime(), __ATOMIC_RELAXED, __HIP_MEMORY_SCOPE_AGENT); }
}
__device__ __forceinline__ void probe_emit(cptr64 ka) {
    unsigned long long* ts = (unsigned long long*)((unsigned char*)ka[21] + WS_TS);
    const float ta = (float)(long long)(__hip_atomic_load(&ts[PROBE_A_HI], __ATOMIC_RELAXED, __HIP_MEMORY_SCOPE_AGENT) - __hip_atomic_load(&ts[PROBE_A_LO], __ATOMIC_RELAXED, __HIP_MEMORY_SCOPE_AGENT)) * 0.01f;
    const float tb = (float)(long long)(__hip_atomic_load(&ts[PROBE_B_HI], __ATOMIC_RELAXED, __HIP_MEMORY_SCOPE_AGENT) - __hip_atomic_load(&ts[PROBE_B_LO], __ATOMIC_RELAXED, __HIP_MEMORY_SCOPE_AGENT)) * 0.01f;
    float* out = (float*)ka[20];
    for (int i = blockIdx.x * 256 + threadIdx.x; i < 1024 * DM; i += gridDim.x * 256) out[i] += tb * 0.01f;
    if (blockIdx.x == 0 && threadIdx.x == 0) out[(size_t)T * DM - 1] = ta;
}
#endif
#ifndef DUP_MASK
#define DUP_MASK 0u
#endif
template <int PH>
__device__ __forceinline__ void run_dup(const Params& lp, int bid, int nb) {
    unsigned char* ws = lp.ws;
    if constexpr (PH == 7) phase_peer<2>(lp, 0, lp.norm_mix + DM, bid, nb);
    else if constexpr (PH == 14) phase_peer<2>(lp, 1, lp.final_norm, bid, nb);
    else if constexpr (PH == 12) phase_gemm_residual(lp, (const u16*)(ws + WS_O), DM, (const u16*)(ws + WS_WMOT), DM, lp.out, (float*)(ws + WS_PROJ), lp.norm_ffn + DM, (u16*)(ws + WS_PROJ + (size_t)T * DM * 4), (float*)(ws + WS_PROJ + (size_t)T * DM * 6), bid, nb);
    else if constexpr (PH == 3) {}
#ifdef PROBE_GM
    else if constexpr (PH == 1) phase_inproj<PROBE_GM>(lp, bid, nb);
#endif
    else run_phase<PH>(lp, bid, nb);
}
template <int PH>
__device__ __forceinline__ void run_from(cptr64 ka, unsigned nloc, unsigned nx) {
#ifdef PROBE_A_LO
    probe_stamp(ka, PH);
#endif
    if constexpr (((DUP_MASK >> PH) & 1u) != 0u) {
        cptr64 q = ka; asm volatile("" : "+s"(q));
        Params lp; load_params(lp, q);
        run_dup<PH>(lp, (int)blockIdx.x, (int)gridDim.x);
        xcd_barrier((unsigned*)((unsigned char*)q[21] + WS_BAR), nloc, nx);
    }
    {
        cptr64 q = ka; asm volatile("" : "+s"(q));
        Params lp; load_params(lp, q);
        run_phase<PH>(lp, (int)blockIdx.x, (int)gridDim.x);
    }
    if constexpr (PH + 1 < NPHASES) {
        cptr64 q = ka; asm volatile("" : "+s"(q));
        xcd_barrier((unsigned*)((unsigned char*)q[21] + WS_BAR), nloc, nx);
        run_from<PH + 1>(ka, nloc, nx);
    }
#ifdef PROBE_A_LO
    else {
        cptr64 q = ka; asm volatile("" : "+s"(q));
        xcd_barrier((unsigned*)((unsigned char*)q[21] + WS_BAR), nloc, nx);
        probe_stamp(ka, NPHASES);
        xcd_barrier((unsigned*)((unsigned char*)q[21] + WS_BAR), nloc, nx);
        probe_emit(ka);
    }
#endif
}
__global__ void __launch_bounds__(NTHREADS, 2) k_mega(Params p_unused) {
    cg::grid_group grid = cg::this_grid();
    cptr64 ka = (cptr64)__builtin_amdgcn_kernarg_segment_ptr();
    unsigned* bar = (unsigned*)((unsigned char*)ka[21] + WS_BAR);
    if (threadIdx.x == 0) (void)xb_add(&bar[XB_XCNT(xb_xcc_id())], 1u);
#ifdef PROBE_A_LO
    probe_stamp(ka, 0);
#endif
    {
        cptr64 q = ka; asm volatile("" : "+s"(q));
        Params lp; load_params(lp, q);
        run_phase<0>(lp, (int)blockIdx.x, (int)gridDim.x);
    }
    if constexpr ((DUP_MASK & 1u) != 0u) {
        __syncthreads();
        cptr64 q = ka; asm volatile("" : "+s"(q));
        Params lp; load_params(lp, q);
        run_phase<0>(lp, (int)blockIdx.x, (int)gridDim.x);
    }
    unsigned nloc, nx;
    {
        const unsigned x = xb_xcc_id(), G = gridDim.x;
        unsigned cnt, mine, sum, sp = 0u;
        for (;;) {
            sum = 0u; cnt = 0u; mine = 0u;
#pragma unroll
            for (unsigned j = 0; j < 16; ++j) { const unsigned c = __builtin_amdgcn_readfirstlane(xb_ld(&bar[XB_XCNT(j)])); sum += c; cnt += (c > 0u) ? 1u : 0u; mine = (j == x) ? c : mine; }
            if (sum == G) break;
            __builtin_amdgcn_s_sleep(2);
            if (++sp > XB_SPIN_CAP) break;
        }
        nloc = __builtin_amdgcn_readfirstlane(mine > 0u ? mine : 1u); nx = __builtin_amdgcn_readfirstlane(cnt > 0u ? cnt : 1u);
    }
    xcd_barrier(bar, nloc, nx);
    run_from<1>(ka, nloc, nx);
}

extern "C" void kernel_launch(void* const* d_in, const int* in_sizes, int n_in, void* d_out, int out_size, void* d_ws, size_t ws_size, hipStream_t stream) {
    if (n_in != 20 || out_size != T * DM || ws_size < WS_END) { fprintf(stderr, "kernel_launch: unexpected shapes (n_in %d out %d ws %zu need %zu)\n", n_in, out_size, ws_size, (size_t)WS_END); return; }
    static int grid_blocks = 0;
    if (!grid_blocks) {
        int dev = 0, cus = 0, per_cu = 0;
        (void)hipGetDevice(&dev);
        (void)hipDeviceGetAttribute(&cus, hipDeviceAttributeMultiprocessorCount, dev);
        if (hipFuncSetAttribute((const void*)k_mega, hipFuncAttributeMaxDynamicSharedMemorySize, LDS_TOTAL) != hipSuccess) { fprintf(stderr, "kernel_launch: hipFuncSetAttribute failed\n"); return; }
        if (hipOccupancyMaxActiveBlocksPerMultiprocessor(&per_cu, (const void*)k_mega, NTHREADS, LDS_TOTAL) != hipSuccess || per_cu < 1) { fprintf(stderr, "kernel_launch: occupancy query failed (%d)\n", per_cu); return; }
        if (per_cu > 1) per_cu = 1;
        grid_blocks = cus * per_cu;
        fprintf(stderr, "kernel_launch: %d CUs x %d blocks\n", cus, per_cu);
    }
    Params p{};
    const float** f = (const float**)&p;
    for (int i = 0; i < 20; ++i) f[i] = (const float*)d_in[i];
    p.out = (float*)d_out; p.ws = (unsigned char*)d_ws;
    (void)hipMemsetAsync((unsigned char*)d_ws + WS_BAR, 0, 16384, stream);
    void* args[] = {&p};
    hipError_t e = hipLaunchCooperativeKernel((const void*)k_mega, dim3(grid_blocks), dim3(NTHREADS), args, LDS_TOTAL, stream);
    if (e != hipSuccess) fprintf(stderr, "cooperative launch failed: %s (grid %d)\n", hipGetErrorString(e), grid_blocks);
}
```

```cpp
#include <hip/hip_runtime.h>
#include <hip/hip_cooperative_groups.h>
#include <cstdint>
#include <cstdio>
namespace cg = cooperative_groups;

typedef unsigned short u16;
typedef short bf16x8 __attribute__((ext_vector_type(8)));
typedef float f32x16 __attribute__((ext_vector_type(16)));
typedef float f32x4 __attribute__((ext_vector_type(4)));
typedef float f32x2 __attribute__((ext_vector_type(2)));
typedef unsigned u32x4 __attribute__((ext_vector_type(4)));
typedef unsigned u32x2 __attribute__((ext_vector_type(2)));
typedef __bf16 bf16v2 __attribute__((ext_vector_type(2)));

constexpr int T = 16384, DM = 1024, SEQ = 4096;
constexpr int HY_IN = 5120, HY_OUT = 2048;
constexpr int MLA_DOWN = 704, MLA_DOWN_PAD = 768, MLA_QR = 384, MLA_KVR = 256;
constexpr int NEXP = 16384;
constexpr float EPS = 1e-6f;
constexpr int NTHREADS = 512;
constexpr int LDS_BYTES = 81920;
constexpr int LDS_TOTAL = 2 * LDS_BYTES;

constexpr size_t al256(size_t x) { return (x + 255) & ~(size_t)255; }
constexpr size_t WS_WINT   = 0;
constexpr size_t WS_WOUTT  = WS_WINT   + (size_t)HY_IN * DM * 2;
constexpr size_t WS_WDOWNT = WS_WOUTT  + (size_t)DM * HY_OUT * 2;
constexpr size_t WS_WQUPT  = WS_WDOWNT + (size_t)MLA_DOWN_PAD * DM * 2;
constexpr size_t WS_WKVUPT = WS_WQUPT  + (size_t)1536 * MLA_QR * 2;
constexpr size_t WS_WMOT   = WS_WKVUPT + (size_t)2048 * MLA_KVR * 2;
constexpr size_t WS_WPQT   = WS_WMOT   + (size_t)DM * DM * 2;
constexpr size_t WS_ROPE_R = WS_WPQT   + (size_t)2 * 2048 * DM * 2;
constexpr size_t WS_ROPE_M = WS_ROPE_R + (size_t)SEQ * 64 * 8;
constexpr size_t WS_UBF    = WS_ROPE_M + (size_t)SEQ * 32 * 8;
constexpr size_t WS_VBF    = WS_UBF    + (size_t)2 * NEXP * DM;
constexpr size_t WS_USC    = WS_VBF    + (size_t)2 * NEXP * DM;
constexpr size_t WS_VSC    = WS_USC    + (size_t)2 * NEXP * 4;
constexpr size_t WS_H      = WS_VSC    + (size_t)2 * NEXP * 4;
constexpr size_t WS_PROJ   = WS_H      + (size_t)T * DM * 2;
constexpr size_t WS_Y      = WS_PROJ   + (size_t)T * HY_IN * 2;
constexpr size_t WS_SSQ    = WS_Y      + (size_t)T * HY_OUT * 2;
constexpr size_t WS_DST    = WS_SSQ    + (size_t)T * 8 * 4;
constexpr size_t WS_EXP    = WS_DST    + (size_t)512 * 256 * 128 * 4;
constexpr size_t WS_GATE   = WS_EXP    + (size_t)T * 128 * 2;
constexpr size_t WS_BAR    = WS_GATE   + (size_t)T * 128 * 4;
constexpr size_t WS_TS     = WS_BAR    + 16384;
constexpr size_t WS_AVT    = WS_TS     + 4096;
constexpr size_t WS_KT     = WS_AVT    + (size_t)T * 1024 * 2;
constexpr size_t WS_VTR    = WS_KT     + (size_t)T * 512 * 2;
constexpr size_t WS_END    = WS_VTR    + (size_t)T * 1024 * 2;
constexpr size_t WS_Q      = WS_PROJ;
constexpr size_t WS_KV     = WS_Q  + (size_t)T * 1536 * 2;
constexpr size_t WS_DOWN   = WS_KV + (size_t)T * 2048 * 2;
constexpr size_t WS_TK = WS_PROJ;
constexpr size_t WS_O      = WS_Y;
constexpr size_t WS_CQN    = WS_O    + (size_t)T * DM * 2;
constexpr size_t WS_CKVN   = WS_CQN  + (size_t)T * MLA_QR * 2;
constexpr size_t WS_KROPE  = WS_CKVN + (size_t)T * MLA_KVR * 2;
static_assert(WS_DOWN + (size_t)T * 768 * 4 <= WS_Y, "overlay");
static_assert(WS_KROPE + (size_t)T * 64 * 2 <= WS_SSQ, "overlay");

struct Params {
    const float *x, *norm_mix, *norm_ffn, *hy_w_in, *gm_v_norm, *gm_w_s, *gm_b_s, *ret_norm, *hy_w_out;
    const float *mla_w_down, *mla_q_norm, *mla_w_q_up, *mla_kv_norm, *mla_w_kv_up, *mla_w_out;
    const float *peer_w_q, *peer_sub_keys, *peer_u, *peer_v, *final_norm;
    float* out;
    unsigned char* ws;
};

extern __shared__ __attribute__((aligned(16))) unsigned char smem_raw[];
__device__ __forceinline__ int vhalf() { return __builtin_amdgcn_readfirstlane((int)(threadIdx.x >> 8)); }
#define smem (smem_raw + vhalf() * LDS_BYTES)

__device__ __forceinline__ unsigned pk2(float lo, float hi) { unsigned r; asm volatile("v_cvt_pk_bf16_f32 %0, %1, %2" : "=v"(r) : "v"(lo), "v"(hi)); return r; }
__device__ __forceinline__ u16 f2bf(float f) { return (u16)(pk2(f, 0.f) & 0xffffu); }
__device__ __forceinline__ float bflo(unsigned u) { return __uint_as_float(u << 16); }
__device__ __forceinline__ float bfhi(unsigned u) { return __uint_as_float(u & 0xffff0000u); }
__device__ __forceinline__ float bf2f(u16 h) { return __uint_as_float((unsigned)h << 16); }
__device__ __forceinline__ u32x4 pack8(const float* v) { u32x4 w; w.x = pk2(v[0], v[1]); w.y = pk2(v[2], v[3]); w.z = pk2(v[4], v[5]); w.w = pk2(v[6], v[7]); return w; }
__device__ __forceinline__ void unpack8(u32x4 w, float* v) { v[0] = bflo(w.x); v[1] = bfhi(w.x); v[2] = bflo(w.y); v[3] = bfhi(w.y); v[4] = bflo(w.z); v[5] = bfhi(w.z); v[6] = bflo(w.w); v[7] = bfhi(w.w); }
__device__ __forceinline__ float gelu_f(float v) {
    const float t = __builtin_amdgcn_rcpf(fabsf(v) * 0.2316418882f + 1.0f);
    float q = t * 0.5307027145f + (-0.7265760135f); q = q * t + 0.7107068705f; q = q * t + (-0.142248368f); q = q * t + 0.127414796f; q = q * t;
    const float m = v * (q * __builtin_amdgcn_exp2f(v * v * (-0.72134752044f)));
    return v < 0.f ? m : v - m;
}
__device__ __forceinline__ float silu_f(float v) { return v * __builtin_amdgcn_rcpf(1.0f + __builtin_amdgcn_exp2f(v * (-1.4426950408889634f))); }
__device__ __forceinline__ float wave_sum(float v) {
#pragma unroll
    for (int o = 32; o >= 1; o >>= 1) v += __shfl_xor(v, o);
    return v;
}

__device__ __forceinline__ int opaque(int v) { asm volatile("" : "+v"(v)); return v; }
__device__ __forceinline__ int opaque_s(int v) { asm volatile("" : "+s"(v)); return v; }

__device__ __forceinline__ int toff(int r, int c8) { return r * 128 + ((c8 ^ ((r >> 1) & 7)) << 4); }
__device__ __forceinline__ int toff_e(int r, int k) { return toff(r, k >> 3) + (k & 7) * 2; }

template <int PT, int QT>
__device__ __forceinline__ void mma_kb(f32x16 (&acc)[PT][QT], int Ps, int prow0, int Qs, int qrow0, int lane) {
    const int lr = lane & 31, hi = lane >> 5;
    bf16x8 a[4][PT], b[4][QT];
#pragma unroll
    for (int s = 0; s < 4; ++s) {
        const int c8 = 2 * s + hi;
#pragma unroll
        for (int i = 0; i < PT; ++i) a[s][i] = *(const bf16x8*)(smem + Ps + toff(prow0 + i * 32 + lr, c8));
#pragma unroll
        for (int j = 0; j < QT; ++j) b[s][j] = *(const bf16x8*)(smem + Qs + toff(qrow0 + j * 32 + lr, c8));
    }
    __builtin_amdgcn_sched_barrier(0);
#pragma unroll
    for (int s = 0; s < 4; ++s)
#pragma unroll
        for (int i = 0; i < PT; ++i)
#pragma unroll
            for (int j = 0; j < QT; ++j) acc[i][j] = __builtin_amdgcn_mfma_f32_32x32x16_bf16(a[s][i], b[s][j], acc[i][j], 0, 0, 0);
#pragma unroll
    for (int i = 0; i < PT; ++i)
#pragma unroll
        for (int j = 0; j < QT; ++j) asm volatile("" : "+v"(acc[i][j]));
}

template <int ROWS>
__device__ __forceinline__ void gload_nat(u32x4 (&r)[ROWS / 32], const u16* src, int ld, int tid) {
    tid = opaque(tid);
#pragma unroll
    for (int i = 0; i < ROWS / 32; ++i) { const int idx = tid + 256 * i, row = idx >> 3, c8 = idx & 7; r[i] = *(const u32x4*)(src + (size_t)row * ld + c8 * 8); }
}
template <int ROWS>
__device__ __forceinline__ void sstore_nat(int lds, const u32x4 (&r)[ROWS / 32], int tid) {
    tid = opaque(tid);
#pragma unroll
    for (int i = 0; i < ROWS / 32; ++i) { const int idx = tid + 256 * i, row = idx >> 3, c8 = idx & 7; *(u32x4*)(smem + lds + toff(row, c8)) = r[i]; }
}
template <int ROWS, bool SCALE>
__device__ __forceinline__ void load_tr(int lds, const u16* src, int ld, int tid, const float* kscale) {
    constexpr int CH = ROWS / 8;
    tid = opaque(tid);
#pragma unroll 2
    for (int i = 0; i < (64 * CH) / 256; ++i) {
        const int idx = tid + 256 * i, k = idx / CH, nc = idx % CH;
        const u32x4 v = *(const u32x4*)(src + (size_t)k * ld + nc * 8);
        const unsigned wd[4] = {v.x, v.y, v.z, v.w};
        float sc = 1.f; if (SCALE) sc = kscale[k];
#pragma unroll
        for (int e = 0; e < 8; ++e) {
            u16 h;
            if (SCALE) h = f2bf(((e & 1) ? bfhi(wd[e >> 1]) : bflo(wd[e >> 1])) * sc);
            else h = (u16)((e & 1) ? (wd[e >> 1] >> 16) : (wd[e >> 1] & 0xffffu));
            *(u16*)(smem + lds + toff_e(nc * 8 + e, k)) = h;
        }
    }
}

constexpr int CS_LD = 132;
__device__ __forceinline__ void stage_c22(const f32x16 (&acc)[2][2], int wm, int wn, int lane) {
    const int lr = lane & 31, hi = lane >> 5;
#pragma unroll
    for (int i = 0; i < 2; ++i)
#pragma unroll
        for (int j = 0; j < 2; ++j)
#pragma unroll
            for (int q = 0; q < 4; ++q) {
                const int n = wm * 64 + i * 32 + 8 * q + 4 * hi, m = wn * 64 + j * 32 + lr;
                f32x4 v = {acc[i][j][4 * q], acc[i][j][4 * q + 1], acc[i][j][4 * q + 2], acc[i][j][4 * q + 3]};
                *(f32x4*)(smem + (m * CS_LD + n) * 4) = v;
            }
}
__device__ __forceinline__ void cs_read8(int m, int c, float* v) {
    const f32x4 a = *(const f32x4*)(smem + (m * CS_LD + c) * 4), b = *(const f32x4*)(smem + (m * CS_LD + c + 4) * 4);
    v[0] = a[0]; v[1] = a[1]; v[2] = a[2]; v[3] = a[3]; v[4] = b[0]; v[5] = b[1]; v[6] = b[2]; v[7] = b[3];
}

__device__ __forceinline__ void cs_store_transposed(u16* dst  , int tid) {
#pragma unroll
    for (int ps = 0; ps < 8; ++ps) {
        const int col = ps * 16 + (tid >> 4), tk8 = (tid & 15) * 8;
        float v[8];
#pragma unroll
        for (int e = 0; e < 8; ++e) v[e] = *(const float*)(smem + ((tk8 + e) * CS_LD + col) * 4);
        *(u32x4*)(dst + (size_t)col * 128 + tk8) = pack8(v);
    }
}
__device__ __forceinline__ void load_nat_colscale(int lds, const u16* src, int ld, int tid, const float* kscale) {
    tid = opaque(tid);
#pragma unroll 2
    for (int i = 0; i < 4; ++i) {
        const int idx = tid + 256 * i, row = idx >> 3, c8 = idx & 7;
        float f[8]; unpack8(*(const u32x4*)(src + (size_t)row * ld + c8 * 8), f);
#pragma unroll
        for (int e = 0; e < 8; ++e) f[e] *= kscale[c8 * 8 + e];
        *(u32x4*)(smem + lds + toff(row, c8)) = pack8(f);
    }
}
__device__ __forceinline__ void glds_tile128(int lds, const u16* src, int ld, int tid) {
    const int lane = tid & 63, w = tid >> 6;
#pragma unroll
    for (int i = 0; i < 4; ++i) {
        const int r0 = (w * 4 + i) * 8, r = r0 + (lane >> 3), c8 = (lane & 7) ^ ((r >> 1) & 7);
        __builtin_amdgcn_global_load_lds((const unsigned*)(src + (size_t)r * ld + c8 * 8), (unsigned*)(smem + lds + r0 * 128), 16, 0, 0);
    }
}

template <class Epi>
__device__ __forceinline__ void gemm_tile(const u16* A, int lda, const u16* Bt, int ldb, int K, int m0, int n0, Epi&& epi) {
    const int tid = opaque((int)threadIdx.x & 255), lane = tid & 63, w = tid >> 6, wm = w >> 1, wn = w & 1;
    f32x16 acc[2][2];
#pragma unroll
    for (int i = 0; i < 2; ++i)
#pragma unroll
        for (int j = 0; j < 2; ++j)
#pragma unroll
            for (int r = 0; r < 16; ++r) acc[i][j][r] = 0.f;
    const u16* Ap = A + (size_t)m0 * lda; const u16* Bp = Bt + (size_t)n0 * ldb;
    glds_tile128(0, Bp, ldb, tid); glds_tile128(16384, Ap, lda, tid);
    const int nk = K >> 6;
    for (int kb = 0; kb < nk; ++kb) {
        const int buf = (kb & 1) * 32768;
        asm volatile("s_waitcnt vmcnt(0)" ::: "memory");
        __syncthreads();
        if (kb + 1 < nk) { glds_tile128(buf ^ 32768, Bp + (kb + 1) * 64, ldb, tid); glds_tile128((buf ^ 32768) + 16384, Ap + (kb + 1) * 64, lda, tid); }
        mma_kb<2, 2>(acc, buf, wm * 64, buf + 16384, wn * 64, lane);
    }
    __syncthreads();
    stage_c22(acc, wm, wn, lane);
    __syncthreads();
    epi(m0, n0);
    __syncthreads();
}

__device__ __forceinline__ int toff32(int r, int c4) { return r * 64 + ((c4 ^ ((r >> 2) & 3)) << 4); }
template <int ROWS>
__device__ __forceinline__ void glds_rows32(int lds, const u16* src, int ld, int tid) {
    const int lane = tid & 63, w = tid >> 6;
#pragma unroll
    for (int i = 0; i < ROWS / 64; ++i) {
        const int r0 = (w * (ROWS / 64) + i) * 16, r = r0 + (lane >> 2), c4 = (lane & 3) ^ ((r >> 2) & 3);
        __builtin_amdgcn_global_load_lds((const unsigned*)(src + (size_t)r * ld + c4 * 8), (unsigned*)(smem + lds + r0 * 64), 16, 0, 0);
    }
}
__device__ __forceinline__ void glds_piece(int st, int piece, const u16* Bp, int ldb, const u16* Ap, int lda, int tid) {
    const int lane = tid & 63, w = tid >> 6;
    const bool isq = piece >= 4;
    const int r0 = isq ? (w * 2 + (piece - 4)) * 16 : (w * 4 + piece) * 16, r = r0 + (lane >> 2), c4 = (lane & 3) ^ ((r >> 2) & 3);
    const u16* src = isq ? Ap + (size_t)r * lda : Bp + (size_t)r * ldb;
    __builtin_amdgcn_global_load_lds((const unsigned*)(src + c4 * 8), (unsigned*)(smem + st + (isq ? 16384 : 0) + r0 * 64), 16, 0, 0);
}
constexpr int G2_STAGE = 24576;
template <int GM = 0, class Epi>
__device__ __forceinline__ void gemm_tile2(const u16* A, int lda, const u16* Bt, int ldb, int K, int m0, int n0, Epi&& epi) {
    const int tid = opaque((int)threadIdx.x & 255), lane = tid & 63, w = tid >> 6, wm = w >> 1, wn = w & 1, lr = lane & 31, hi = lane >> 5;
    f32x16 acc[4][2];
#pragma unroll
    for (int i = 0; i < 4; ++i)
#pragma unroll
        for (int j = 0; j < 2; ++j)
#pragma unroll
            for (int r = 0; r < 16; ++r) acc[i][j][r] = 0.f;
    const u16* Ap = A + (size_t)m0 * lda; const u16* Bp = Bt + (size_t)n0 * ldb;
    const int nk = K >> 5;
    glds_rows32<256>(0, Bp, ldb, tid); glds_rows32<128>(16384, Ap, lda, tid);
    glds_rows32<256>(G2_STAGE, Bp + 32, ldb, tid); glds_rows32<128>(G2_STAGE + 16384, Ap + 32, lda, tid);
    int st = 0, stn = 2 * G2_STAGE;
    for (int kb = 0; kb < nk; ++kb) {
        if (GM != 2 && kb + 1 < nk) asm volatile("s_waitcnt vmcnt(6)" ::: "memory"); else asm volatile("s_waitcnt vmcnt(0)" ::: "memory");
        __builtin_amdgcn_s_barrier();
        const bool refill = (GM != 2) && (kb + 2 < nk);
        bf16x8 a[2][4], b[2][2];
#pragma unroll
        for (int s = 0; s < 2; ++s) {
            const int c4 = 2 * s + hi;
#pragma unroll
            for (int i = 0; i < 4; ++i) a[s][i] = *(const bf16x8*)(smem + st + toff32(wm * 128 + i * 32 + lr, c4));
#pragma unroll
            for (int j = 0; j < 2; ++j) b[s][j] = *(const bf16x8*)(smem + st + 16384 + toff32(wn * 64 + j * 32 + lr, c4));
        }
        __builtin_amdgcn_sched_barrier(0);
#pragma unroll
        for (int s = 0; s < 2; ++s)
#pragma unroll
            for (int i = 0; i < 4; ++i) {
                if (GM == 1) { asm volatile("" :: "v"(a[s][i])); asm volatile("" :: "v"(b[s][0])); asm volatile("" :: "v"(b[s][1])); }
                else {
#pragma unroll
                    for (int j = 0; j < 2; ++j) acc[i][j] = __builtin_amdgcn_mfma_f32_32x32x16_bf16(a[s][i], b[s][j], acc[i][j], 0, 0, 0);
                }
                const int pc = s * 4 + i;
                if (pc < 6) { if (refill) glds_piece(stn, pc, Bp + (kb + 2) * 32, ldb, Ap + (kb + 2) * 32, lda, tid); __builtin_amdgcn_sched_barrier(0); }
            }
#pragma unroll
        for (int i = 0; i < 4; ++i)
#pragma unroll
            for (int j = 0; j < 2; ++j) asm volatile("" : "+v"(acc[i][j]));
        st = (st == 2 * G2_STAGE) ? 0 : st + G2_STAGE; stn = (stn == 2 * G2_STAGE) ? 0 : stn + G2_STAGE;
    }
#pragma unroll 1
    for (int h = 0; h < 2; ++h) {
        __syncthreads();
        if (wm == h) {
#pragma unroll
            for (int i = 0; i < 4; ++i)
#pragma unroll
                for (int j = 0; j < 2; ++j)
#pragma unroll
                    for (int q = 0; q < 4; ++q) {
                        const int n = i * 32 + 8 * q + 4 * hi, m = wn * 64 + j * 32 + lr;
                        f32x4 v = {acc[i][j][4 * q], acc[i][j][4 * q + 1], acc[i][j][4 * q + 2], acc[i][j][4 * q + 3]};
                        *(f32x4*)(smem + (m * CS_LD + n) * 4) = v;
                    }
        }
        __syncthreads();
        if (GM != 3) epi(m0, n0 + h * 128);
    }
    __syncthreads();
}

constexpr int G3_STAGE = 32768;
__device__ __forceinline__ void glds_piece3(int st, int i, const u16* Bp, int ldb, const u16* Ap, int lda, int lane, int w8) {
    const bool isq = i >= 2;
    const int r0 = (w8 * 2 + (i & 1)) * 16, r = r0 + (lane >> 2), c4 = (lane & 3) ^ ((r >> 2) & 3);
    const u16* src = isq ? Ap + (size_t)r * lda : Bp + (size_t)r * ldb;
    __builtin_amdgcn_global_load_lds((const unsigned*)(src + c4 * 8), (unsigned*)(smem_raw + st + (isq ? 16384 : 0) + r0 * 64), 16, 0, 0);
}
namespace pg8 {
#define PG8_LAS __attribute__((address_space(3)))
typedef unsigned short bf16_t;
typedef short bf16x8 __attribute__((ext_vector_type(8)));
typedef float f32x4 __attribute__((ext_vector_type(4)));
typedef unsigned u32x4 __attribute__((ext_vector_type(4)));
constexpr int BM = 256, BK = 64, HALF = 128, HTB = HALF * BK * 2  , STAGE_BYTES = 8 * HTB, NXCD = 8, WGM = 8;

__host__ __device__ __forceinline__ int lds_byte(int r, int c) { const int st = (r >> 4) * 2 + (c >> 5), rr = r & 15, cc = c & 31, ob = rr * 64 + cc * 2; return st * 1024 + (ob ^ (((ob >> 9) & 1) << 5)); }
__host__ __device__ __forceinline__ void stage_rc(int b, int& R, int& C) { const int st = b / 1024, sb = b % 1024, swz = sb ^ (((sb >> 9) & 1) << 5); R = (st >> 1) * 16 + swz / 64; C = (st & 1) * 32 + (swz % 64) / 2; }
__host__ __device__ __forceinline__ int perm32(int rho) { const int n = rho >> 4, i = rho & 15; return 8 * (i >> 2) + 4 * n + (i & 3); }

struct Unit { int pm, pn; };
struct Gemm { const bf16_t* A; const bf16_t* Bt; int M, N, K; };
struct OneUnit {
    __device__ __forceinline__ bool next(int i, Unit& u) const { if (i > 0) return false; u.pm = 0; u.pn = 0; return true; }
    __device__ __forceinline__ void a_ready(const Unit&) const {}
    __device__ __forceinline__ void done(const Unit&) const {}
};
template <class Epi, class Sched, bool ALIGN_EPI = false, bool SP2 = false>
__device__ __forceinline__ void gemm_phase(PG8_LAS unsigned char* lds, const Gemm g, const Sched& S, const Epi& E) {
    const int tid = opaque((int)threadIdx.x), wid = __builtin_amdgcn_readfirstlane(tid >> 6), lane = tid & 63, wr = wid >> 2, wc = wid & 3, fr = lane & 15, fq = lane >> 4;
    const int K = g.K, nt = K / BK;
    unsigned voffA[2], voffB[2];
#pragma unroll
    for (int i = 0; i < 2; ++i) { int R, C; stage_rc(tid * 16 + i * 8192, R, C); const int Rb = Epi::PERM ? ((R & ~31) + perm32(R & 31)) : R;
        voffA[i] = (unsigned)(R * K + C) * 2u; voffB[i] = (unsigned)(Rb * K + C) * 2u; }
    const size_t kstep = (size_t)(BK * 2);
    const size_t hstep = (size_t)HALF * K * 2;
    const size_t tstep = 2 * hstep;
    const unsigned ldsw = (unsigned)wid * 1024u;
    const int aoff = lds_byte(wr * 64 + fr, fq * 8), boff = lds_byte(wc * 32 + fr, fq * 8);
#define PG8_SA(b, h) (((b) * 2 + (h)) * HTB)
#define PG8_SB(b, h) ((4 + (b) * 2 + (h)) * HTB)
#define PG8_STAGE(bufoff, gbase, voff) do { _Pragma("unroll") for (int _i = 0; _i < 2; ++_i) \
        __builtin_amdgcn_global_load_lds((const unsigned*)((const char*)(gbase) + (voff)[_i]), (PG8_LAS unsigned*)(lds + (bufoff) + ldsw + _i * 8192), 16, 0, 0); } while (0)
#define PG8_LDA(dst, b, h) do { _Pragma("unroll") for (int m = 0; m < 4; ++m) _Pragma("unroll") for (int k = 0; k < 2; ++k) dst[m][k] = *(const PG8_LAS bf16x8*)(lds + PG8_SA(b, h) + aoff + m * 2048 + k * 1024); } while (0)
#define PG8_LDB(dst, b, h) do { _Pragma("unroll") for (int n = 0; n < 2; ++n) _Pragma("unroll") for (int k = 0; k < 2; ++k) dst[n][k] = *(const PG8_LAS bf16x8*)(lds + PG8_SB(b, h) + boff + n * 2048 + k * 1024); } while (0)
#define PG8_MMA(ai, bj, At, Bt) do { __builtin_amdgcn_s_setprio(1); _Pragma("unroll") for (int m = 0; m < 4; ++m) _Pragma("unroll") for (int n = 0; n < 2; ++n) _Pragma("unroll") for (int k = 0; k < 2; ++k) \
        acc[ai][bj][m][n] = __builtin_amdgcn_mfma_f32_16x16x32_bf16(Bt[n][k], At[m][k], acc[ai][bj][m][n], 0, 0, 0); __builtin_amdgcn_s_setprio(0); } while (0)
#define PG8_WAIT_V(n) asm volatile("s_waitcnt vmcnt(" #n ")" ::: "memory")
#define PG8_WAIT_L(n) asm volatile("s_waitcnt lgkmcnt(" #n ")" ::: "memory")
#define PG8_BAR __builtin_amdgcn_s_barrier()
#define PG8_SCHED __builtin_amdgcn_sched_barrier(0)
    Unit cur, nxt; int ui = 0;
    if (!S.next(0, cur)) return;
    f32x4 acc[2][2][4][2];
#pragma unroll
    for (int a = 0; a < 2; ++a)
#pragma unroll
        for (int b = 0; b < 2; ++b)
#pragma unroll
            for (int m = 0; m < 4; ++m)
#pragma unroll
                for (int n = 0; n < 2; ++n) acc[a][b][m][n] = (f32x4){0.f, 0.f, 0.f, 0.f};
    bf16x8 At[4][2], B0[2][2], B1[2][2];
    const char* cA = (const char*)g.A + (size_t)cur.pm * tstep; const char* cB = (const char*)g.Bt + (size_t)cur.pn * tstep;
    S.a_ready(cur);
    if constexpr (SP2) {
        PG8_STAGE(PG8_SB(0, 0), cB, voffB); PG8_STAGE(PG8_SB(0, 1), cB + hstep, voffB); PG8_STAGE(PG8_SA(0, 0), cA, voffA); PG8_STAGE(PG8_SA(0, 1), cA + hstep, voffA);
        if (wr == 1) PG8_BAR;
        PG8_WAIT_V(2); PG8_BAR;
        PG8_STAGE(PG8_SB(1, 0), cB + kstep, voffB); PG8_STAGE(PG8_SA(1, 0), cA + kstep, voffA); PG8_STAGE(PG8_SB(1, 1), cB + hstep + kstep, voffB);
        PG8_WAIT_V(6); PG8_BAR;
    } else {
        PG8_STAGE(PG8_SB(0, 0), cB, voffB); PG8_STAGE(PG8_SA(0, 0), cA, voffA); PG8_STAGE(PG8_SB(0, 1), cB + hstep, voffB); PG8_STAGE(PG8_SA(0, 1), cA + hstep, voffA);
        if (wr == 1) PG8_BAR;
        PG8_WAIT_V(4); PG8_BAR;
        PG8_STAGE(PG8_SB(1, 0), cB + kstep, voffB); PG8_STAGE(PG8_SA(1, 0), cA + kstep, voffA); PG8_STAGE(PG8_SB(1, 1), cB + hstep + kstep, voffB);
        PG8_WAIT_V(6); PG8_BAR;
    }
    for (;;) {
        const bool has_next = S.next(ui + 1, nxt);
        const char* nA = has_next ? (const char*)g.A + (size_t)nxt.pm * tstep : cA; const char* nB = has_next ? (const char*)g.Bt + (size_t)nxt.pn * tstep : cB;
        for (int t = 0; t < nt; t += 2) {
            const bool last = (t == nt - 2);
            const char* a1 = cA + (size_t)(t + 1) * kstep;
            const char* a2 = last ? nA : cA + (size_t)(t + 2) * kstep; const char* b2 = last ? nB : cB + (size_t)(t + 2) * kstep;
            const char* a3 = a2 + kstep; const char* b3 = b2 + kstep;
            if (last && has_next) S.a_ready(nxt);
            if constexpr (SP2) {
            PG8_LDB(B0, 0, 0); PG8_LDB(B1, 0, 1); PG8_SCHED; PG8_LDA(At, 0, 0); PG8_STAGE(PG8_SA(1, 1), a1 + hstep, voffA);
            PG8_WAIT_V(8); PG8_WAIT_L(0); PG8_BAR; PG8_MMA(0, 0, At, B0); PG8_MMA(0, 1, At, B1); PG8_BAR; PG8_SCHED;
            PG8_LDA(At, 0, 1); PG8_STAGE(PG8_SB(0, 0), b2, voffB); PG8_STAGE(PG8_SB(0, 1), b2 + hstep, voffB); PG8_STAGE(PG8_SA(0, 0), a2, voffA);
            PG8_WAIT_V(8); PG8_WAIT_L(0); PG8_BAR; PG8_MMA(1, 0, At, B0); PG8_MMA(1, 1, At, B1); PG8_BAR; PG8_SCHED;
            PG8_LDB(B0, 1, 0); PG8_LDB(B1, 1, 1); PG8_SCHED; PG8_LDA(At, 1, 0); PG8_STAGE(PG8_SA(0, 1), a2 + hstep, voffA);
            PG8_WAIT_V(8); PG8_WAIT_L(0); PG8_BAR; PG8_MMA(0, 0, At, B0); PG8_MMA(0, 1, At, B1); PG8_BAR; PG8_SCHED;
            PG8_LDA(At, 1, 1); PG8_STAGE(PG8_SB(1, 0), b3, voffB); PG8_STAGE(PG8_SB(1, 1), b3 + hstep, voffB); PG8_STAGE(PG8_SA(1, 0), a3, voffA);
            PG8_WAIT_V(8); PG8_WAIT_L(0); PG8_BAR; PG8_MMA(1, 0, At, B0); PG8_MMA(1, 1, At, B1); PG8_BAR; PG8_SCHED;
            } else {
            PG8_LDB(B0, 0, 0); PG8_SCHED; PG8_LDA(At, 0, 0); PG8_STAGE(PG8_SA(1, 1), a1 + hstep, voffA);
            PG8_WAIT_L(8); PG8_BAR; PG8_WAIT_L(0); PG8_MMA(0, 0, At, B0); PG8_BAR; PG8_SCHED;
            PG8_LDB(B1, 0, 1); PG8_STAGE(PG8_SB(0, 0), b2, voffB);
            PG8_BAR; PG8_WAIT_L(0); PG8_MMA(0, 1, At, B1); PG8_BAR;
            PG8_LDA(At, 0, 1); PG8_STAGE(PG8_SA(0, 0), a2, voffA);
            PG8_BAR; PG8_WAIT_L(0); PG8_MMA(1, 0, At, B0); PG8_BAR; PG8_SCHED;
            PG8_STAGE(PG8_SB(0, 1), b2 + hstep, voffB);
            PG8_WAIT_V(6); PG8_BAR; PG8_MMA(1, 1, At, B1); PG8_BAR;
            PG8_LDB(B0, 1, 0); PG8_SCHED; PG8_LDA(At, 1, 0); PG8_STAGE(PG8_SA(0, 1), a2 + hstep, voffA);
            PG8_WAIT_L(8); PG8_BAR; PG8_WAIT_L(0); PG8_MMA(0, 0, At, B0); PG8_BAR; PG8_SCHED;
            PG8_LDB(B1, 1, 1); PG8_STAGE(PG8_SB(1, 0), b3, voffB);
            PG8_BAR; PG8_WAIT_L(0); PG8_MMA(0, 1, At, B1); PG8_BAR;
            PG8_LDA(At, 1, 1); PG8_STAGE(PG8_SA(1, 0), a3, voffA);
            PG8_BAR; PG8_WAIT_L(0); PG8_MMA(1, 0, At, B0); PG8_BAR; PG8_SCHED;
            PG8_STAGE(PG8_SB(1, 1), b3 + hstep, voffB);
            PG8_WAIT_V(6); PG8_BAR; PG8_MMA(1, 1, At, B1); PG8_BAR;
            }
        }
        if constexpr (ALIGN_EPI) { if (wr == 0) PG8_BAR; }
        if constexpr (!Epi::AFTER_DRAIN) { E(acc, cur, wr, wc, fr, fq); S.done(cur); }
        if (!has_next) break;
#pragma unroll
        for (int a = 0; a < 2; ++a)
#pragma unroll
            for (int b = 0; b < 2; ++b)
#pragma unroll
                for (int m = 0; m < 4; ++m)
#pragma unroll
                    for (int n = 0; n < 2; ++n) acc[a][b][m][n] = (f32x4){0.f, 0.f, 0.f, 0.f};
        cur = nxt; cA = nA; cB = nB; ++ui;
        if constexpr (ALIGN_EPI) { if (wr == 1) PG8_BAR; }
    }
    PG8_WAIT_V(0);
    if constexpr (!ALIGN_EPI) { if (wr == 0) PG8_BAR; }
    PG8_BAR;
    if constexpr (Epi::AFTER_DRAIN) { E.fused(acc, cur, wr, wc, fr, fq, lds, wid, lane); S.done(cur); }
#undef PG8_SA
#undef PG8_SB
#undef PG8_STAGE
#undef PG8_LDA
#undef PG8_LDB
#undef PG8_MMA
#undef PG8_WAIT_V
#undef PG8_WAIT_L
#undef PG8_BAR
#undef PG8_SCHED
}
}

template <class F> struct EpiStaged {
    static constexpr bool PERM = false, AFTER_DRAIN = true;
    F& f; int m0, n0;
    __device__ __forceinline__ void fused(pg8::f32x4 (&acc)[2][2][4][2], const pg8::Unit&, int wr, int wc, int fr, int fq, PG8_LAS unsigned char*, int, int) const {
        const int vh = vhalf();
#pragma unroll
        for (int bj = 0; bj < 2; ++bj) {
            __syncthreads();
#pragma unroll
            for (int ai = 0; ai < 2; ++ai)
#pragma unroll
                for (int m = 0; m < 4; ++m)
#pragma unroll
                    for (int n = 0; n < 2; ++n) {
                        const int row = 64 * wr + 16 * m + fr, col = 32 * wc + 16 * n + 4 * fq;
                        *(f32x4*)(smem_raw + ai * LDS_BYTES + (row * CS_LD + col) * 4) = acc[ai][bj][m][n];
                    }
            __syncthreads();
            f(m0 + vh * 128, n0 + bj * 128);
        }
        __syncthreads();
    }
};
template <class Epi>
__device__ __forceinline__ void gemm_tile3(const u16* A, int lda, const u16* Bt, int ldb, int K, int m0, int n0, Epi&& epi) {
    const pg8::Gemm g{A + (size_t)m0 * K, Bt + (size_t)n0 * K, 256, 256, K};
    const EpiStaged<Epi> E{epi, m0, n0};
    pg8::gemm_phase<EpiStaged<Epi>, pg8::OneUnit, false, true>((PG8_LAS unsigned char*)smem_raw, g, pg8::OneUnit{}, E);
}
template <int NT>
__device__ __forceinline__ bool tile_map3(int it, int bid, int nb, int& mt, int& nt) {
    constexpr int PN = (NT % 4 == 0) ? 4 : (NT % 3 == 0) ? 3 : (NT % 2 == 0) ? 2 : 1;
    const int x = bid & 7, lb = bid >> 3, nlb = nb >> 3;
    const int j = it * nlb + lb;
    if (j >= 8 * NT) return false;
    const int patch = j / (8 * PN), within = j % (8 * PN);
    mt = x * 8 + (within & 7); nt = patch * PN + (within >> 3);
    return true;
}

template <int NT>
__device__ __forceinline__ bool tile_map(int it, int bid, int nb, int& mt, int& nt) {
    constexpr int PN = (NT % 8 == 0) ? 8 : (NT % 7 == 0) ? 7 : (NT % 6 == 0) ? 6 : (NT % 5 == 0) ? 5 : (NT % 4 == 0) ? 4 : (NT % 3 == 0) ? 3 : (NT % 2 == 0) ? 2 : 1;
    static_assert(NT % PN == 0, "tile_map: NT");
    const int x = bid & 7, lb = bid >> 3, nlb = nb >> 3;
    const int j = it * nlb + lb;
    if (j >= 16 * NT) return false;
    const int patch = j / (8 * PN), within = j % (8 * PN), pm = within & 7, pn = within >> 3;
    mt = x * 16 + (patch & 1) * 8 + pm; nt = (patch >> 1) * PN + pn;
    return true;
}

__device__ __forceinline__ void convT_tile(const float* W, int K, int N, u16* Wt, int kt, int nt, int tid) {
    u16* tile = (u16*)smem;
    __syncthreads();
#pragma unroll
    for (int i = 0; i < 16; ++i) {
        const int k = i * 4 + (tid >> 6), n = tid & 63, gn = nt * 64 + n;
        const float v = (gn < N) ? W[(size_t)(kt * 64 + k) * N + gn] : 0.f;
        tile[n * 72 + k] = f2bf(v);
    }
    __syncthreads();
    const int n = tid >> 2, kc = (tid & 3) * 16;
    const u32x4 a = *(const u32x4*)(tile + n * 72 + kc), b = *(const u32x4*)(tile + n * 72 + kc + 8);
    u16* dst = Wt + (size_t)(nt * 64 + n) * K + kt * 64 + kc;
    *(u32x4*)dst = a; *(u32x4*)(dst + 8) = b;
}
__device__ __forceinline__ void convT_all(const float* W, int K, int N, int Npad, u16* Wt, int bid, int nb, int tid) {
    const int nkt = K / 64, nnt = Npad / 64;
    for (int j = bid; j < nkt * nnt; j += nb) convT_tile(W, K, N, Wt, j % nkt, j / nkt, tid);
}
__device__ __forceinline__ void rmsnorm_rows(const float* X, const float* g, u16* H, int bid, int nb, int tid) {
    const int lane = tid & 63, w = tid >> 6;
    for (int row = bid * 4 + w; row < T; row += nb * 4) {
        const float* xr = X + (size_t)row * DM;
        f32x4 v[4]; float ss = 0.f;
#pragma unroll
        for (int c = 0; c < 4; ++c) { v[c] = *(const f32x4*)(xr + c * 256 + lane * 4); ss += v[c][0] * v[c][0] + v[c][1] * v[c][1] + v[c][2] * v[c][2] + v[c][3] * v[c][3]; }
        ss = wave_sum(ss);
        const float r = rsqrtf(ss * (1.0f / DM) + EPS);
#pragma unroll
        for (int c = 0; c < 4; ++c) {
            const f32x4 gg = *(const f32x4*)(g + c * 256 + lane * 4);
            u32x2 o; o.x = pk2(v[c][0] * r * gg[0], v[c][1] * r * gg[1]); o.y = pk2(v[c][2] * r * gg[2], v[c][3] * r * gg[3]);
            *(u32x2*)(H + (size_t)row * DM + c * 256 + lane * 4) = o;
        }
    }
}
__device__ __forceinline__ void convert_table_rows(const Params& p, int r0, int r1, int tid) {
    unsigned char* ws = p.ws;
    const int lane = tid & 63, w = tid >> 6;
    for (int row = r0 + w; row < r1; row += 4) {
        const int tb = row >= 2 * NEXP, rr = row - tb * 2 * NEXP;
        const float* srcp = (tb ? p.peer_v : p.peer_u) + (size_t)rr * DM + lane * 16;
        f32x4 v[4]; float am = 0.f;
#pragma unroll
        for (int c = 0; c < 4; ++c) { v[c] = *(const f32x4*)(srcp + c * 4); am = fmaxf(am, fmaxf(fmaxf(fabsf(v[c][0]), fabsf(v[c][1])), fmaxf(fabsf(v[c][2]), fabsf(v[c][3])))); }
#pragma unroll
        for (int o = 32; o >= 1; o >>= 1) am = fmaxf(am, __shfl_xor(am, o));
        am = fmaxf(am, 1e-30f);
        if (tb == 0) {
            const float sc = 384.0f / am;
            u32x4 o4;
#pragma unroll
            for (int c = 0; c < 4; ++c) {
                int pk = __builtin_amdgcn_cvt_pk_fp8_f32(v[c][0] * sc, v[c][1] * sc, 0, false);
                pk = __builtin_amdgcn_cvt_pk_fp8_f32(v[c][2] * sc, v[c][3] * sc, pk, true);
                o4[c] = (unsigned)pk;
            }
            *(u32x4*)(ws + WS_UBF + (size_t)rr * DM + lane * 16) = o4;
            if (lane == 0) ((float*)(ws + WS_USC))[rr] = am * (1.0f / 384.0f);
        } else {
            const float sc = 6.0f / am;
            unsigned p0 = 0u, p1 = 0u;
            p0 = __builtin_amdgcn_cvt_scalef32_pk_fp4_f32(p0, v[0][0] * sc, v[0][1] * sc, 1.0f, 0); p0 = __builtin_amdgcn_cvt_scalef32_pk_fp4_f32(p0, v[0][2] * sc, v[0][3] * sc, 1.0f, 1);
            p0 = __builtin_amdgcn_cvt_scalef32_pk_fp4_f32(p0, v[1][0] * sc, v[1][1] * sc, 1.0f, 2); p0 = __builtin_amdgcn_cvt_scalef32_pk_fp4_f32(p0, v[1][2] * sc, v[1][3] * sc, 1.0f, 3);
            p1 = __builtin_amdgcn_cvt_scalef32_pk_fp4_f32(p1, v[2][0] * sc, v[2][1] * sc, 1.0f, 0); p1 = __builtin_amdgcn_cvt_scalef32_pk_fp4_f32(p1, v[2][2] * sc, v[2][3] * sc, 1.0f, 1);
            p1 = __builtin_amdgcn_cvt_scalef32_pk_fp4_f32(p1, v[3][0] * sc, v[3][1] * sc, 1.0f, 2); p1 = __builtin_amdgcn_cvt_scalef32_pk_fp4_f32(p1, v[3][2] * sc, v[3][3] * sc, 1.0f, 3);
            *(u32x2*)(ws + WS_VBF + (size_t)rr * (DM / 2) + lane * 8) = (u32x2){p0, p1};
            if (lane == 0) ((float*)(ws + WS_VSC))[rr] = am * (1.0f / 6.0f);
        }
    }
}

__device__ __forceinline__ void phase_prep(const Params& p, int bid, int nb) {
    const int tid = opaque((int)threadIdx.x & 255);
    unsigned char* ws = p.ws;
    {
        constexpr int J0 = (DM / 64) * (HY_IN / 64), J1 = J0 + (HY_OUT / 64) * (DM / 64), J2 = J1 + (DM / 64) * (MLA_DOWN_PAD / 64), J3 = J2 + (MLA_QR / 64) * (1536 / 64),
                      J4 = J3 + (MLA_KVR / 64) * (2048 / 64), J5 = J4 + (DM / 64) * (DM / 64);
        for (int j = bid; j < J5; j += nb) {
            if (j < J0) convT_tile(p.hy_w_in, DM, HY_IN, (u16*)(ws + WS_WINT), j % (DM / 64), j / (DM / 64), tid);
            else if (j < J1) { const int q = j - J0; convT_tile(p.hy_w_out, HY_OUT, DM, (u16*)(ws + WS_WOUTT), q % (HY_OUT / 64), q / (HY_OUT / 64), tid); }
            else if (j < J2) { const int q = j - J1; convT_tile(p.mla_w_down, DM, MLA_DOWN, (u16*)(ws + WS_WDOWNT), q % (DM / 64), q / (DM / 64), tid); }
            else if (j < J3) { const int q = j - J2; convT_tile(p.mla_w_q_up, MLA_QR, 1536, (u16*)(ws + WS_WQUPT), q % (MLA_QR / 64), q / (MLA_QR / 64), tid); }
            else if (j < J4) { const int q = j - J3; convT_tile(p.mla_w_kv_up, MLA_KVR, 2048, (u16*)(ws + WS_WKVUPT), q % (MLA_KVR / 64), q / (MLA_KVR / 64), tid); }
            else { const int q = j - J4; convT_tile(p.mla_w_out, DM, DM, (u16*)(ws + WS_WMOT), q % (DM / 64), q / (DM / 64), tid); }
        }
    }
    __syncthreads();
    {
        float* Wq_s = (float*)smem; float* key_s = (float*)(smem + 64 * 129 * 4);
        for (int j = bid; j < 2 * 16 * 16 * 2; j += nb) {
            const int kh = j & 1, kt = (j >> 1) & 15, hp = (j >> 5) & 15, L = j >> 9;
            const float* Wq = p.peer_w_q + (size_t)L * DM * 2048 + (size_t)(kt * 64) * 2048 + hp * 128;
            const float* ky = p.peer_sub_keys + (size_t)L * 2 * 128 * 128 + (size_t)(hp & 1) * 128 * 128 + (size_t)(kh * 64) * 128;
            __syncthreads();
#pragma unroll 4
            for (int i = 0; i < 32; ++i) { const int idx = tid + 256 * i, row = idx >> 7, d = idx & 127; Wq_s[row * 129 + d] = Wq[(size_t)row * 2048 + d]; key_s[row * 129 + d] = ky[row * 128 + d]; }
            __syncthreads();
            const int tk = tid & 15, tkey = tid >> 4;
            float acc[4][4];
#pragma unroll
            for (int a = 0; a < 4; ++a)
#pragma unroll
                for (int b = 0; b < 4; ++b) acc[a][b] = 0.f;
            for (int d = 0; d < 128; ++d) {
                float wv[4], kv[4];
#pragma unroll
                for (int a = 0; a < 4; ++a) { wv[a] = Wq_s[(tk * 4 + a) * 129 + d]; kv[a] = key_s[(tkey * 4 + a) * 129 + d]; }
#pragma unroll
                for (int a = 0; a < 4; ++a)
#pragma unroll
                    for (int b = 0; b < 4; ++b) acc[a][b] += kv[a] * wv[b];
            }
            u16* dst = (u16*)(ws + WS_WPQT) + (size_t)L * 2048 * DM;
#pragma unroll
            for (int a = 0; a < 4; ++a) {
                u32x2 o; o.x = pk2(acc[a][0], acc[a][1]); o.y = pk2(acc[a][2], acc[a][3]);
                *(u32x2*)(dst + (size_t)(hp * 128 + kh * 64 + tkey * 4 + a) * DM + kt * 64 + tk * 4) = o;
            }
        }
    }
    { const int rpb = (4 * NEXP + nb - 1) / nb; convert_table_rows(p, bid * rpb, min((bid + 1) * rpb, 4 * NEXP), tid); }
    {
        f32x2* rr = (f32x2*)(ws + WS_ROPE_R); f32x2* rm = (f32x2*)(ws + WS_ROPE_M);
        for (int i = bid * 256 + tid; i < SEQ * 64; i += nb * 256) {
            const int s = i >> 6, d = i & 63; const float inv = 1.0f / powf(10000.0f, (float)d / 64.0f); const float ang = (float)s * inv;
            float sn, cs; sincosf(ang, &sn, &cs); rr[i] = (f32x2){cs, sn};
        }
        for (int i = bid * 256 + tid; i < SEQ * 32; i += nb * 256) {
            const int s = i >> 5, d = i & 31; const float inv = 1.0f / powf(10000.0f, (float)d / 32.0f); const float ang = (float)s * inv;
            float sn, cs; sincosf(ang, &sn, &cs); rm[i] = (f32x2){cs, sn};
        }
    }
    rmsnorm_rows(p.x, p.norm_mix, (u16*)(ws + WS_H), bid, nb, tid);
}

template <int GM = 0>
__device__ __forceinline__ void phase_inproj(const Params& p, int rbid, int rnb) {
    const int bid = rbid * 2 + vhalf(), nb = rnb * 2;
    unsigned char* ws = p.ws;
    const u16* A = (const u16*)(ws + WS_H); const u16* Bt = (const u16*)(ws + WS_WINT);
    u16* proj = (u16*)(ws + WS_PROJ); float* ssq = (float*)(ws + WS_SSQ); const f32x2* rope = (const f32x2*)(ws + WS_ROPE_R);
    const int tid = opaque((int)threadIdx.x & 255);
    constexpr int NT = HY_IN / 256;
    for (int it = 0;; ++it) {
        int mt, nt; if (!tile_map3<NT>(it, rbid, rnb, mt, nt)) break;
        gemm_tile3(A, DM, Bt, DM, DM, mt * 256, nt * 256, [&](int m0, int n0) {
            const int tid = opaque((int)threadIdx.x & 255);
            const int chunk = m0 >> 7;
            if (n0 >= 2048 && n0 < 3072) {
                const bool isk = n0 >= 2560;
                const float sc = isk ? 0.08838834764831845f : 1.0f;
#pragma unroll
                for (int ps = 0; ps < 4; ++ps) {
                    const int m = ps * 32 + (tid >> 3), c = (tid & 7) * 8;
                    float x1[8], x2[8], y1[8], y2[8]; cs_read8(m, c, x1); cs_read8(m, c + 64, x2);
                    const f32x2* rp = rope + (size_t)((m0 + m) & (SEQ - 1)) * 64 + c;
#pragma unroll
                    for (int e = 0; e < 8; ++e) { const f32x2 cssn = rp[e]; y1[e] = (x1[e] * cssn[0] - x2[e] * cssn[1]) * sc; y2[e] = (x1[e] * cssn[1] + x2[e] * cssn[0]) * sc; }
                    u16* dst = proj + (size_t)(m0 + m) * HY_IN + n0 + c;
                    *(u32x4*)dst = pack8(y1); *(u32x4*)(dst + 64) = pack8(y2);
                    if (isk) {
                        *(f32x4*)(smem + (m * CS_LD + c) * 4) = (f32x4){y1[0], y1[1], y1[2], y1[3]}; *(f32x4*)(smem + (m * CS_LD + c + 4) * 4) = (f32x4){y1[4], y1[5], y1[6], y1[7]};
                        *(f32x4*)(smem + (m * CS_LD + c + 64) * 4) = (f32x4){y2[0], y2[1], y2[2], y2[3]}; *(f32x4*)(smem + (m * CS_LD + c + 68) * 4) = (f32x4){y2[4], y2[5], y2[6], y2[7]};
                    }
                }
                if (isk) { __syncthreads(); cs_store_transposed((u16*)(ws + WS_KT) + ((size_t)chunk * 512 + (n0 - 2560)) * 128, tid); }
            } else if (n0 >= 3072 && n0 < 4096) {
                cs_store_transposed((u16*)(ws + WS_VTR) + ((size_t)chunk * 1024 + (n0 - 3072)) * 128, tid);
            } else if (n0 >= 1024 && n0 < 2048) {
#pragma unroll
                for (int ps = 0; ps < 8; ++ps) {
                    const int m = ps * 16 + (tid >> 4), c = (tid & 15) * 8;
                    float v[8]; cs_read8(m, c, v);
                    float s = 0.f;
#pragma unroll
                    for (int e = 0; e < 8; ++e) { v[e] = gelu_f(v[e]); s += v[e] * v[e]; }
                    s += __shfl_xor(s, 1); s += __shfl_xor(s, 2); s += __shfl_xor(s, 4); s += __shfl_xor(s, 8);
                    if ((tid & 15) == 0) ssq[(size_t)(m0 + m) * 8 + ((n0 - 1024) >> 7)] = s;
                    *(f32x4*)(smem + (m * CS_LD + c) * 4) = (f32x4){v[0], v[1], v[2], v[3]}; *(f32x4*)(smem + (m * CS_LD + c + 4) * 4) = (f32x4){v[4], v[5], v[6], v[7]};
                }
                __syncthreads();
                cs_store_transposed((u16*)(ws + WS_AVT) + ((size_t)chunk * 1024 + (n0 - 1024)) * 128, tid);
            } else {
                const bool is_gate = n0 >= 4096;
#pragma unroll
                for (int ps = 0; ps < 8; ++ps) {
                    const int m = ps * 16 + (tid >> 4), c = (tid & 15) * 8;
                    float v[8]; cs_read8(m, c, v);
#pragma unroll
                    for (int e = 0; e < 8; ++e) v[e] = is_gate ? silu_f(v[e]) : gelu_f(v[e]);
                    *(u32x4*)(proj + (size_t)(m0 + m) * HY_IN + n0 + c) = pack8(v);
                }
            }
        });
    }
}

__device__ __forceinline__ float ret_log2gamma(int h) { return log2f(1.0f - exp2f(-5.0f - (float)h)); }
constexpr int YS_LD = 264;
__device__ __forceinline__ void zero4(f32x16 (&acc)[4][1]) {
#pragma unroll
    for (int i = 0; i < 4; ++i)
#pragma unroll
        for (int r = 0; r < 16; ++r) acc[i][0][r] = 0.f;
}

__device__ __forceinline__ void gmlp_task(const Params& p, int ci, int g, int dh) {
    unsigned char* ws = p.ws;
    const int tid = opaque((int)threadIdx.x & 255), lane = tid & 63, w = tid >> 6, lr = lane & 31, hi = lane >> 5;
    const int m0 = ci * 128, col0 = g * 256 + dh * 128;
    const u16* proj = (const u16*)(ws + WS_PROJ); const float* ssq = (const float*)(ws + WS_SSQ);
    float* r_s = (float*)(smem + 49152);
    __syncthreads();
    if (tid < 128) { const float s = ssq[(size_t)(m0 + tid) * 8 + 2 * g] + ssq[(size_t)(m0 + tid) * 8 + 2 * g + 1]; r_s[tid] = rsqrtf(s * (1.0f / 256.0f) + EPS); }
    f32x16 acc[4][1]; zero4(acc);
    const float* Wg = p.gm_w_s + (size_t)g * 128 * 128;
    for (int kb = 0; kb < 2; ++kb) {
        __syncthreads();
        { u32x4 rr[4]; gload_nat<128>(rr, (const u16*)(ws + WS_AVT) + ((size_t)ci * 1024 + col0) * 128 + kb * 64, 128, tid); sstore_nat<128>(0, rr, tid); }
#pragma unroll 2
        for (int i = 0; i < 8; ++i) {
            const int idx = tid + 256 * i, t = idx >> 4, c4 = idx & 15, s0 = kb * 64 + c4 * 4;
            const f32x4 wv = *(const f32x4*)(Wg + t * 128 + s0);
            float o[4];
#pragma unroll
            for (int e = 0; e < 4; ++e) o[e] = (s0 + e <= t) ? wv[e] * r_s[s0 + e] : 0.f;
            u32x2 pk; pk.x = pk2(o[0], o[1]); pk.y = pk2(o[2], o[3]);
            *(u32x2*)(smem + 16384 + toff_e(t, c4 * 4)) = pk;
        }
        __syncthreads();
        mma_kb<4, 1>(acc, 0, 0, 16384, w * 32, lane);
    }
    __syncthreads();
    const int t = w * 32 + lr;
    const float bs = p.gm_b_s[g * 128 + t];
    u16* Ys = (u16*)smem;
#pragma unroll
    for (int i = 0; i < 4; ++i)
#pragma unroll
        for (int q = 0; q < 4; ++q) {
            const int d = i * 32 + 8 * q + 4 * hi;
            const f32x4 gn = *(const f32x4*)(p.gm_v_norm + col0 + d);
            u32x2 pk; pk.x = pk2(acc[i][0][4 * q] * gn[0] + bs, acc[i][0][4 * q + 1] * gn[1] + bs); pk.y = pk2(acc[i][0][4 * q + 2] * gn[2] + bs, acc[i][0][4 * q + 3] * gn[3] + bs);
            *(u32x2*)(Ys + t * YS_LD + d) = pk;
        }
    __syncthreads();
    u16* y = (u16*)(ws + WS_Y);
#pragma unroll
    for (int ps = 0; ps < 8; ++ps) {
        const int tt = ps * 16 + (tid >> 4), c = (tid & 15) * 8;
        float mv[8], uv[8]; unpack8(*(const u32x4*)(Ys + tt * YS_LD + c), mv); unpack8(*(const u32x4*)(proj + (size_t)(m0 + tt) * HY_IN + col0 + c), uv);
#pragma unroll
        for (int e = 0; e < 8; ++e) mv[e] *= uv[e];
        *(u32x4*)(y + (size_t)(m0 + tt) * HY_OUT + col0 + c) = pack8(mv);
    }
}

__device__ __forceinline__ void ret_ds_task(const Params& p, int ci, int h, int eh) {
    unsigned char* ws = p.ws;
    const int tid = opaque((int)threadIdx.x & 255), lane = tid & 63, w = tid >> 6, lr = lane & 31, hi = lane >> 5;
    const int m0 = ci * 128;
    const u16* proj = (const u16*)(ws + WS_PROJ);
    float* kd_s = (float*)(smem + 49152);
    const float l2g = ret_log2gamma(h);
    __syncthreads();
    if (tid < 128) kd_s[tid] = exp2f((float)(127 - tid) * l2g);
    f32x16 acc[4][1]; zero4(acc);
    for (int kb = 0; kb < 2; ++kb) {
        __syncthreads();
        { u32x4 rr[4]; gload_nat<128>(rr, (const u16*)(ws + WS_KT) + ((size_t)ci * 512 + h * 128) * 128 + kb * 64, 128, tid); sstore_nat<128>(0, rr, tid); }
        load_nat_colscale(16384, (const u16*)(ws + WS_VTR) + ((size_t)ci * 1024 + h * 256 + eh * 128) * 128 + kb * 64, 128, tid, kd_s + kb * 64);
        __syncthreads();
        mma_kb<4, 1>(acc, 0, 0, 16384, w * 32, lane);
    }
    float* dst = (float*)(ws + WS_DST) + (size_t)(ci * 4 + h) * 256 * 128;
#pragma unroll
    for (int i = 0; i < 4; ++i)
#pragma unroll
        for (int q = 0; q < 4; ++q) {
            const int d = i * 32 + 8 * q + 4 * hi, e = eh * 128 + w * 32 + lr;
            f32x4 v = {acc[i][0][4 * q], acc[i][0][4 * q + 1], acc[i][0][4 * q + 2], acc[i][0][4 * q + 3]};
            *(f32x4*)(dst + (size_t)e * 128 + d) = v;
        }
}

__device__ __forceinline__ void phase_mixA(const Params& p, int bid, int nb) {
    for (int t = bid; t < 2048; t += nb) {
        const int ci = t >> 4, sub = (t + ((t / nb) << 3)) & 15;
        if (sub < 8) gmlp_task(p, ci, sub >> 1, sub & 1); else ret_ds_task(p, ci, (sub - 8) >> 1, sub & 1);
    }
}

__device__ __forceinline__ void phase_scan(const Params& p, int bid, int nb) {
    float* base = (float*)(p.ws + WS_DST);
    for (int i = bid * 256 + opaque((int)threadIdx.x & 255); i < 4 * 4 * 256 * 128 / 4; i += nb * 256) {
        const int b = i >> 15, h = (i >> 13) & 3, rest = i & 8191;
        const float cd = exp2f(128.0f * ret_log2gamma(h));
        f32x4 s = {0.f, 0.f, 0.f, 0.f};
        float* ptr = base + ((size_t)(b * 32) * 4 + h) * 32768 + (size_t)rest * 4;
#pragma unroll 8
        for (int n = 0; n < 32; ++n) {
            f32x4* q = (f32x4*)(ptr + (size_t)n * 4 * 32768);
            const f32x4 tmp = *q; *q = s; s = s * cd + tmp;
        }
    }
}

__device__ __forceinline__ void ret_out_task(const Params& p, int ci, int h) {
    unsigned char* ws = p.ws;
    const int tid = opaque((int)threadIdx.x & 255), lane = tid & 63, w = tid >> 6, lr = lane & 31, hi = lane >> 5;
    const int m0 = ci * 128;
    const u16* proj = (const u16*)(ws + WS_PROJ);
    const float l2g = ret_log2gamma(h);
    const int qi = w * 32 + lr;
    constexpr int RA = 0, RB = 16384, RC = 49152;
    __syncthreads();
    {
        u32x4 r0[4], r1[4];
        const u16* qp = proj + (size_t)m0 * HY_IN + 2048 + h * 128; const u16* kp = proj + (size_t)m0 * HY_IN + 2560 + h * 128;
        gload_nat<128>(r0, qp, HY_IN, tid); gload_nat<128>(r1, qp + 64, HY_IN, tid);
        sstore_nat<128>(RC, r0, tid); sstore_nat<128>(RC + 16384, r1, tid);
        gload_nat<128>(r0, kp, HY_IN, tid); gload_nat<128>(r1, kp + 64, HY_IN, tid);
        sstore_nat<128>(RB, r0, tid); sstore_nat<128>(RB + 16384, r1, tid);
    }
    __syncthreads();
    {
        f32x16 sc[4][1]; zero4(sc);
        mma_kb<4, 1>(sc, RB, 0, RC, w * 32, lane);
        mma_kb<4, 1>(sc, RB + 16384, 0, RC + 16384, w * 32, lane);
        __syncthreads();
#pragma unroll
        for (int i = 0; i < 4; ++i)
#pragma unroll
            for (int q = 0; q < 4; ++q) {
                const int j = i * 32 + 8 * q + 4 * hi;
                float o[4];
#pragma unroll
                for (int e = 0; e < 4; ++e) { const int df = qi - (j + e); o[e] = (df >= 0) ? sc[i][0][4 * q + e] * exp2f((float)df * l2g) : 0.f; }
                u32x2 pk; pk.x = pk2(o[0], o[1]); pk.y = pk2(o[2], o[3]);
                *(u32x2*)(smem + RB + (j >> 6) * 16384 + toff_e(qi, j & 63)) = pk;
            }
#pragma unroll 2
        for (int i = 0; i < 8; ++i) {
            const int idx = tid + 256 * i, row = idx >> 4, c16 = idx & 15;
            unsigned char* ptr = smem + RC + (c16 >> 3) * 16384 + toff(row, c16 & 7);
            float f[8]; unpack8(*(const u32x4*)ptr, f);
            const float qd = exp2f((float)(row + 1) * l2g);
#pragma unroll
            for (int e = 0; e < 8; ++e) f[e] *= qd;
            *(u32x4*)ptr = pack8(f);
        }
    }
    const float* st = (const float*)(ws + WS_DST) + (size_t)(ci * 4 + h) * 256 * 128;
    float ssq = 0.f;
    u16* ytmp = (u16*)(ws + WS_Y) + (size_t)(m0 + qi) * HY_OUT + 1024 + h * 256;
    f32x16 acc[4][1];
#pragma unroll
    for (int eh = 0; eh < 2; ++eh) {
        zero4(acc);
        for (int kb = 0; kb < 4; ++kb) {
            __syncthreads();
            if (kb < 2) {
                { u32x4 rr[4]; gload_nat<128>(rr, (const u16*)(ws + WS_VTR) + ((size_t)ci * 1024 + h * 256 + eh * 128) * 128 + kb * 64, 128, tid); sstore_nat<128>(RA, rr, tid); }
            } else {
                const int d0 = (kb - 2) * 64, tq = opaque(tid);
#pragma unroll 2
                for (int i = 0; i < 8; ++i) {
                    const int idx = tq + 256 * i, row = idx >> 4, c4 = idx & 15;
                    const f32x4 v = *(const f32x4*)(st + (size_t)(eh * 128 + row) * 128 + d0 + c4 * 4);
                    u32x2 pk; pk.x = pk2(v[0], v[1]); pk.y = pk2(v[2], v[3]);
                    *(u32x2*)(smem + RA + toff_e(row, c4 * 4)) = pk;
                }
            }
            __syncthreads();
            mma_kb<4, 1>(acc, RA, 0, (kb < 2) ? (RB + kb * 16384) : (RC + (kb - 2) * 16384), w * 32, lane);
        }
#pragma unroll
        for (int i = 0; i < 4; ++i)
#pragma unroll
            for (int r = 0; r < 16; ++r) ssq += acc[i][0][r] * acc[i][0][r];
        if (eh == 0) {
#pragma unroll
            for (int i = 0; i < 4; ++i)
#pragma unroll
                for (int q = 0; q < 4; ++q) {
                    u32x2 pk; pk.x = pk2(acc[i][0][4 * q], acc[i][0][4 * q + 1]); pk.y = pk2(acc[i][0][4 * q + 2], acc[i][0][4 * q + 3]);
                    *(u32x2*)(ytmp + i * 32 + 8 * q + 4 * hi) = pk;
                }
        }
    }
    ssq += __shfl_xor(ssq, 32);
    const float rn = rsqrtf(ssq * (1.0f / 256.0f) + EPS);
    __syncthreads();
    u16* Ys = (u16*)smem;
#pragma unroll
    for (int i = 0; i < 4; ++i)
#pragma unroll
        for (int q = 0; q < 4; ++q) {
            const int e = i * 32 + 8 * q + 4 * hi;
            const f32x4 g0 = *(const f32x4*)(p.ret_norm + h * 256 + e), g1 = *(const f32x4*)(p.ret_norm + h * 256 + 128 + e);
            u32x2 pk; const u32x2 z = *(const u32x2*)(ytmp + e);
            pk.x = pk2(bflo(z.x) * rn * g0[0], bfhi(z.x) * rn * g0[1]); pk.y = pk2(bflo(z.y) * rn * g0[2], bfhi(z.y) * rn * g0[3]);
            *(u32x2*)(Ys + qi * YS_LD + e) = pk;
            pk.x = pk2(acc[i][0][4 * q] * rn * g1[0], acc[i][0][4 * q + 1] * rn * g1[1]); pk.y = pk2(acc[i][0][4 * q + 2] * rn * g1[2], acc[i][0][4 * q + 3] * rn * g1[3]);
            *(u32x2*)(Ys + qi * YS_LD + 128 + e) = pk;
        }
    __syncthreads();
    u16* y = (u16*)(ws + WS_Y);
#pragma unroll 4
    for (int ps = 0; ps < 16; ++ps) {
        const int tt = ps * 8 + (tid >> 5), c = (tid & 31) * 8;
        float mv[8], gv[8]; unpack8(*(const u32x4*)(Ys + tt * YS_LD + c), mv); unpack8(*(const u32x4*)(proj + (size_t)(m0 + tt) * HY_IN + 4096 + h * 256 + c), gv);
#pragma unroll
        for (int e = 0; e < 8; ++e) mv[e] *= gv[e];
        *(u32x4*)(y + (size_t)(m0 + tt) * HY_OUT + 1024 + h * 256 + c) = pack8(mv);
    }
}
__device__ __forceinline__ void phase_mixB(const Params& p, int bid, int nb) {
    for (int t = bid; t < 512; t += nb) ret_out_task(p, t >> 2, t & 3);
}

__device__ __forceinline__ void phase_gemm_residual(const Params& p, const u16* A, int lda, const u16* Bt, int K, const float* xsrc, float* xdst, const float* g, u16* hb, float* ssq2, int bid, int nb) {
    constexpr int NT = DM / 256;
    for (int it = 0;; ++it) {
        int mt, nt; if (!tile_map3<NT>(it, bid, nb, mt, nt)) break;
        gemm_tile3(A, lda, Bt, K, K, mt * 256, nt * 256, [&](int m0, int n0) {
            const int tid = opaque((int)threadIdx.x & 255);
#pragma unroll
            for (int ps = 0; ps < 8; ++ps) {
                const int m = ps * 16 + (tid >> 4), c = (tid & 15) * 8;
                float v[8]; cs_read8(m, c, v);
                const size_t o = (size_t)(m0 + m) * DM + n0 + c;
                const f32x4 a = *(const f32x4*)(xsrc + o), b = *(const f32x4*)(xsrc + o + 4);
                v[0] += a[0]; v[1] += a[1]; v[2] += a[2]; v[3] += a[3]; v[4] += b[0]; v[5] += b[1]; v[6] += b[2]; v[7] += b[3];
                *(f32x4*)(xdst + o) = (f32x4){v[0], v[1], v[2], v[3]}; *(f32x4*)(xdst + o + 4) = (f32x4){v[4], v[5], v[6], v[7]};
                float s = 0.f;
#pragma unroll
                for (int e = 0; e < 8; ++e) s += v[e] * v[e];
                s += __shfl_xor(s, 1); s += __shfl_xor(s, 2); s += __shfl_xor(s, 4); s += __shfl_xor(s, 8);
                if ((tid & 15) == 0) ssq2[(size_t)(m0 + m) * 8 + (n0 >> 7)] = s;
                const f32x4 ga = *(const f32x4*)(g + n0 + c), gb = *(const f32x4*)(g + n0 + c + 4);
                v[0] *= ga[0]; v[1] *= ga[1]; v[2] *= ga[2]; v[3] *= ga[3]; v[4] *= gb[0]; v[5] *= gb[1]; v[6] *= gb[2]; v[7] *= gb[3];
                *(u32x4*)(hb + o) = pack8(v);
            }
        });
    }
}
template <int K, int N>
__device__ __forceinline__ void phase_gemm_f32(const u16* A, const u16* Bt, float* C, int bid, int nb) {
    const int tid = opaque((int)threadIdx.x & 255);
    constexpr int NT = N / 256, lda = K, ldc = N;
    for (int it = 0;; ++it) {
        int mt, nt; if (!tile_map3<NT>(it, bid, nb, mt, nt)) break;
        gemm_tile3(A, lda, Bt, K, K, mt * 256, nt * 256, [&](int m0, int n0) {
            const int tid = opaque((int)threadIdx.x & 255);
#pragma unroll
            for (int ps = 0; ps < 8; ++ps) {
                const int m = ps * 16 + (tid >> 4), c = (tid & 15) * 8;
                float v[8]; cs_read8(m, c, v);
                const size_t o = (size_t)(m0 + m) * ldc + n0 + c;
                f32x4 ra = {v[0], v[1], v[2], v[3]}, rb = {v[4], v[5], v[6], v[7]};
                *(f32x4*)(C + o) = ra; *(f32x4*)(C + o + 4) = rb;
            }
        });
    }
}

__device__ __forceinline__ void ce_desc(float& a, float& b) { const float hi = fmaxf(a, b), lo = fminf(a, b); a = hi; b = lo; }
__device__ __forceinline__ void sort16_desc(float (&v)[16]) {
#pragma unroll
    for (int k = 2; k <= 16; k <<= 1)
#pragma unroll
        for (int j = k >> 1; j > 0; j >>= 1)
#pragma unroll
            for (int i = 0; i < 16; ++i) { const int l = i ^ j; if (l > i) { if ((i & k) == 0) ce_desc(v[i], v[l]); else ce_desc(v[l], v[i]); } }
}
__device__ __forceinline__ void merge16_desc(float (&A)[16], const float (&B)[16]) {
#pragma unroll
    for (int i = 0; i < 16; ++i) A[i] = fmaxf(A[i], B[15 - i]);
#pragma unroll
    for (int j = 8; j > 0; j >>= 1)
#pragma unroll
        for (int i = 0; i < 16; ++i) { const int l = i ^ j; if (l > i) ce_desc(A[i], A[l]); }
}
__device__ __forceinline__ void ins16(float (&L)[16], float e) {
#pragma unroll
    for (int i = 0; i < 16; ++i) { const float hi = fmaxf(L[i], e); e = fminf(L[i], e); L[i] = hi; }
}
__device__ __forceinline__ float row_rscale(const float* ssq2, int t) {
    const f32x4 a = *(const f32x4*)(ssq2 + (size_t)t * 8), b = *(const f32x4*)(ssq2 + (size_t)t * 8 + 4);
    return rsqrtf(((a[0] + a[1]) + (a[2] + a[3]) + (b[0] + b[1]) + (b[2] + b[3])) * (1.0f / DM) + EPS);
}
constexpr int TKA_OFF = 67584;
__device__ __forceinline__ void phase_scores_top16(const Params& p, int L, int bid, int nb) {
    const u16* A = (const u16*)(p.ws + WS_H); const u16* Bt = (const u16*)(p.ws + WS_WPQT) + (size_t)L * 2048 * DM;
    u16* experts = (u16*)(p.ws + WS_EXP); float* gates = (float*)(p.ws + WS_GATE);
    constexpr int NT = 2048 / 256;
    for (int it = 0;; ++it) {
        int mt, nt; if (!tile_map3<NT>(it, bid, nb, mt, nt)) break;
        gemm_tile3(A, DM, Bt, DM, DM, mt * 256, nt * 256, [&](int m0, int n0) {
            const int tid = opaque((int)threadIdx.x & 255);
            const int m = tid >> 1, half = tid & 1;
            float Lst[16];
#pragma unroll
            for (int g = 0; g < 4; ++g) {
                float v[16];
#pragma unroll
                for (int c = 0; c < 4; ++c) {
                    const f32x4 x = *(const f32x4*)(smem + (m * CS_LD + half * 64 + g * 16 + c * 4) * 4);
#pragma unroll
                    for (int e = 0; e < 4; ++e) v[c * 4 + e] = __uint_as_float((__float_as_uint(x[e]) & ~127u) | (unsigned)(half * 64 + g * 16 + c * 4 + e));
                }
                sort16_desc(v);
                if (g == 0) {
#pragma unroll
                    for (int i = 0; i < 16; ++i) Lst[i] = v[i];
                } else merge16_desc(Lst, v);
            }
            float P[16];
#pragma unroll
            for (int i = 0; i < 16; ++i) P[i] = __shfl_xor(Lst[i], 1);
            merge16_desc(Lst, P);
            float* la = (float*)(smem + TKA_OFF);
            if (((n0 >> 7) & 1) == 0) {
                if (half == 0) {
#pragma unroll
                    for (int i = 0; i < 16; ++i) la[i * 128 + m] = Lst[i];
                }
            } else {
                __syncthreads();
                float* lb = (float*)smem;
                if (half == 0) {
#pragma unroll
                    for (int i = 0; i < 16; ++i) lb[i * 128 + m] = Lst[i];
                }
                __syncthreads();
                if (tid < 128) {
                    const int tkn = tid;
                    float a[16];
#pragma unroll
                    for (int i = 0; i < 16; ++i) a[i] = la[i * 128 + tkn];
                    float bq[16];
#pragma unroll
                    for (int i = 0; i < 16; ++i) bq[i] = lb[i * 128 + tkn];
                    float c[16];
#pragma unroll
                    for (int i = 0; i < 16; ++i) c[i] = -INFINITY;
#pragma unroll
                    for (int i = 0; i < 16; ++i)
#pragma unroll
                        for (int j = 0; j < 16; ++j)
                            if ((i + 1) * (j + 1) <= 16) {
                                const float s = __uint_as_float(__float_as_uint(a[i]) & ~127u) + __uint_as_float(__float_as_uint(bq[j]) & ~127u);
                                ins16(c, __uint_as_float((__float_as_uint(s) & ~255u) | (unsigned)(i * 16 + j)));
                            }
                    const int t = m0 + tkn, th = t * 8 + (n0 >> 8);
                    const float rs = row_rscale((const float*)(p.ws + WS_SSQ), t);
                    float bs[16]; unsigned ex[16]; float mx = -INFINITY;
#pragma unroll
                    for (int k = 0; k < 16; ++k) {
                        const unsigned code = __float_as_uint(c[k]) & 255u;
                        const unsigned av = __float_as_uint(la[(code >> 4) * 128 + tkn]), bv = __float_as_uint(lb[(code & 15) * 128 + tkn]);
                        bs[k] = (__uint_as_float(av & ~127u) + __uint_as_float(bv & ~127u)) * rs;
                        ex[k] = (av & 127u) * 128u + (bv & 127u);
                        mx = fmaxf(mx, bs[k]);
                    }
                    float sum = 0.f;
#pragma unroll
                    for (int k = 0; k < 16; ++k) { bs[k] = __expf(bs[k] - mx); sum += bs[k]; }
                    const float inv = 1.0f / sum;
                    u32x4 e0, e1;
                    e0.x = ex[0] | (ex[1] << 16); e0.y = ex[2] | (ex[3] << 16); e0.z = ex[4] | (ex[5] << 16); e0.w = ex[6] | (ex[7] << 16);
                    e1.x = ex[8] | (ex[9] << 16); e1.y = ex[10] | (ex[11] << 16); e1.z = ex[12] | (ex[13] << 16); e1.w = ex[14] | (ex[15] << 16);
                    *(u32x4*)(experts + (size_t)th * 16) = e0; *(u32x4*)(experts + (size_t)th * 16 + 8) = e1;
#pragma unroll
                    for (int k4 = 0; k4 < 4; ++k4) { f32x4 g = {bs[4 * k4] * inv, bs[4 * k4 + 1] * inv, bs[4 * k4 + 2] * inv, bs[4 * k4 + 3] * inv}; *(f32x4*)(gates + (size_t)th * 16 + k4 * 4) = g; }
                }
            }
        });
    }
}

__device__ __forceinline__ void fp4x16_to_f32(const u32x2 r, float* f) {
#define FP4_PAIR(D, B) { const f32x2 pr = __builtin_amdgcn_cvt_scalef32_pk_f32_fp4(r[D], 1.0f, B); f[((D) * 4 + (B)) * 2] = pr[0]; f[((D) * 4 + (B)) * 2 + 1] = pr[1]; }
    FP4_PAIR(0, 0) FP4_PAIR(0, 1) FP4_PAIR(0, 2) FP4_PAIR(0, 3) FP4_PAIR(1, 0) FP4_PAIR(1, 1) FP4_PAIR(1, 2) FP4_PAIR(1, 3)
#undef FP4_PAIR
}
__device__ __forceinline__ float folded_sum8(const float (&d)[8], int lane) {
    float d4[4], d2[2], d1;
#pragma unroll
    for (int k = 0; k < 4; ++k) { const bool up = (lane & 32) != 0; const float keep = up ? d[k + 4] : d[k], send = up ? d[k] : d[k + 4]; d4[k] = keep + __shfl_xor(send, 32); }
#pragma unroll
    for (int k = 0; k < 2; ++k) { const bool up = (lane & 16) != 0; const float keep = up ? d4[k + 2] : d4[k], send = up ? d4[k] : d4[k + 2]; d2[k] = keep + __shfl_xor(send, 16); }
    { const bool up = (lane & 8) != 0; const float keep = up ? d2[1] : d2[0], send = up ? d2[0] : d2[1]; d1 = keep + __shfl_xor(send, 8); }
    d1 += __shfl_xor(d1, 4); d1 += __shfl_xor(d1, 2); d1 += __shfl_xor(d1, 1);
    return d1;
}
__device__ __forceinline__ void fp8x16_to_f32(const u32x4 r, float* f) {
#pragma unroll
    for (int c = 0; c < 4; ++c) {
        const f32x2 lo = __builtin_amdgcn_cvt_pk_f32_fp8((int)r[c], false), hi = __builtin_amdgcn_cvt_pk_f32_fp8((int)r[c], true);
        f[4 * c] = lo[0]; f[4 * c + 1] = lo[1]; f[4 * c + 2] = hi[0]; f[4 * c + 3] = hi[1];
    }
}
__device__ __forceinline__ void sort128(unsigned& k_lo, unsigned& k_hi, int lane) {
#pragma unroll
    for (int k = 2; k <= 128; k <<= 1)
#pragma unroll
        for (int j = k >> 1; j > 0; j >>= 1) {
            if (j == 64) { const unsigned lo = min(k_lo, k_hi), hi2 = max(k_lo, k_hi); k_lo = lo; k_hi = hi2; }
            else {
                const unsigned o_lo = __shfl_xor(k_lo, j), o_hi = __shfl_xor(k_hi, j);
                const bool upper = (lane & j) != 0;
                const bool asc_lo = (k == 128) ? true : ((lane & k) == 0), asc_hi = (k == 128) ? true : (((lane + 64) & k) == 0);
                k_lo = (upper != asc_lo) ? min(k_lo, o_lo) : max(k_lo, o_lo);
                k_hi = (upper != asc_hi) ? min(k_hi, o_hi) : max(k_hi, o_hi);
            }
        }
}
template <int MODE>
__device__ __forceinline__ void phase_peer(const Params& p, int L, const float* gnext, int bid, int nb) {
    const int tid = opaque((int)threadIdx.x & 255), lane = tid & 63, w = tid >> 6;
    const u16* H = (const u16*)(p.ws + WS_H);
    const unsigned char* U = p.ws + WS_UBF + (size_t)L * NEXP * DM; const unsigned char* V = p.ws + WS_VBF + (size_t)L * NEXP * (DM / 2);
    const float* Usc = (const float*)(p.ws + WS_USC) + (size_t)L * NEXP; const float* Vsc = (const float*)(p.ws + WS_VSC) + (size_t)L * NEXP;
    const u16* experts = (const u16*)(p.ws + WS_EXP); const float* gates = (const float*)(p.ws + WS_GATE);
    const int srcl = (((lane & 7) >> 2) & 1) * 32 + (((lane & 7) >> 1) & 1) * 16 + (lane & 1) * 8;
    constexpr int TP = 4;
    for (int tb = (bid * 4 + w) * TP; tb < T; tb += nb * 4 * TP) {
        unsigned k_lo[TP], k_hi[TP]; float w_lo[TP], w_hi[TP];
#pragma unroll
        for (int tk = 0; tk < TP; ++tk) {
            const int t = tb + tk;
            k_lo[tk] = ((unsigned)experts[(size_t)t * 128 + lane] << 7) | (unsigned)lane; k_hi[tk] = ((unsigned)experts[(size_t)t * 128 + 64 + lane] << 7) | (unsigned)(64 + lane);
            sort128(k_lo[tk], k_hi[tk], opaque(lane));
            w_lo[tk] = 0.f; w_hi[tk] = 0.f;
            __builtin_amdgcn_sched_barrier(0);
        }
#pragma unroll 1
        for (int eb = 0; eb < 128; eb += 16) {
#pragma unroll
            for (int tk = 0; tk < TP; ++tk) {
                u32x4 ru[16];
#pragma unroll
                for (int k = 0; k < 16; ++k) {
                    const int e = eb + k;
                    const unsigned ex = __builtin_amdgcn_readlane((e < 64) ? k_lo[tk] : k_hi[tk], e & 63) >> 7;
                    ru[k] = *(const u32x4*)(U + (size_t)ex * DM + lane * 16);
                }
                float xh[16];
                { const u16* hp = H + (size_t)(tb + tk) * DM + lane * 16; unpack8(*(const u32x4*)hp, xh); unpack8(*(const u32x4*)(hp + 8), xh + 8); }
                float dA[8], dB[8];
#pragma unroll
                for (int k = 0; k < 16; ++k) {
                    asm volatile("" : "+v"(ru[k]));
                    float s = 0.f;
                    if (MODE == 3) { s = __uint_as_float(ru[k][0]); } else {
                    float f[16]; fp8x16_to_f32(ru[k], f);
#pragma unroll
                    for (int i = 0; i < 16; ++i) s += f[i] * xh[i];
                    }
                    asm volatile("" : "+v"(s));
                    if (k < 8) dA[k] = s; else dB[k - 8] = s;
                }
                const float sA = folded_sum8(dA, lane), sB = folded_sum8(dB, lane);
                const float vA = __shfl(sA, srcl), vB = __shfl(sB, srcl);
                const int j = (lane & 63) - (eb & 63);
                const float val = ((j & 8) != 0) ? vB : vA;
                if (j >= 0 && j < 16) { if (eb < 64) w_lo[tk] = val; else w_hi[tk] = val; }
                __builtin_amdgcn_sched_barrier(0);
            }
        }
#pragma unroll
        for (int tk = 0; tk < TP; ++tk) {
            const int t = tb + tk;
            const float rs = row_rscale((const float*)(p.ws + WS_SSQ), t);
            const unsigned e0 = k_lo[tk] >> 7, e1 = k_hi[tk] >> 7;
            w_lo[tk] = gelu_f(w_lo[tk] * rs * Usc[e0]) * gates[(size_t)t * 128 + (k_lo[tk] & 127u)] * Vsc[e0];
            w_hi[tk] = gelu_f(w_hi[tk] * rs * Usc[e1]) * gates[(size_t)t * 128 + (k_hi[tk] & 127u)] * Vsc[e1];
        }
        float o[TP][16];
#pragma unroll
        for (int tk = 0; tk < TP; ++tk)
#pragma unroll
            for (int i = 0; i < 16; ++i) o[tk][i] = 0.f;
#pragma unroll 1
        for (int eb = 0; eb < 128; eb += 32) {
#pragma unroll
            for (int tk = 0; tk < TP; ++tk) {
                u32x2 rv[32]; float wk[32];
#pragma unroll
                for (int k = 0; k < 32; ++k) {
                    const int e = eb + k;
                    const unsigned ex = __builtin_amdgcn_readlane((e < 64) ? k_lo[tk] : k_hi[tk], e & 63) >> 7;
                    wk[k] = __uint_as_float(__builtin_amdgcn_readlane(__float_as_uint((e < 64) ? w_lo[tk] : w_hi[tk]), e & 63));
                    rv[k] = *(const u32x2*)(V + (size_t)ex * (DM / 2) + lane * 8);
                }
#pragma unroll
                for (int k = 0; k < 32; ++k) {
                    asm volatile("" : "+v"(rv[k]));
                    if (MODE == 3) { o[tk][k & 15] += __uint_as_float(rv[k][0]); } else {
                    float f[16]; fp4x16_to_f32(rv[k], f);
#pragma unroll
                    for (int i = 0; i < 16; ++i) o[tk][i] += wk[k] * f[i];
                    }
                    asm volatile("" : "+v"(o[tk][0]), "+v"(o[tk][1]), "+v"(o[tk][2]), "+v"(o[tk][3]), "+v"(o[tk][4]), "+v"(o[tk][5]), "+v"(o[tk][6]), "+v"(o[tk][7]),
                                      "+v"(o[tk][8]), "+v"(o[tk][9]), "+v"(o[tk][10]), "+v"(o[tk][11]), "+v"(o[tk][12]), "+v"(o[tk][13]), "+v"(o[tk][14]), "+v"(o[tk][15]));
                }
            }
        }
#pragma unroll
        for (int tk = 0; tk < TP; ++tk) {
            const int t = tb + tk;
            float* xr = ((MODE >= 2) ? (float*)(p.ws + WS_PROJ) : p.out) + (size_t)t * DM + lane * 16;
            if (MODE >= 2) {
#pragma unroll
                for (int c = 0; c < 4; ++c) *(f32x4*)(xr + 4 * c) = (f32x4){o[tk][4 * c], o[tk][4 * c + 1], o[tk][4 * c + 2], o[tk][4 * c + 3]};
                continue;
            }
            float xv[16];
#pragma unroll
            for (int c = 0; c < 4; ++c) { const f32x4 a = *(const f32x4*)(xr + 4 * c); xv[4 * c] = a[0]; xv[4 * c + 1] = a[1]; xv[4 * c + 2] = a[2]; xv[4 * c + 3] = a[3]; }
            float ss = 0.f;
#pragma unroll
            for (int i = 0; i < 16; ++i) { xv[i] += o[tk][i]; ss += xv[i] * xv[i]; }
            ss = wave_sum(ss);
            const float rn = rsqrtf(ss * (1.0f / DM) + EPS);
            float gv[16];
#pragma unroll
            for (int c = 0; c < 4; ++c) { const f32x4 a = *(const f32x4*)(gnext + lane * 16 + 4 * c); gv[4 * c] = a[0]; gv[4 * c + 1] = a[1]; gv[4 * c + 2] = a[2]; gv[4 * c + 3] = a[3]; }
            if (MODE == 0) {
#pragma unroll
                for (int c = 0; c < 4; ++c) *(f32x4*)(xr + 4 * c) = (f32x4){xv[4 * c], xv[4 * c + 1], xv[4 * c + 2], xv[4 * c + 3]};
                float hv[16];
#pragma unroll
                for (int i = 0; i < 16; ++i) hv[i] = xv[i] * rn * gv[i];
                u16* hp = (u16*)(p.ws + WS_H) + (size_t)t * DM + lane * 16;
                *(u32x4*)hp = pack8(hv); *(u32x4*)(hp + 8) = pack8(hv + 8);
            } else {
#pragma unroll
                for (int c = 0; c < 4; ++c) *(f32x4*)(xr + 4 * c) = (f32x4){xv[4 * c] * rn * gv[4 * c], xv[4 * c + 1] * rn * gv[4 * c + 1], xv[4 * c + 2] * rn * gv[4 * c + 2], xv[4 * c + 3] * rn * gv[4 * c + 3]};
            }
        }
    }
}

__device__ __forceinline__ void phase_mla_norm(const Params& p, int bid, int nb) {
    const int tid = opaque((int)threadIdx.x & 255), lane = tid & 63, w = tid >> 6;
    const float* down = (const float*)(p.ws + WS_DOWN);
    u16* cqn = (u16*)(p.ws + WS_CQN); u16* ckvn = (u16*)(p.ws + WS_CKVN); u16* kr = (u16*)(p.ws + WS_KROPE);
    const f32x2* rope = (const f32x2*)(p.ws + WS_ROPE_M);
    for (int t = bid * 4 + w; t < T; t += nb * 4) {
        const float* dr = down + (size_t)t * MLA_DOWN_PAD;
        float q[6], kv[4];
#pragma unroll
        for (int i = 0; i < 6; ++i) q[i] = dr[i * 64 + lane];
#pragma unroll
        for (int i = 0; i < 4; ++i) kv[i] = dr[384 + i * 64 + lane];
        const float rp = dr[640 + lane];
        float sq = 0.f, sk = 0.f;
#pragma unroll
        for (int i = 0; i < 6; ++i) sq += q[i] * q[i];
#pragma unroll
        for (int i = 0; i < 4; ++i) sk += kv[i] * kv[i];
        sq = wave_sum(sq); sk = wave_sum(sk);
        const float rq = rsqrtf(sq * (1.0f / MLA_QR) + EPS), rk = rsqrtf(sk * (1.0f / MLA_KVR) + EPS);
#pragma unroll
        for (int i = 0; i < 6; ++i) cqn[(size_t)t * MLA_QR + i * 64 + lane] = f2bf(q[i] * rq * p.mla_q_norm[i * 64 + lane]);
#pragma unroll
        for (int i = 0; i < 4; ++i) ckvn[(size_t)t * MLA_KVR + i * 64 + lane] = f2bf(kv[i] * rk * p.mla_kv_norm[i * 64 + lane]);
        const float other = __shfl_xor(rp, 32);
        const f32x2 cssn = rope[(size_t)(t & (SEQ - 1)) * 32 + (lane & 31)];
        const float res = (lane < 32) ? (rp * cssn[0] - other * cssn[1]) : (other * cssn[1] + rp * cssn[0]);
        kr[(size_t)t * 64 + lane] = f2bf(res);
    }
}

__device__ __forceinline__ void phase_mla_up(const Params& p, int bid, int nb) {
    unsigned char* ws = p.ws;
    const f32x2* rope = (const f32x2*)(ws + WS_ROPE_M);
    u16* qo = (u16*)(ws + WS_Q); u16* kvo = (u16*)(ws + WS_KV);
    constexpr int NTQ = 1536 / 256, NTKV = 2048 / 256, NTT = NTQ + NTKV;
    for (int it = 0;; ++it) {
        int mt, nt; if (!tile_map3<NTT>(it, bid, nb, mt, nt)) break;
        const bool isq = nt < NTQ;
        const u16* A = (const u16*)(ws + (isq ? WS_CQN : WS_CKVN)); const u16* Bt = (const u16*)(ws + (isq ? WS_WQUPT : WS_WKVUPT));
        const int K = isq ? MLA_QR : MLA_KVR, ntl = isq ? nt : nt - NTQ;
        gemm_tile3(A, K, Bt, K, K, mt * 256, ntl * 256, [&](int m0, int n0) {
            const int tid = opaque((int)threadIdx.x & 255);
            if (isq) {
#pragma unroll
                for (int ps = 0; ps < 8; ++ps) {
                    const int m = ps * 16 + (tid >> 4), c = (tid & 15) * 8;
                    const int within = (n0 + c) % 192;
                    u16* dst = qo + (size_t)(m0 + m) * 1536 + n0 + c;
                    if (within < 128) { float v[8]; cs_read8(m, c, v); *(u32x4*)dst = pack8(v); }
                    else if (within < 160) {
                        float x1[8], x2[8], y1[8], y2[8]; cs_read8(m, c, x1); cs_read8(m, c + 32, x2);
                        const f32x2* rp = rope + (size_t)((m0 + m) & (SEQ - 1)) * 32 + (within - 128);
#pragma unroll
                        for (int e = 0; e < 8; ++e) { const f32x2 cssn = rp[e]; y1[e] = x1[e] * cssn[0] - x2[e] * cssn[1]; y2[e] = x1[e] * cssn[1] + x2[e] * cssn[0]; }
                        *(u32x4*)dst = pack8(y1); *(u32x4*)(dst + 32) = pack8(y2);
                    }
                }
            } else {
                const int head = n0 >> 8;
                if (((n0 >> 7) & 1) == 0) {
#pragma unroll
                    for (int ps = 0; ps < 8; ++ps) {
                        const int m = ps * 16 + (tid >> 4), c = (tid & 15) * 8;
                        float v[8]; cs_read8(m, c, v);
                        *(u32x4*)(kvo + (size_t)(m0 + m) * 1024 + head * 128 + c) = pack8(v);
                    }
                } else {
                    u16* vT = kvo + (size_t)T * 1024 + ((size_t)((m0 >> 12) * 8 + head) * 128) * SEQ + (m0 & (SEQ - 1));
#pragma unroll
                    for (int ps = 0; ps < 8; ++ps) {
                        const int dv = ps * 16 + (tid >> 4), tk8 = (tid & 15) * 8;
                        float v[8];
#pragma unroll
                        for (int e = 0; e < 8; ++e) v[e] = *(const float*)(smem + ((tk8 + e) * CS_LD + dv) * 4);
                        *(u32x4*)(vT + (size_t)dv * SEQ + tk8) = pack8(v);
                    }
                }
            }
        });
    }
}

__device__ __forceinline__ int crow(int r, int hi) { return (r & 3) + 8 * (r >> 2) + 4 * hi; }
template <int ROWS, bool PERM>
__device__ __forceinline__ void glds_rows(int lds, const u16* src, size_t ld, int tid) {
    const int lane = tid & 63, w = tid >> 6;
#pragma unroll
    for (int i = 0; i < ROWS / 32; ++i) {
        const int r0 = (w * (ROWS / 32) + i) * 8, r = r0 + (lane >> 3), c8 = (lane & 7) ^ ((r >> 1) & 7);
        const int sr = PERM ? ((r & ~12) | ((r & 4) << 1) | ((r & 8) >> 1)) : r;
        __builtin_amdgcn_global_load_lds((const unsigned*)(src + (size_t)sr * ld + c8 * 8), (unsigned*)(smem + lds + r0 * 128), 16, 0, 0);
    }
}
constexpr int ATT_STAGE = 40960;
__device__ __forceinline__ void attn_task(const Params& p, int b, int h, int qb) {
    unsigned char* ws = p.ws;
    const int tid = opaque((int)threadIdx.x & 255), lane = tid & 63, w = tid >> 6, lr = lane & 31, hi = lane >> 5;
    const u16* Q = (const u16*)(ws + WS_Q); const u16* KN = (const u16*)(ws + WS_KV); const u16* KR = (const u16*)(ws + WS_KROPE);
    const u16* VT = KN + (size_t)T * 1024 + (size_t)((b * 8 + h) * 128) * SEQ;
    const int t0 = b * SEQ, q0 = qb * 128, qrow = q0 + w * 32 + lr;
    const int ntiles = (q0 + 128) >> 6;
    __syncthreads();
    bf16x8 qf[12];
#pragma unroll
    for (int s = 0; s < 12; ++s) qf[s] = *(const bf16x8*)(Q + (size_t)(t0 + qrow) * 1536 + h * 192 + s * 16 + hi * 8);
    auto fill = [&](int jt, int st) {
        const int j0 = jt * 64;
        glds_rows<64, true>(st, KN + (size_t)(t0 + j0) * 1024 + h * 128, 1024, tid);
        glds_rows<64, true>(st + 8192, KN + (size_t)(t0 + j0) * 1024 + h * 128 + 64, 1024, tid);
        glds_rows<64, true>(st + 16384, KR + (size_t)(t0 + j0) * 64, 64, tid);
        glds_rows<128, false>(st + 24576, VT + j0, SEQ, tid);
    };
    fill(0, 0);
    f32x16 o[4];
#pragma unroll
    for (int i = 0; i < 4; ++i)
#pragma unroll
        for (int r = 0; r < 16; ++r) o[i][r] = 0.f;
    float m = -1e30f, l = 0.f;
    const float c2 = 0.07216878364870322f * 1.4426950408889634f;
    for (int jt = 0; jt < ntiles; ++jt) {
        const int j0 = jt * 64, st = (jt & 1) * ATT_STAGE;
        asm volatile("s_waitcnt vmcnt(0)" ::: "memory");
        __syncthreads();
        if (jt + 1 < ntiles) fill(jt + 1, st ^ ATT_STAGE);
        f32x16 s0, s1;
#pragma unroll
        for (int r = 0; r < 16; ++r) { s0[r] = 0.f; s1[r] = 0.f; }
#pragma unroll
        for (int kbk = 0; kbk < 3; ++kbk) {
            bf16x8 a0[4], a1[4];
#pragma unroll
            for (int s = 0; s < 4; ++s) { const int c8 = 2 * s + hi; a0[s] = *(const bf16x8*)(smem + st + kbk * 8192 + toff(lr, c8)); a1[s] = *(const bf16x8*)(smem + st + kbk * 8192 + toff(32 + lr, c8)); }
            __builtin_amdgcn_sched_barrier(0);
#pragma unroll
            for (int s = 0; s < 4; ++s) {
                s0 = __builtin_amdgcn_mfma_f32_32x32x16_bf16(a0[s], qf[kbk * 4 + s], s0, 0, 0, 0);
                s1 = __builtin_amdgcn_mfma_f32_32x32x16_bf16(a1[s], qf[kbk * 4 + s], s1, 0, 0, 0);
            }
            __builtin_amdgcn_sched_barrier(0);
        }
        if (j0 + 63 > q0 + w * 32) {
#pragma unroll
            for (int r = 0; r < 16; ++r) {
                const int ko = 16 * (r >> 3) + 8 * hi + 4 * ((r >> 2) & 1) + (r & 3);
                if (j0 + ko > qrow) s0[r] = -INFINITY;
                if (j0 + 32 + ko > qrow) s1[r] = -INFINITY;
            }
        }
        float mx = s0[0];
#pragma unroll
        for (int r = 1; r < 16; ++r) mx = fmaxf(mx, s0[r]);
#pragma unroll
        for (int r = 0; r < 16; ++r) mx = fmaxf(mx, s1[r]);
        mx = fmaxf(mx, __shfl_xor(mx, 32));
        const float mn = fmaxf(m, mx), alpha = __builtin_amdgcn_exp2f((m - mn) * c2), nmc = -mn * c2;
        m = mn;
        float rs = 0.f;
#pragma unroll
        for (int r = 0; r < 16; ++r) { s0[r] = __builtin_amdgcn_exp2f(fmaf(s0[r], c2, nmc)); s1[r] = __builtin_amdgcn_exp2f(fmaf(s1[r], c2, nmc)); rs += s0[r] + s1[r]; }
        l = l * alpha + rs;
#pragma unroll
        for (int i = 0; i < 4; ++i)
#pragma unroll
            for (int r = 0; r < 16; ++r) o[i][r] *= alpha;
        bf16x8 pf[4];
#pragma unroll
        for (int ks = 0; ks < 4; ++ks) {
            u32x4 wv; const int bs = 8 * (ks & 1);
            if (ks < 2) { wv.x = pk2(s0[bs], s0[bs + 1]); wv.y = pk2(s0[bs + 2], s0[bs + 3]); wv.z = pk2(s0[bs + 4], s0[bs + 5]); wv.w = pk2(s0[bs + 6], s0[bs + 7]); }
            else { wv.x = pk2(s1[bs], s1[bs + 1]); wv.y = pk2(s1[bs + 2], s1[bs + 3]); wv.z = pk2(s1[bs + 4], s1[bs + 5]); wv.w = pk2(s1[bs + 6], s1[bs + 7]); }
            pf[ks] = __builtin_bit_cast(bf16x8, wv);
        }
#pragma unroll
        for (int kh = 0; kh < 2; ++kh) {
            bf16x8 av[2][4];
#pragma unroll
            for (int k2 = 0; k2 < 2; ++k2)
#pragma unroll
                for (int dvb = 0; dvb < 4; ++dvb) av[k2][dvb] = *(const bf16x8*)(smem + st + 24576 + toff(dvb * 32 + lr, 2 * (kh * 2 + k2) + hi));
            __builtin_amdgcn_sched_barrier(0);
#pragma unroll
            for (int k2 = 0; k2 < 2; ++k2)
#pragma unroll
                for (int dvb = 0; dvb < 4; ++dvb) o[dvb] = __builtin_amdgcn_mfma_f32_32x32x16_bf16(av[k2][dvb], pf[kh * 2 + k2], o[dvb], 0, 0, 0);
            __builtin_amdgcn_sched_barrier(0);
        }
    }
    l += __shfl_xor(l, 32);
    const float inv = 1.0f / l;
    __syncthreads();
    u16* Os = (u16*)smem;
#pragma unroll
    for (int dvb = 0; dvb < 4; ++dvb)
#pragma unroll
        for (int q = 0; q < 4; ++q) {
            const int dv = dvb * 32 + 8 * q + 4 * hi;
            u32x2 pk; pk.x = pk2(o[dvb][4 * q] * inv, o[dvb][4 * q + 1] * inv); pk.y = pk2(o[dvb][4 * q + 2] * inv, o[dvb][4 * q + 3] * inv);
            *(u32x2*)(Os + (w * 32 + lr) * 136 + dv) = pk;
        }
    __syncthreads();
    u16* O = (u16*)(ws + WS_O);
#pragma unroll
    for (int ps = 0; ps < 8; ++ps) {
        const int qq = ps * 16 + (tid >> 4), c = (tid & 15) * 8;
        *(u32x4*)(O + (size_t)(t0 + q0 + qq) * DM + h * 128 + c) = *(const u32x4*)(Os + qq * 136 + c);
    }
}
__device__ __forceinline__ void phase_attn(const Params& p, int bid, int nb) {
    const int x = bid & 7, lb = bid >> 3, nlb = nb >> 3, vh = vhalf();
    for (int it = 0;; ++it) {
        const int c = it * nlb + lb;
        if (c >= 64) break;
        const int bh = x * 4 + (c >> 5) * 2 + vh, q = c & 31, qb = (it & 1) ? q : 31 - q;
        attn_task(p, bh >> 3, bh & 7, qb);
    }
}

#define XB_TMO      128
#define XB_XCNT(j)  (256  + 64 * (j))
#define XB_XSUB(j)  (1280 + 64 * (j))
#define XB_XGEN(j)  (2304 + 64 * (j))
#define XB_TOP      3328
#define XB_TOPGEN   3392
#define XCD_BAR_WORDS 3456
#define XB_SPIN_CAP (1u << 22)
#define LAS __attribute__((address_space(3)))
__device__ __forceinline__ unsigned xb_ld(unsigned* p)              { return __hip_atomic_load(p, __ATOMIC_RELAXED, __HIP_MEMORY_SCOPE_AGENT); }
__device__ __forceinline__ unsigned xb_add(unsigned* p, unsigned v) { return __hip_atomic_fetch_add(p, v, __ATOMIC_RELAXED, __HIP_MEMORY_SCOPE_AGENT); }
__device__ __forceinline__ unsigned xb_xcc_id() { return (unsigned)__builtin_amdgcn_s_getreg((3 << 11) | 20) & 0xFu; }
#define XB_SPIN(cond, bar) do { unsigned _sp = 0; while (cond) { __builtin_amdgcn_s_sleep(1); \
    if ((++_sp & 255u) == 0u) { if (xb_ld(&(bar)[XB_TMO])) break; if (_sp > XB_SPIN_CAP) { atomicAdd(&(bar)[XB_TMO], 1u); break; } } } } while (0)
__device__ __forceinline__ void xcd_barrier_complete(unsigned* bar, unsigned x, unsigned& nloc, unsigned& nx) {
    const unsigned G = gridDim.x;
    unsigned sum, cnt, mine, sp = 0u;
    for (;;) {
        sum = 0u; cnt = 0u; mine = 0u;
#pragma unroll
        for (unsigned j = 0; j < 16; ++j) { const unsigned c = xb_ld(&bar[XB_XCNT(j)]); sum += c; cnt += (c > 0u) ? 1u : 0u; mine = (j == x) ? c : mine; }
        if (sum == G) break;
        __builtin_amdgcn_s_sleep(1);
        if ((++sp & 255u) == 0u) { if (xb_ld(&bar[XB_TMO])) break; if (sp > XB_SPIN_CAP) { atomicAdd(&bar[XB_TMO], 1u); break; } }
    }
    nloc = mine > 0u ? mine : 1u; nx = cnt > 0u ? cnt : 1u;
}
__device__ __forceinline__ void xcd_barrier(unsigned* bar, unsigned nloc, unsigned nx) {
    asm volatile("s_waitcnt vmcnt(0)" ::: "memory");
    __syncthreads();
    if (threadIdx.x == 0) {
        const unsigned x = xb_xcc_id();
        __builtin_amdgcn_s_waitcnt(0);
        const unsigned old = xb_add(&bar[XB_XSUB(x)], 1u);
        const unsigned gen = old / nloc;
        if (old + 1u == (gen + 1u) * nloc) {
            __builtin_amdgcn_fence(__ATOMIC_RELEASE, "agent");
            asm volatile("s_waitcnt vmcnt(0)" ::: "memory");
            const unsigned og = xb_add(&bar[XB_TOP], 1u);
            const unsigned tg = og / nx;
            if (og + 1u == (tg + 1u) * nx) xb_add(&bar[XB_TOPGEN], 1u);
            else XB_SPIN(xb_ld(&bar[XB_TOPGEN]) == tg, bar);
            __builtin_amdgcn_fence(__ATOMIC_ACQUIRE, "agent");
            xb_add(&bar[XB_XGEN(x)], 1u);
            asm volatile("s_waitcnt vmcnt(0)" ::: "memory");
        } else {
            XB_SPIN(xb_ld(&bar[XB_XGEN(x)]) == gen, bar);
            __builtin_amdgcn_fence(__ATOMIC_ACQUIRE, "agent");
            asm volatile("s_waitcnt vmcnt(0)" ::: "memory");
        }
    }
    __syncthreads();
}

constexpr int NPHASES = 15;
template <int PH>
__device__ __forceinline__ void run_phase(const Params& p, int rbid, int rnb) {
    unsigned char* ws = p.ws;
    u16* hb = (u16*)(ws + WS_H); float* ssq2 = (float*)(ws + WS_SSQ);
    constexpr bool REAL = (PH == 1 || PH == 5 || PH == 6 || PH == 8 || PH == 10 || PH == 11 || PH == 12 || PH == 13);
    const int bid = REAL ? rbid : rbid * 2 + vhalf(), nb = REAL ? rnb : rnb * 2;
    if constexpr (PH == 0) phase_prep(p, bid, nb);
    else if constexpr (PH == 1) phase_inproj(p, bid, nb);
    else if constexpr (PH == 2) phase_mixA(p, bid, nb);
    else if constexpr (PH == 3) phase_scan(p, bid, nb);
    else if constexpr (PH == 4) phase_mixB(p, bid, nb);
    else if constexpr (PH == 5) phase_gemm_residual(p, (const u16*)(ws + WS_Y), HY_OUT, (const u16*)(ws + WS_WOUTT), HY_OUT, p.x, p.out, p.norm_ffn, hb, ssq2, bid, nb);
    else if constexpr (PH == 6) phase_scores_top16(p, 0, bid, nb);
    else if constexpr (PH == 7) phase_peer<0>(p, 0, p.norm_mix + DM, bid, nb);
    else if constexpr (PH == 8) phase_gemm_f32<DM, MLA_DOWN_PAD>((const u16*)(ws + WS_H), (const u16*)(ws + WS_WDOWNT), (float*)(ws + WS_DOWN), bid, nb);
    else if constexpr (PH == 9) phase_mla_norm(p, bid, nb);
    else if constexpr (PH == 10) phase_mla_up(p, bid, nb);
    else if constexpr (PH == 11) phase_attn(p, bid, nb);
    else if constexpr (PH == 12) phase_gemm_residual(p, (const u16*)(ws + WS_O), DM, (const u16*)(ws + WS_WMOT), DM, p.out, p.out, p.norm_ffn + DM, hb, ssq2, bid, nb);
    else if constexpr (PH == 13) phase_scores_top16(p, 1, bid, nb);
    else if constexpr (PH == 14) phase_peer<1>(p, 1, p.final_norm, bid, nb);
}

typedef const __attribute__((address_space(4))) unsigned long long* cptr64;
typedef __attribute__((address_space(1))) unsigned char* gptr8;
__device__ __forceinline__ void load_params(Params& r, cptr64 s) {
    const float** f = (const float**)&r;
#pragma unroll
    for (int i = 0; i < 20; ++i) f[i] = (const float*)(gptr8)s[i];
    r.out = (float*)(gptr8)s[20]; r.ws = (unsigned char*)(gptr8)s[21];
}
#ifdef PROBE_A_LO
__device__ __forceinline__ void probe_stamp(cptr64 ka, int k) {
    if (blockIdx.x == 0 && threadIdx.x == 0) { unsigned long long* ts = (unsigned long long*)((unsigned char*)ka[21] + WS_TS); __hip_atomic_store(&ts[k], (unsigned long long)__builtin_amdgcn_s_memrealtime(), __ATOMIC_RELAXED, __HIP_MEMORY_SCOPE_AGENT); }
}
__device__ __forceinline__ void probe_emit(cptr64 ka) {
    unsigned long long* ts = (unsigned long long*)((unsigned char*)ka[21] + WS_TS);
    const float ta = (float)(long long)(__hip_atomic_load(&ts[PROBE_A_HI], __ATOMIC_RELAXED, __HIP_MEMORY_SCOPE_AGENT) - __hip_atomic_load(&ts[PROBE_A_LO], __ATOMIC_RELAXED, __HIP_MEMORY_SCOPE_AGENT)) * 0.01f;
    const float tb = (float)(long long)(__hip_atomic_load(&ts[PROBE_B_HI], __ATOMIC_RELAXED, __HIP_MEMORY_SCOPE_AGENT) - __hip_atomic_load(&ts[PROBE_B_LO], __ATOMIC_RELAXED, __HIP_MEMORY_SCOPE_AGENT)) * 0.01f;
    float* out = (float*)ka[20];
    for (int i = blockIdx.x * 256 + threadIdx.x; i < 1024 * DM; i += gridDim.x * 256) out[i] += tb * 0.01f;
    if (blockIdx.x == 0 && threadIdx.x == 0) out[(size_t)T * DM - 1] = ta;
}
#endif
#ifndef DUP_MASK
#define DUP_MASK 0u
#endif
template <int PH>
__device__ __forceinline__ void run_dup(const Params& lp, int bid, int nb) {
    unsigned char* ws = lp.ws;
    if constexpr (PH == 7) phase_peer<2>(lp, 0, lp.norm_mix + DM, bid, nb);
    else if constexpr (PH == 14) phase_peer<2>(lp, 1, lp.final_norm, bid, nb);
    else if constexpr (PH == 12) phase_gemm_residual(lp, (const u16*)(ws + WS_O), DM, (const u16*)(ws + WS_WMOT), DM, lp.out, (float*)(ws + WS_PROJ), lp.norm_ffn + DM, (u16*)(ws + WS_PROJ + (size_t)T * DM * 4), (float*)(ws + WS_PROJ + (size_t)T * DM * 6), bid, nb);
    else if constexpr (PH == 3) {}
#ifdef PROBE_GM
    else if constexpr (PH == 1) phase_inproj<PROBE_GM>(lp, bid, nb);
#endif
    else run_phase<PH>(lp, bid, nb);
}
template <int PH>
__device__ __forceinline__ void run_from(cptr64 ka, unsigned nloc, unsigned nx) {
#ifdef PROBE_A_LO
    probe_stamp(ka, PH);
#endif
    if constexpr (((DUP_MASK >> PH) & 1u) != 0u) {
        cptr64 q = ka; asm volatile("" : "+s"(q));
        Params lp; load_params(lp, q);
        run_dup<PH>(lp, (int)blockIdx.x, (int)gridDim.x);
        xcd_barrier((unsigned*)((unsigned char*)q[21] + WS_BAR), nloc, nx);
    }
    {
        cptr64 q = ka; asm volatile("" : "+s"(q));
        Params lp; load_params(lp, q);
        run_phase<PH>(lp, (int)blockIdx.x, (int)gridDim.x);
    }
    if constexpr (PH + 1 < NPHASES) {
        cptr64 q = ka; asm volatile("" : "+s"(q));
        xcd_barrier((unsigned*)((unsigned char*)q[21] + WS_BAR), nloc, nx);
        run_from<PH + 1>(ka, nloc, nx);
    }
#ifdef PROBE_A_LO
    else {
        cptr64 q = ka; asm volatile("" : "+s"(q));
        xcd_barrier((unsigned*)((unsigned char*)q[21] + WS_BAR), nloc, nx);
        probe_stamp(ka, NPHASES);
        xcd_barrier((unsigned*)((unsigned char*)q[21] + WS_BAR), nloc, nx);
        probe_emit(ka);
    }
#endif
}
__global__ void __launch_bounds__(NTHREADS, 2) k_mega(Params p_unused) {
    cg::grid_group grid = cg::this_grid();
    cptr64 ka = (cptr64)__builtin_amdgcn_kernarg_segment_ptr();
    unsigned* bar = (unsigned*)((unsigned char*)ka[21] + WS_BAR);
    if (threadIdx.x == 0) (void)xb_add(&bar[XB_XCNT(xb_xcc_id())], 1u);
#ifdef PROBE_A_LO
    probe_stamp(ka, 0);
#endif
    {
        cptr64 q = ka; asm volatile("" : "+s"(q));
        Params lp; load_params(lp, q);
        run_phase<0>(lp, (int)blockIdx.x, (int)gridDim.x);
    }
    if constexpr ((DUP_MASK & 1u) != 0u) {
        __syncthreads();
        cptr64 q = ka; asm volatile("" : "+s"(q));
        Params lp; load_params(lp, q);
        run_phase<0>(lp, (int)blockIdx.x, (int)gridDim.x);
    }
    unsigned nloc, nx;
    {
        const unsigned x = xb_xcc_id(), G = gridDim.x;
        unsigned cnt, mine, sum, sp = 0u;
        for (;;) {
            sum = 0u; cnt = 0u; mine = 0u;
#pragma unroll
            for (unsigned j = 0; j < 16; ++j) { const unsigned c = __builtin_amdgcn_readfirstlane(xb_ld(&bar[XB_XCNT(j)])); sum += c; cnt += (c > 0u) ? 1u : 0u; mine = (j == x) ? c : mine; }
            if (sum == G) break;
            __builtin_amdgcn_s_sleep(2);
            if (++sp > XB_SPIN_CAP) break;
        }
        nloc = __builtin_amdgcn_readfirstlane(mine > 0u ? mine : 1u); nx = __builtin_amdgcn_readfirstlane(cnt > 0u ? cnt : 1u);
    }
    xcd_barrier(bar, nloc, nx);
    run_from<1>(ka, nloc, nx);
}

extern "C" void kernel_launch(void* const* d_in, const int* in_sizes, int n_in, void* d_out, int out_size, void* d_ws, size_t ws_size, hipStream_t stream) {
    if (n_in != 20 || out_size != T * DM || ws_size < WS_END) { fprintf(stderr, "kernel_launch: unexpected shapes (n_in %d out %d ws %zu need %zu)\n", n_in, out_size, ws_size, (size_t)WS_END); return; }
    static int grid_blocks = 0;
    if (!grid_blocks) {
        int dev = 0, cus = 0, per_cu = 0;
        (void)hipGetDevice(&dev);
        (void)hipDeviceGetAttribute(&cus, hipDeviceAttributeMultiprocessorCount, dev);
        if (hipFuncSetAttribute((const void*)k_mega, hipFuncAttributeMaxDynamicSharedMemorySize, LDS_TOTAL) != hipSuccess) { fprintf(stderr, "kernel_launch: hipFuncSetAttribute failed\n"); return; }
        if (hipOccupancyMaxActiveBlocksPerMultiprocessor(&per_cu, (const void*)k_mega, NTHREADS, LDS_TOTAL) != hipSuccess || per_cu < 1) { fprintf(stderr, "kernel_launch: occupancy query failed (%d)\n", per_cu); return; }
        if (per_cu > 1) per_cu = 1;
        grid_blocks = cus * per_cu;
        fprintf(stderr, "kernel_launch: %d CUs x %d blocks\n", cus, per_cu);
    }
    Params p{};
    const float** f = (const float**)&p;
    for (int i = 0; i < 20; ++i) f[i] = (const float*)d_in[i];
    p.out = (float*)d_out; p.ws = (unsigned char*)d_ws;
    (void)hipMemsetAsync((unsigned char*)d_ws + WS_BAR, 0, 16384, stream);
    void* args[] = {&p};
    hipError_t e = hipLaunchCooperativeKernel((const void*)k_mega, dim3(grid_blocks), dim3(NTHREADS), args, LDS_TOTAL, stream);
    if (e != hipSuccess) fprintf(stderr, "cooperative launch failed: %s (grid %d)\n", hipGetErrorString(e), grid_blocks);
}
```

```cpp
#include <hip/hip_runtime.h>
#include <hip/hip_cooperative_groups.h>
#include <cstdint>
#include <cstdio>
namespace cg = cooperative_groups;

typedef unsigned short u16;
typedef short bf16x8 __attribute__((ext_vector_type(8)));
typedef float f32x16 __attribute__((ext_vector_type(16)));
typedef float f32x4 __attribute__((ext_vector_type(4)));
typedef float f32x2 __attribute__((ext_vector_type(2)));
typedef unsigned u32x4 __attribute__((ext_vector_type(4)));
typedef unsigned u32x2 __attribute__((ext_vector_type(2)));
typedef __bf16 bf16v2 __attribute__((ext_vector_type(2)));

constexpr int T = 16384, DM = 1024, SEQ = 4096;
constexpr int HY_IN = 5120, HY_OUT = 2048;
constexpr int MLA_DOWN = 704, MLA_DOWN_PAD = 768, MLA_QR = 384, MLA_KVR = 256;
constexpr int NEXP = 16384;
constexpr float EPS = 1e-6f;
constexpr int NTHREADS = 512;
constexpr int LDS_BYTES = 81920;
constexpr int LDS_TOTAL = 2 * LDS_BYTES;

constexpr size_t al256(size_t x) { return (x + 255) & ~(size_t)255; }
constexpr size_t WS_WINT   = 0;
constexpr size_t WS_WOUTT  = WS_WINT   + (size_t)HY_IN * DM * 2;
constexpr size_t WS_WDOWNT = WS_WOUTT  + (size_t)DM * HY_OUT * 2;
constexpr size_t WS_WQUPT  = WS_WDOWNT + (size_t)MLA_DOWN_PAD * DM * 2;
constexpr size_t WS_WKVUPT = WS_WQUPT  + (size_t)1536 * MLA_QR * 2;
constexpr size_t WS_WMOT   = WS_WKVUPT + (size_t)2048 * MLA_KVR * 2;
constexpr size_t WS_WPQT   = WS_WMOT   + (size_t)DM * DM * 2;
constexpr size_t WS_ROPE_R = WS_WPQT   + (size_t)2 * 2048 * DM * 2;
constexpr size_t WS_ROPE_M = WS_ROPE_R + (size_t)SEQ * 64 * 8;
constexpr size_t WS_UBF    = WS_ROPE_M + (size_t)SEQ * 32 * 8;
constexpr size_t WS_VBF    = WS_UBF    + (size_t)2 * NEXP * DM;
constexpr size_t WS_USC    = WS_VBF    + (size_t)2 * NEXP * DM;
constexpr size_t WS_VSC    = WS_USC    + (size_t)2 * NEXP * 4;
constexpr size_t WS_H      = WS_VSC    + (size_t)2 * NEXP * 4;
constexpr size_t WS_PROJ   = WS_H      + (size_t)T * DM * 2;
constexpr size_t WS_Y      = WS_PROJ   + (size_t)T * HY_IN * 2;
constexpr size_t WS_SSQ    = WS_Y      + (size_t)T * HY_OUT * 2;
constexpr size_t WS_DST    = WS_SSQ    + (size_t)T * 8 * 4;
constexpr size_t WS_EXP    = WS_DST    + (size_t)512 * 256 * 128 * 4;
constexpr size_t WS_GATE   = WS_EXP    + (size_t)T * 128 * 2;
constexpr size_t WS_BAR    = WS_GATE   + (size_t)T * 128 * 4;
constexpr size_t WS_TS     = WS_BAR    + 16384;
constexpr size_t WS_AVT    = WS_TS     + 4096;
constexpr size_t WS_KT     = WS_AVT    + (size_t)T * 1024 * 2;
constexpr size_t WS_VTR    = WS_KT     + (size_t)T * 512 * 2;
constexpr size_t WS_END    = WS_VTR    + (size_t)T * 1024 * 2;
constexpr size_t WS_Q      = WS_PROJ;
constexpr size_t WS_KV     = WS_Q  + (size_t)T * 1536 * 2;
constexpr size_t WS_DOWN   = WS_KV + (size_t)T * 2048 * 2;
constexpr size_t WS_TK = WS_PROJ;
constexpr size_t WS_O      = WS_Y;
constexpr size_t WS_CQN    = WS_O    + (size_t)T * DM * 2;
constexpr size_t WS_CKVN   = WS_CQN  + (size_t)T * MLA_QR * 2;
constexpr size_t WS_KROPE  = WS_CKVN + (size_t)T * MLA_KVR * 2;
static_assert(WS_DOWN + (size_t)T * 768 * 4 <= WS_Y, "overlay");
static_assert(WS_KROPE + (size_t)T * 64 * 2 <= WS_SSQ, "overlay");

struct Params {
    const float *x, *norm_mix, *norm_ffn, *hy_w_in, *gm_v_norm, *gm_w_s, *gm_b_s, *ret_norm, *hy_w_out;
    const float *mla_w_down, *mla_q_norm, *mla_w_q_up, *mla_kv_norm, *mla_w_kv_up, *mla_w_out;
    const float *peer_w_q, *peer_sub_keys, *peer_u, *peer_v, *final_norm;
    float* out;
    unsigned char* ws;
};

extern __shared__ __attribute__((aligned(16))) unsigned char smem_raw[];
__device__ __forceinline__ int vhalf() { return __builtin_amdgcn_readfirstlane((int)(threadIdx.x >> 8)); }
#define smem (smem_raw + vhalf() * LDS_BYTES)

__device__ __forceinline__ unsigned pk2(float lo, float hi) { unsigned r; asm volatile("v_cvt_pk_bf16_f32 %0, %1, %2" : "=v"(r) : "v"(lo), "v"(hi)); return r; }
__device__ __forceinline__ u16 f2bf(float f) { return (u16)(pk2(f, 0.f) & 0xffffu); }
__device__ __forceinline__ float bflo(unsigned u) { return __uint_as_float(u << 16); }
__device__ __forceinline__ float bfhi(unsigned u) { return __uint_as_float(u & 0xffff0000u); }
__device__ __forceinline__ float bf2f(u16 h) { return __uint_as_float((unsigned)h << 16); }
__device__ __forceinline__ u32x4 pack8(const float* v) { u32x4 w; w.x = pk2(v[0], v[1]); w.y = pk2(v[2], v[3]); w.z = pk2(v[4], v[5]); w.w = pk2(v[6], v[7]); return w; }
__device__ __forceinline__ void unpack8(u32x4 w, float* v) { v[0] = bflo(w.x); v[1] = bfhi(w.x); v[2] = bflo(w.y); v[3] = bfhi(w.y); v[4] = bflo(w.z); v[5] = bfhi(w.z); v[6] = bflo(w.w); v[7] = bfhi(w.w); }
__device__ __forceinline__ float gelu_f(float v) {
    const float t = __builtin_amdgcn_rcpf(fabsf(v) * 0.2316418882f + 1.0f);
    float q = t * 0.5307027145f + (-0.7265760135f); q = q * t + 0.7107068705f; q = q * t + (-0.142248368f); q = q * t + 0.127414796f; q = q * t;
    const float m = v * (q * __builtin_amdgcn_exp2f(v * v * (-0.72134752044f)));
    return v < 0.f ? m : v - m;
}
__device__ __forceinline__ float silu_f(float v) { return v * __builtin_amdgcn_rcpf(1.0f + __builtin_amdgcn_exp2f(v * (-1.4426950408889634f))); }
__device__ __forceinline__ float wave_sum(float v) {
#pragma unroll
    for (int o = 32; o >= 1; o >>= 1) v += __shfl_xor(v, o);
    return v;
}

__device__ __forceinline__ int opaque(int v) { asm volatile("" : "+v"(v)); return v; }
__device__ __forceinline__ int opaque_s(int v) { asm volatile("" : "+s"(v)); return v; }

__device__ __forceinline__ int toff(int r, int c8) { return r * 128 + ((c8 ^ ((r >> 1) & 7)) << 4); }
__device__ __forceinline__ int toff_e(int r, int k) { return toff(r, k >> 3) + (k & 7) * 2; }

template <int PT, int QT>
__device__ __forceinline__ void mma_kb(f32x16 (&acc)[PT][QT], int Ps, int prow0, int Qs, int qrow0, int lane) {
    const int lr = lane & 31, hi = lane >> 5;
    bf16x8 a[4][PT], b[4][QT];
#pragma unroll
    for (int s = 0; s < 4; ++s) {
        const int c8 = 2 * s + hi;
#pragma unroll
        for (int i = 0; i < PT; ++i) a[s][i] = *(const bf16x8*)(smem + Ps + toff(prow0 + i * 32 + lr, c8));
#pragma unroll
        for (int j = 0; j < QT; ++j) b[s][j] = *(const bf16x8*)(smem + Qs + toff(qrow0 + j * 32 + lr, c8));
    }
    __builtin_amdgcn_sched_barrier(0);
#pragma unroll
    for (int s = 0; s < 4; ++s)
#pragma unroll
        for (int i = 0; i < PT; ++i)
#pragma unroll
            for (int j = 0; j < QT; ++j) acc[i][j] = __builtin_amdgcn_mfma_f32_32x32x16_bf16(a[s][i], b[s][j], acc[i][j], 0, 0, 0);
#pragma unroll
    for (int i = 0; i < PT; ++i)
#pragma unroll
        for (int j = 0; j < QT; ++j) asm volatile("" : "+v"(acc[i][j]));
}

template <int ROWS>
__device__ __forceinline__ void gload_nat(u32x4 (&r)[ROWS / 32], const u16* src, int ld, int tid) {
    tid = opaque(tid);
#pragma unroll
    for (int i = 0; i < ROWS / 32; ++i) { const int idx = tid + 256 * i, row = idx >> 3, c8 = idx & 7; r[i] = *(const u32x4*)(src + (size_t)row * ld + c8 * 8); }
}
template <int ROWS>
__device__ __forceinline__ void sstore_nat(int lds, const u32x4 (&r)[ROWS / 32], int tid) {
    tid = opaque(tid);
#pragma unroll
    for (int i = 0; i < ROWS / 32; ++i) { const int idx = tid + 256 * i, row = idx >> 3, c8 = idx & 7; *(u32x4*)(smem + lds + toff(row, c8)) = r[i]; }
}
template <int ROWS, bool SCALE>
__device__ __forceinline__ void load_tr(int lds, const u16* src, int ld, int tid, const float* kscale) {
    constexpr int CH = ROWS / 8;
    tid = opaque(tid);
#pragma unroll 2
    for (int i = 0; i < (64 * CH) / 256; ++i) {
        const int idx = tid + 256 * i, k = idx / CH, nc = idx % CH;
        const u32x4 v = *(const u32x4*)(src + (size_t)k * ld + nc * 8);
        const unsigned wd[4] = {v.x, v.y, v.z, v.w};
        float sc = 1.f; if (SCALE) sc = kscale[k];
#pragma unroll
        for (int e = 0; e < 8; ++e) {
            u16 h;
            if (SCALE) h = f2bf(((e & 1) ? bfhi(wd[e >> 1]) : bflo(wd[e >> 1])) * sc);
            else h = (u16)((e & 1) ? (wd[e >> 1] >> 16) : (wd[e >> 1] & 0xffffu));
            *(u16*)(smem + lds + toff_e(nc * 8 + e, k)) = h;
        }
    }
}

constexpr int CS_LD = 132;
__device__ __forceinline__ void stage_c22(const f32x16 (&acc)[2][2], int wm, int wn, int lane) {
    const int lr = lane & 31, hi = lane >> 5;
#pragma unroll
    for (int i = 0; i < 2; ++i)
#pragma unroll
        for (int j = 0; j < 2; ++j)
#pragma unroll
            for (int q = 0; q < 4; ++q) {
                const int n = wm * 64 + i * 32 + 8 * q + 4 * hi, m = wn * 64 + j * 32 + lr;
                f32x4 v = {acc[i][j][4 * q], acc[i][j][4 * q + 1], acc[i][j][4 * q + 2], acc[i][j][4 * q + 3]};
                *(f32x4*)(smem + (m * CS_LD + n) * 4) = v;
            }
}
__device__ __forceinline__ void cs_read8(int m, int c, float* v) {
    const f32x4 a = *(const f32x4*)(smem + (m * CS_LD + c) * 4), b = *(const f32x4*)(smem + (m * CS_LD + c + 4) * 4);
    v[0] = a[0]; v[1] = a[1]; v[2] = a[2]; v[3] = a[3]; v[4] = b[0]; v[5] = b[1]; v[6] = b[2]; v[7] = b[3];
}

__device__ __forceinline__ void cs_store_transposed(u16* dst  , int tid) {
#pragma unroll
    for (int ps = 0; ps < 8; ++ps) {
        const int col = ps * 16 + (tid >> 4), tk8 = (tid & 15) * 8;
        float v[8];
#pragma unroll
        for (int e = 0; e < 8; ++e) v[e] = *(const float*)(smem + ((tk8 + e) * CS_LD + col) * 4);
        *(u32x4*)(dst + (size_t)col * 128 + tk8) = pack8(v);
    }
}
__device__ __forceinline__ void load_nat_colscale(int lds, const u16* src, int ld, int tid, const float* kscale) {
    tid = opaque(tid);
#pragma unroll 2
    for (int i = 0; i < 4; ++i) {
        const int idx = tid + 256 * i, row = idx >> 3, c8 = idx & 7;
        float f[8]; unpack8(*(const u32x4*)(src + (size_t)row * ld + c8 * 8), f);
#pragma unroll
        for (int e = 0; e < 8; ++e) f[e] *= kscale[c8 * 8 + e];
        *(u32x4*)(smem + lds + toff(row, c8)) = pack8(f);
    }
}
__device__ __forceinline__ void glds_tile128(int lds, const u16* src, int ld, int tid) {
    const int lane = tid & 63, w = tid >> 6;
#pragma unroll
    for (int i = 0; i < 4; ++i) {
        const int r0 = (w * 4 + i) * 8, r = r0 + (lane >> 3), c8 = (lane & 7) ^ ((r >> 1) & 7);
        __builtin_amdgcn_global_load_lds((const unsigned*)(src + (size_t)r * ld + c8 * 8), (unsigned*)(smem + lds + r0 * 128), 16, 0, 0);
    }
}

template <class Epi>
__device__ __forceinline__ void gemm_tile(const u16* A, int lda, const u16* Bt, int ldb, int K, int m0, int n0, Epi&& epi) {
    const int tid = opaque((int)threadIdx.x & 255), lane = tid & 63, w = tid >> 6, wm = w >> 1, wn = w & 1;
    f32x16 acc[2][2];
#pragma unroll
    for (int i = 0; i < 2; ++i)
#pragma unroll
        for (int j = 0; j < 2; ++j)
#pragma unroll
            for (int r = 0; r < 16; ++r) acc[i][j][r] = 0.f;
    const u16* Ap = A + (size_t)m0 * lda; const u16* Bp = Bt + (size_t)n0 * ldb;
    glds_tile128(0, Bp, ldb, tid); glds_tile128(16384, Ap, lda, tid);
    const int nk = K >> 6;
    for (int kb = 0; kb < nk; ++kb) {
        const int buf = (kb & 1) * 32768;
        asm volatile("s_waitcnt vmcnt(0)" ::: "memory");
        __syncthreads();
        if (kb + 1 < nk) { glds_tile128(buf ^ 32768, Bp + (kb + 1) * 64, ldb, tid); glds_tile128((buf ^ 32768) + 16384, Ap + (kb + 1) * 64, lda, tid); }
        mma_kb<2, 2>(acc, buf, wm * 64, buf + 16384, wn * 64, lane);
    }
    __syncthreads();
    stage_c22(acc, wm, wn, lane);
    __syncthreads();
    epi(m0, n0);
    __syncthreads();
}

__device__ __forceinline__ int toff32(int r, int c4) { return r * 64 + ((c4 ^ ((r >> 2) & 3)) << 4); }
template <int ROWS>
__device__ __forceinline__ void glds_rows32(int lds, const u16* src, int ld, int tid) {
    const int lane = tid & 63, w = tid >> 6;
#pragma unroll
    for (int i = 0; i < ROWS / 64; ++i) {
        const int r0 = (w * (ROWS / 64) + i) * 16, r = r0 + (lane >> 2), c4 = (lane & 3) ^ ((r >> 2) & 3);
        __builtin_amdgcn_global_load_lds((const unsigned*)(src + (size_t)r * ld + c4 * 8), (unsigned*)(smem + lds + r0 * 64), 16, 0, 0);
    }
}
__device__ __forceinline__ void glds_piece(int st, int piece, const u16* Bp, int ldb, const u16* Ap, int lda, int tid) {
    const int lane = tid & 63, w = tid >> 6;
    const bool isq = piece >= 4;
    const int r0 = isq ? (w * 2 + (piece - 4)) * 16 : (w * 4 + piece) * 16, r = r0 + (lane >> 2), c4 = (lane & 3) ^ ((r >> 2) & 3);
    const u16* src = isq ? Ap + (size_t)r * lda : Bp + (size_t)r * ldb;
    __builtin_amdgcn_global_load_lds((const unsigned*)(src + c4 * 8), (unsigned*)(smem + st + (isq ? 16384 : 0) + r0 * 64), 16, 0, 0);
}
constexpr int G2_STAGE = 24576;
template <int GM = 0, class Epi>
__device__ __forceinline__ void gemm_tile2(const u16* A, int lda, const u16* Bt, int ldb, int K, int m0, int n0, Epi&& epi) {
    const int tid = opaque((int)threadIdx.x & 255), lane = tid & 63, w = tid >> 6, wm = w >> 1, wn = w & 1, lr = lane & 31, hi = lane >> 5;
    f32x16 acc[4][2];
#pragma unroll
    for (int i = 0; i < 4; ++i)
#pragma unroll
        for (int j = 0; j < 2; ++j)
#pragma unroll
            for (int r = 0; r < 16; ++r) acc[i][j][r] = 0.f;
    const u16* Ap = A + (size_t)m0 * lda; const u16* Bp = Bt + (size_t)n0 * ldb;
    const int nk = K >> 5;
    glds_rows32<256>(0, Bp, ldb, tid); glds_rows32<128>(16384, Ap, lda, tid);
    glds_rows32<256>(G2_STAGE, Bp + 32, ldb, tid); glds_rows32<128>(G2_STAGE + 16384, Ap + 32, lda, tid);
    int st = 0, stn = 2 * G2_STAGE;
    for (int kb = 0; kb < nk; ++kb) {
        if (GM != 2 && kb + 1 < nk) asm volatile("s_waitcnt vmcnt(6)" ::: "memory"); else asm volatile("s_waitcnt vmcnt(0)" ::: "memory");
        __builtin_amdgcn_s_barrier();
        const bool refill = (GM != 2) && (kb + 2 < nk);
        bf16x8 a[2][4], b[2][2];
#pragma unroll
        for (int s = 0; s < 2; ++s) {
            const int c4 = 2 * s + hi;
#pragma unroll
            for (int i = 0; i < 4; ++i) a[s][i] = *(const bf16x8*)(smem + st + toff32(wm * 128 + i * 32 + lr, c4));
#pragma unroll
            for (int j = 0; j < 2; ++j) b[s][j] = *(const bf16x8*)(smem + st + 16384 + toff32(wn * 64 + j * 32 + lr, c4));
        }
        __builtin_amdgcn_sched_barrier(0);
#pragma unroll
        for (int s = 0; s < 2; ++s)
#pragma unroll
            for (int i = 0; i < 4; ++i) {
                if (GM == 1) { asm volatile("" :: "v"(a[s][i])); asm volatile("" :: "v"(b[s][0])); asm volatile("" :: "v"(b[s][1])); }
                else {
#pragma unroll
                    for (int j = 0; j < 2; ++j) acc[i][j] = __builtin_amdgcn_mfma_f32_32x32x16_bf16(a[s][i], b[s][j], acc[i][j], 0, 0, 0);
                }
                const int pc = s * 4 + i;
                if (pc < 6) { if (refill) glds_piece(stn, pc, Bp + (kb + 2) * 32, ldb, Ap + (kb + 2) * 32, lda, tid); __builtin_amdgcn_sched_barrier(0); }
            }
#pragma unroll
        for (int i = 0; i < 4; ++i)
#pragma unroll
            for (int j = 0; j < 2; ++j) asm volatile("" : "+v"(acc[i][j]));
        st = (st == 2 * G2_STAGE) ? 0 : st + G2_STAGE; stn = (stn == 2 * G2_STAGE) ? 0 : stn + G2_STAGE;
    }
#pragma unroll 1
    for (int h = 0; h < 2; ++h) {
        __syncthreads();
        if (wm == h) {
#pragma unroll
            for (int i = 0; i < 4; ++i)
#pragma unroll
                for (int j = 0; j < 2; ++j)
#pragma unroll
                    for (int q = 0; q < 4; ++q) {
                        const int n = i * 32 + 8 * q + 4 * hi, m = wn * 64 + j * 32 + lr;
                        f32x4 v = {acc[i][j][4 * q], acc[i][j][4 * q + 1], acc[i][j][4 * q + 2], acc[i][j][4 * q + 3]};
                        *(f32x4*)(smem + (m * CS_LD + n) * 4) = v;
                    }
        }
        __syncthreads();
        if (GM != 3) epi(m0, n0 + h * 128);
    }
    __syncthreads();
}

constexpr int G3_STAGE = 32768;
__device__ __forceinline__ void glds_piece3(int st, int i, const u16* Bp, int ldb, const u16* Ap, int lda, int lane, int w8) {
    const bool isq = i >= 2;
    const int r0 = (w8 * 2 + (i & 1)) * 16, r = r0 + (lane >> 2), c4 = (lane & 3) ^ ((r >> 2) & 3);
    const u16* src = isq ? Ap + (size_t)r * lda : Bp + (size_t)r * ldb;
    __builtin_amdgcn_global_load_lds((const unsigned*)(src + c4 * 8), (unsigned*)(smem_raw + st + (isq ? 16384 : 0) + r0 * 64), 16, 0, 0);
}
namespace pg8 {
#define PG8_LAS __attribute__((address_space(3)))
typedef unsigned short bf16_t;
typedef short bf16x8 __attribute__((ext_vector_type(8)));
typedef float f32x4 __attribute__((ext_vector_type(4)));
typedef unsigned u32x4 __attribute__((ext_vector_type(4)));
constexpr int BM = 256, BK = 64, HALF = 128, HTB = HALF * BK * 2  , STAGE_BYTES = 8 * HTB, NXCD = 8, WGM = 8;

__host__ __device__ __forceinline__ int lds_byte(int r, int c) { const int st = (r >> 4) * 2 + (c >> 5), rr = r & 15, cc = c & 31, ob = rr * 64 + cc * 2; return st * 1024 + (ob ^ (((ob >> 9) & 1) << 5)); }
__host__ __device__ __forceinline__ void stage_rc(int b, int& R, int& C) { const int st = b / 1024, sb = b % 1024, swz = sb ^ (((sb >> 9) & 1) << 5); R = (st >> 1) * 16 + swz / 64; C = (st & 1) * 32 + (swz % 64) / 2; }
__host__ __device__ __forceinline__ int perm32(int rho) { const int n = rho >> 4, i = rho & 15; return 8 * (i >> 2) + 4 * n + (i & 3); }

struct Unit { int pm, pn; };
struct Gemm { const bf16_t* A; const bf16_t* Bt; int M, N, K; };
struct OneUnit {
    __device__ __forceinline__ bool next(int i, Unit& u) const { if (i > 0) return false; u.pm = 0; u.pn = 0; return true; }
    __device__ __forceinline__ void a_ready(const Unit&) const {}
    __device__ __forceinline__ void done(const Unit&) const {}
};
template <class Epi, class Sched, bool ALIGN_EPI = false, bool SP2 = false>
__device__ __forceinline__ void gemm_phase(PG8_LAS unsigned char* lds, const Gemm g, const Sched& S, const Epi& E) {
    const int tid = opaque((int)threadIdx.x), wid = __builtin_amdgcn_readfirstlane(tid >> 6), lane = tid & 63, wr = wid >> 2, wc = wid & 3, fr = lane & 15, fq = lane >> 4;
    const int K = g.K, nt = K / BK;
    unsigned voffA[2], voffB[2];
#pragma unroll
    for (int i = 0; i < 2; ++i) { int R, C; stage_rc(tid * 16 + i * 8192, R, C); const int Rb = Epi::PERM ? ((R & ~31) + perm32(R & 31)) : R;
        voffA[i] = (unsigned)(R * K + C) * 2u; voffB[i] = (unsigned)(Rb * K + C) * 2u; }
    const size_t kstep = (size_t)(BK * 2);
    const size_t hstep = (size_t)HALF * K * 2;
    const size_t tstep = 2 * hstep;
    const unsigned ldsw = (unsigned)wid * 1024u;
    const int aoff = lds_byte(wr * 64 + fr, fq * 8), boff = lds_byte(wc * 32 + fr, fq * 8);
#define PG8_SA(b, h) (((b) * 2 + (h)) * HTB)
#define PG8_SB(b, h) ((4 + (b) * 2 + (h)) * HTB)
#define PG8_STAGE(bufoff, gbase, voff) do { _Pragma("unroll") for (int _i = 0; _i < 2; ++_i) \
        __builtin_amdgcn_global_load_lds((const unsigned*)((const char*)(gbase) + (voff)[_i]), (PG8_LAS unsigned*)(lds + (bufoff) + ldsw + _i * 8192), 16, 0, 0); } while (0)
#define PG8_LDA(dst, b, h) do { _Pragma("unroll") for (int m = 0; m < 4; ++m) _Pragma("unroll") for (int k = 0; k < 2; ++k) dst[m][k] = *(const PG8_LAS bf16x8*)(lds + PG8_SA(b, h) + aoff + m * 2048 + k * 1024); } while (0)
#define PG8_LDB(dst, b, h) do { _Pragma("unroll") for (int n = 0; n < 2; ++n) _Pragma("unroll") for (int k = 0; k < 2; ++k) dst[n][k] = *(const PG8_LAS bf16x8*)(lds + PG8_SB(b, h) + boff + n * 2048 + k * 1024); } while (0)
#define PG8_MMA(ai, bj, At, Bt) do { __builtin_amdgcn_s_setprio(1); _Pragma("unroll") for (int m = 0; m < 4; ++m) _Pragma("unroll") for (int n = 0; n < 2; ++n) _Pragma("unroll") for (int k = 0; k < 2; ++k) \
        acc[ai][bj][m][n] = __builtin_amdgcn_mfma_f32_16x16x32_bf16(Bt[n][k], At[m][k], acc[ai][bj][m][n], 0, 0, 0); __builtin_amdgcn_s_setprio(0); } while (0)
#define PG8_WAIT_V(n) asm volatile("s_waitcnt vmcnt(" #n ")" ::: "memory")
#define PG8_WAIT_L(n) asm volatile("s_waitcnt lgkmcnt(" #n ")" ::: "memory")
#define PG8_BAR __builtin_amdgcn_s_barrier()
#define PG8_SCHED __builtin_amdgcn_sched_barrier(0)
    Unit cur, nxt; int ui = 0;
    if (!S.next(0, cur)) return;
    f32x4 acc[2][2][4][2];
#pragma unroll
    for (int a = 0; a < 2; ++a)
#pragma unroll
        for (int b = 0; b < 2; ++b)
#pragma unroll
            for (int m = 0; m < 4; ++m)
#pragma unroll
                for (int n = 0; n < 2; ++n) acc[a][b][m][n] = (f32x4){0.f, 0.f, 0.f, 0.f};
    bf16x8 At[4][2], B0[2][2], B1[2][2];
    const char* cA = (const char*)g.A + (size_t)cur.pm * tstep; const char* cB = (const char*)g.Bt + (size_t)cur.pn * tstep;
    S.a_ready(cur);
    if constexpr (SP2) {
        PG8_STAGE(PG8_SB(0, 0), cB, voffB); PG8_STAGE(PG8_SB(0, 1), cB + hstep, voffB); PG8_STAGE(PG8_SA(0, 0), cA, voffA); PG8_STAGE(PG8_SA(0, 1), cA + hstep, voffA);
        if (wr == 1) PG8_BAR;
        PG8_WAIT_V(2); PG8_BAR;
        PG8_STAGE(PG8_SB(1, 0), cB + kstep, voffB); PG8_STAGE(PG8_SA(1, 0), cA + kstep, voffA); PG8_STAGE(PG8_SB(1, 1), cB + hstep + kstep, voffB);
        PG8_WAIT_V(6); PG8_BAR;
    } else {
        PG8_STAGE(PG8_SB(0, 0), cB, voffB); PG8_STAGE(PG8_SA(0, 0), cA, voffA); PG8_STAGE(PG8_SB(0, 1), cB + hstep, voffB); PG8_STAGE(PG8_SA(0, 1), cA + hstep, voffA);
        if (wr == 1) PG8_BAR;
        PG8_WAIT_V(4); PG8_BAR;
        PG8_STAGE(PG8_SB(1, 0), cB + kstep, voffB); PG8_STAGE(PG8_SA(1, 0), cA + kstep, voffA); PG8_STAGE(PG8_SB(1, 1), cB + hstep + kstep, voffB);
        PG8_WAIT_V(6); PG8_BAR;
    }
    for (;;) {
        const bool has_next = S.next(ui + 1, nxt);
        const char* nA = has_next ? (const char*)g.A + (size_t)nxt.pm * tstep : cA; const char* nB = has_next ? (const char*)g.Bt + (size_t)nxt.pn * tstep : cB;
        for (int t = 0; t < nt; t += 2) {
            const bool last = (t == nt - 2);
            const char* a1 = cA + (size_t)(t + 1) * kstep;
            const char* a2 = last ? nA : cA + (size_t)(t + 2) * kstep; const char* b2 = last ? nB : cB + (size_t)(t + 2) * kstep;
            const char* a3 = a2 + kstep; const char* b3 = b2 + kstep;
            if (last && has_next) S.a_ready(nxt);
            if constexpr (SP2) {
            PG8_LDB(B0, 0, 0); PG8_LDB(B1, 0, 1); PG8_SCHED; PG8_LDA(At, 0, 0); PG8_STAGE(PG8_SA(1, 1), a1 + hstep, voffA);
            PG8_WAIT_V(8); PG8_WAIT_L(0); PG8_BAR; PG8_MMA(0, 0, At, B0); PG8_MMA(0, 1, At, B1); PG8_BAR; PG8_SCHED;
            PG8_LDA(At, 0, 1); PG8_STAGE(PG8_SB(0, 0), b2, voffB); PG8_STAGE(PG8_SB(0, 1), b2 + hstep, voffB); PG8_STAGE(PG8_SA(0, 0), a2, voffA);
            PG8_WAIT_V(8); PG8_WAIT_L(0); PG8_BAR; PG8_MMA(1, 0, At, B0); PG8_MMA(1, 1, At, B1); PG8_BAR; PG8_SCHED;
            PG8_LDB(B0, 1, 0); PG8_LDB(B1, 1, 1); PG8_SCHED; PG8_LDA(At, 1, 0); PG8_STAGE(PG8_SA(0, 1), a2 + hstep, voffA);
            PG8_WAIT_V(8); PG8_WAIT_L(0); PG8_BAR; PG8_MMA(0, 0, At, B0); PG8_MMA(0, 1, At, B1); PG8_BAR; PG8_SCHED;
            PG8_LDA(At, 1, 1); PG8_STAGE(PG8_SB(1, 0), b3, voffB); PG8_STAGE(PG8_SB(1, 1), b3 + hstep, voffB); PG8_STAGE(PG8_SA(1, 0), a3, voffA);
            PG8_WAIT_V(8); PG8_WAIT_L(0); PG8_BAR; PG8_MMA(1, 0, At, B0); PG8_MMA(1, 1, At, B1); PG8_BAR; PG8_SCHED;
            } else {
            PG8_LDB(B0, 0, 0); PG8_SCHED; PG8_LDA(At, 0, 0); PG8_STAGE(PG8_SA(1, 1), a1 + hstep, voffA);
            PG8_WAIT_L(8); PG8_BAR; PG8_WAIT_L(0); PG8_MMA(0, 0, At, B0); PG8_BAR; PG8_SCHED;
            PG8_LDB(B1, 0, 1); PG8_STAGE(PG8_SB(0, 0), b2, voffB);
            PG8_BAR; PG8_WAIT_L(0); PG8_MMA(0, 1, At, B1); PG8_BAR;
            PG8_LDA(At, 0, 1); PG8_STAGE(PG8_SA(0, 0), a2, voffA);
            PG8_BAR; PG8_WAIT_L(0); PG8_MMA(1, 0, At, B0); PG8_BAR; PG8_SCHED;
            PG8_STAGE(PG8_SB(0, 1), b2 + hstep, voffB);
            PG8_WAIT_V(6); PG8_BAR; PG8_MMA(1, 1, At, B1); PG8_BAR;
            PG8_LDB(B0, 1, 0); PG8_SCHED; PG8_LDA(At, 1, 0); PG8_STAGE(PG8_SA(0, 1), a2 + hstep, voffA);
            PG8_WAIT_L(8); PG8_BAR; PG8_WAIT_L(0); PG8_MMA(0, 0, At, B0); PG8_BAR; PG8_SCHED;
            PG8_LDB(B1, 1, 1); PG8_STAGE(PG8_SB(1, 0), b3, voffB);
            PG8_BAR; PG8_WAIT_L(0); PG8_MMA(0, 1, At, B1); PG8_BAR;
            PG8_LDA(At, 1, 1); PG8_STAGE(PG8_SA(1, 0), a3, voffA);
            PG8_BAR; PG8_WAIT_L(0); PG8_MMA(1, 0, At, B0); PG8_BAR; PG8_SCHED;
            PG8_STAGE(PG8_SB(1, 1), b3 + hstep, voffB);
            PG8_WAIT_V(6); PG8_BAR; PG8_MMA(1, 1, At, B1); PG8_BAR;
            }
        }
        if constexpr (ALIGN_EPI) { if (wr == 0) PG8_BAR; }
        if constexpr (!Epi::AFTER_DRAIN) { E(acc, cur, wr, wc, fr, fq); S.done(cur); }
        if (!has_next) break;
#pragma unroll
        for (int a = 0; a < 2; ++a)
#pragma unroll
            for (int b = 0; b < 2; ++b)
#pragma unroll
                for (int m = 0; m < 4; ++m)
#pragma unroll
                    for (int n = 0; n < 2; ++n) acc[a][b][m][n] = (f32x4){0.f, 0.f, 0.f, 0.f};
        cur = nxt; cA = nA; cB = nB; ++ui;
        if constexpr (ALIGN_EPI) { if (wr == 1) PG8_BAR; }
    }
    PG8_WAIT_V(0);
    if constexpr (!ALIGN_EPI) { if (wr == 0) PG8_BAR; }
    PG8_BAR;
    if constexpr (Epi::AFTER_DRAIN) { E.fused(acc, cur, wr, wc, fr, fq, lds, wid, lane); S.done(cur); }
#undef PG8_SA
#undef PG8_SB
#undef PG8_STAGE
#undef PG8_LDA
#undef PG8_LDB
#undef PG8_MMA
#undef PG8_WAIT_V
#undef PG8_WAIT_L
#undef PG8_BAR
#undef PG8_SCHED
}
}

template <class F> struct EpiStaged {
    static constexpr bool PERM = false, AFTER_DRAIN = true;
    F& f; int m0, n0;
    __device__ __forceinline__ void fused(pg8::f32x4 (&acc)[2][2][4][2], const pg8::Unit&, int wr, int wc, int fr, int fq, PG8_LAS unsigned char*, int, int) const {
        const int vh = vhalf();
#pragma unroll
        for (int bj = 0; bj < 2; ++bj) {
            __syncthreads();
#pragma unroll
            for (int ai = 0; ai < 2; ++ai)
#pragma unroll
                for (int m = 0; m < 4; ++m)
#pragma unroll
                    for (int n = 0; n < 2; ++n) {
                        const int row = 64 * wr + 16 * m + fr, col = 32 * wc + 16 * n + 4 * fq;
                        *(f32x4*)(smem_raw + ai * LDS_BYTES + (row * CS_LD + col) * 4) = acc[ai][bj][m][n];
                    }
            __syncthreads();
            f(m0 + vh * 128, n0 + bj * 128);
        }
        __syncthreads();
    }
};
template <class Epi>
__device__ __forceinline__ void gemm_tile3(const u16* A, int lda, const u16* Bt, int ldb, int K, int m0, int n0, Epi&& epi) {
    const pg8::Gemm g{A + (size_t)m0 * K, Bt + (size_t)n0 * K, 256, 256, K};
    const EpiStaged<Epi> E{epi, m0, n0};
    pg8::gemm_phase<EpiStaged<Epi>, pg8::OneUnit, false, true>((PG8_LAS unsigned char*)smem_raw, g, pg8::OneUnit{}, E);
}
template <int NT>
__device__ __forceinline__ bool tile_map3(int it, int bid, int nb, int& mt, int& nt) {
    constexpr int PN = (NT % 4 == 0) ? 4 : (NT % 3 == 0) ? 3 : (NT % 2 == 0) ? 2 : 1;
    const int x = bid & 7, lb = bid >> 3, nlb = nb >> 3;
    const int j = it * nlb + lb;
    if (j >= 8 * NT) return false;
    const int patch = j / (8 * PN), within = j % (8 * PN);
    mt = x * 8 + (within & 7); nt = patch * PN + (within >> 3);
    return true;
}

template <int NT>
__device__ __forceinline__ bool tile_map(int it, int bid, int nb, int& mt, int& nt) {
    constexpr int PN = (NT % 8 == 0) ? 8 : (NT % 7 == 0) ? 7 : (NT % 6 == 0) ? 6 : (NT % 5 == 0) ? 5 : (NT % 4 == 0) ? 4 : (NT % 3 == 0) ? 3 : (NT % 2 == 0) ? 2 : 1;
    static_assert(NT % PN == 0, "tile_map: NT");
    const int x = bid & 7, lb = bid >> 3, nlb = nb >> 3;
    const int j = it * nlb + lb;
    if (j >= 16 * NT) return false;
    const int patch = j / (8 * PN), within = j % (8 * PN), pm = within & 7, pn = within >> 3;
    mt = x * 16 + (patch & 1) * 8 + pm; nt = (patch >> 1) * PN + pn;
    return true;
}

__device__ __forceinline__ void convT_tile(const float* W, int K, int N, u16* Wt, int kt, int nt, int tid) {
    u16* tile = (u16*)smem;
    __syncthreads();
#pragma unroll
    for (int i = 0; i < 16; ++i) {
        const int k = i * 4 + (tid >> 6), n = tid & 63, gn = nt * 64 + n;
        const float v = (gn < N) ? W[(size_t)(kt * 64 + k) * N + gn] : 0.f;
        tile[n * 72 + k] = f2bf(v);
    }
    __syncthreads();
    const int n = tid >> 2, kc = (tid & 3) * 16;
    const u32x4 a = *(const u32x4*)(tile + n * 72 + kc), b = *(const u32x4*)(tile + n * 72 + kc + 8);
    u16* dst = Wt + (size_t)(nt * 64 + n) * K + kt * 64 + kc;
    *(u32x4*)dst = a; *(u32x4*)(dst + 8) = b;
}
__device__ __forceinline__ void convT_all(const float* W, int K, int N, int Npad, u16* Wt, int bid, int nb, int tid) {
    const int nkt = K / 64, nnt = Npad / 64;
    for (int j = bid; j < nkt * nnt; j += nb) convT_tile(W, K, N, Wt, j % nkt, j / nkt, tid);
}
__device__ __forceinline__ void rmsnorm_rows(const float* X, const float* g, u16* H, int bid, int nb, int tid) {
    const int lane = tid & 63, w = tid >> 6;
    for (int row = bid * 4 + w; row < T; row += nb * 4) {
        const float* xr = X + (size_t)row * DM;
        f32x4 v[4]; float ss = 0.f;
#pragma unroll
        for (int c = 0; c < 4; ++c) { v[c] = *(const f32x4*)(xr + c * 256 + lane * 4); ss += v[c][0] * v[c][0] + v[c][1] * v[c][1] + v[c][2] * v[c][2] + v[c][3] * v[c][3]; }
        ss = wave_sum(ss);
        const float r = rsqrtf(ss * (1.0f / DM) + EPS);
#pragma unroll
        for (int c = 0; c < 4; ++c) {
            const f32x4 gg = *(const f32x4*)(g + c * 256 + lane * 4);
            u32x2 o; o.x = pk2(v[c][0] * r * gg[0], v[c][1] * r * gg[1]); o.y = pk2(v[c][2] * r * gg[2], v[c][3] * r * gg[3]);
            *(u32x2*)(H + (size_t)row * DM + c * 256 + lane * 4) = o;
        }
    }
}
__device__ __forceinline__ void convert_table_rows(const Params& p, int r0, int r1, int tid) {
    unsigned char* ws = p.ws;
    const int lane = tid & 63, w = tid >> 6;
    for (int row = r0 + w; row < r1; row += 4) {
        const int tb = row >= 2 * NEXP, rr = row - tb * 2 * NEXP;
        const float* srcp = (tb ? p.peer_v : p.peer_u) + (size_t)rr * DM + lane * 16;
        f32x4 v[4]; float am = 0.f;
#pragma unroll
        for (int c = 0; c < 4; ++c) { v[c] = *(const f32x4*)(srcp + c * 4); am = fmaxf(am, fmaxf(fmaxf(fabsf(v[c][0]), fabsf(v[c][1])), fmaxf(fabsf(v[c][2]), fabsf(v[c][3])))); }
#pragma unroll
        for (int o = 32; o >= 1; o >>= 1) am = fmaxf(am, __shfl_xor(am, o));
        am = fmaxf(am, 1e-30f);
        if (tb == 0) {
            const float sc = 384.0f / am;
            u32x4 o4;
#pragma unroll
            for (int c = 0; c < 4; ++c) {
                int pk = __builtin_amdgcn_cvt_pk_fp8_f32(v[c][0] * sc, v[c][1] * sc, 0, false);
                pk = __builtin_amdgcn_cvt_pk_fp8_f32(v[c][2] * sc, v[c][3] * sc, pk, true);
                o4[c] = (unsigned)pk;
            }
            *(u32x4*)(ws + WS_UBF + (size_t)rr * DM + lane * 16) = o4;
            if (lane == 0) ((float*)(ws + WS_USC))[rr] = am * (1.0f / 384.0f);
        } else {
            const float sc = 6.0f / am;
            unsigned p0 = 0u, p1 = 0u;
            p0 = __builtin_amdgcn_cvt_scalef32_pk_fp4_f32(p0, v[0][0] * sc, v[0][1] * sc, 1.0f, 0); p0 = __builtin_amdgcn_cvt_scalef32_pk_fp4_f32(p0, v[0][2] * sc, v[0][3] * sc, 1.0f, 1);
            p0 = __builtin_amdgcn_cvt_scalef32_pk_fp4_f32(p0, v[1][0] * sc, v[1][1] * sc, 1.0f, 2); p0 = __builtin_amdgcn_cvt_scalef32_pk_fp4_f32(p0, v[1][2] * sc, v[1][3] * sc, 1.0f, 3);
            p1 = __builtin_amdgcn_cvt_scalef32_pk_fp4_f32(p1, v[2][0] * sc, v[2][1] * sc, 1.0f, 0); p1 = __builtin_amdgcn_cvt_scalef32_pk_fp4_f32(p1, v[2][2] * sc, v[2][3] * sc, 1.0f, 1);
            p1 = __builtin_amdgcn_cvt_scalef32_pk_fp4_f32(p1, v[3][0] * sc, v[3][1] * sc, 1.0f, 2); p1 = __builtin_amdgcn_cvt_scalef32_pk_fp4_f32(p1, v[3][2] * sc, v[3][3] * sc, 1.0f, 3);
            *(u32x2*)(ws + WS_VBF + (size_t)rr * (DM / 2) + lane * 8) = (u32x2){p0, p1};
            if (lane == 0) ((float*)(ws + WS_VSC))[rr] = am * (1.0f / 6.0f);
        }
    }
}

__device__ __forceinline__ void phase_prep(const Params& p, int bid, int nb) {
    const int tid = opaque((int)threadIdx.x & 255);
    unsigned char* ws = p.ws;
    {
        constexpr int J0 = (DM / 64) * (HY_IN / 64), J1 = J0 + (HY_OUT / 64) * (DM / 64), J2 = J1 + (DM / 64) * (MLA_DOWN_PAD / 64), J3 = J2 + (MLA_QR / 64) * (1536 / 64),
                      J4 = J3 + (MLA_KVR / 64) * (2048 / 64), J5 = J4 + (DM / 64) * (DM / 64);
        for (int j = bid; j < J5; j += nb) {
            if (j < J0) convT_tile(p.hy_w_in, DM, HY_IN, (u16*)(ws + WS_WINT), j % (DM / 64), j / (DM / 64), tid);
            else if (j < J1) { const int q = j - J0; convT_tile(p.hy_w_out, HY_OUT, DM, (u16*)(ws + WS_WOUTT), q % (HY_OUT / 64), q / (HY_OUT / 64), tid); }
            else if (j < J2) { const int q = j - J1; convT_tile(p.mla_w_down, DM, MLA_DOWN, (u16*)(ws + WS_WDOWNT), q % (DM / 64), q / (DM / 64), tid); }
            else if (j < J3) { const int q = j - J2; convT_tile(p.mla_w_q_up, MLA_QR, 1536, (u16*)(ws + WS_WQUPT), q % (MLA_QR / 64), q / (MLA_QR / 64), tid); }
            else if (j < J4) { const int q = j - J3; convT_tile(p.mla_w_kv_up, MLA_KVR, 2048, (u16*)(ws + WS_WKVUPT), q % (MLA_KVR / 64), q / (MLA_KVR / 64), tid); }
            else { const int q = j - J4; convT_tile(p.mla_w_out, DM, DM, (u16*)(ws + WS_WMOT), q % (DM / 64), q / (DM / 64), tid); }
        }
    }
    __syncthreads();
    {
        float* Wq_s = (float*)smem; float* key_s = (float*)(smem + 64 * 129 * 4);
        for (int j = bid; j < 2 * 16 * 16 * 2; j += nb) {
            const int kh = j & 1, kt = (j >> 1) & 15, hp = (j >> 5) & 15, L = j >> 9;
            const float* Wq = p.peer_w_q + (size_t)L * DM * 2048 + (size_t)(kt * 64) * 2048 + hp * 128;
            const float* ky = p.peer_sub_keys + (size_t)L * 2 * 128 * 128 + (size_t)(hp & 1) * 128 * 128 + (size_t)(kh * 64) * 128;
            __syncthreads();
#pragma unroll 4
            for (int i = 0; i < 32; ++i) { const int idx = tid + 256 * i, row = idx >> 7, d = idx & 127; Wq_s[row * 129 + d] = Wq[(size_t)row * 2048 + d]; key_s[row * 129 + d] = ky[row * 128 + d]; }
            __syncthreads();
            const int tk = tid & 15, tkey = tid >> 4;
            float acc[4][4];
#pragma unroll
            for (int a = 0; a < 4; ++a)
#pragma unroll
                for (int b = 0; b < 4; ++b) acc[a][b] = 0.f;
            for (int d = 0; d < 128; ++d) {
                float wv[4], kv[4];
#pragma unroll
                for (int a = 0; a < 4; ++a) { wv[a] = Wq_s[(tk * 4 + a) * 129 + d]; kv[a] = key_s[(tkey * 4 + a) * 129 + d]; }
#pragma unroll
                for (int a = 0; a < 4; ++a)
#pragma unroll
                    for (int b = 0; b < 4; ++b) acc[a][b] += kv[a] * wv[b];
            }
            u16* dst = (u16*)(ws + WS_WPQT) + (size_t)L * 2048 * DM;
#pragma unroll
            for (int a = 0; a < 4; ++a) {
                u32x2 o; o.x = pk2(acc[a][0], acc[a][1]); o.y = pk2(acc[a][2], acc[a][3]);
                *(u32x2*)(dst + (size_t)(hp * 128 + kh * 64 + tkey * 4 + a) * DM + kt * 64 + tk * 4) = o;
            }
        }
    }
    { const int rpb = (4 * NEXP + nb - 1) / nb; convert_table_rows(p, bid * rpb, min((bid + 1) * rpb, 4 * NEXP), tid); }
    {
        f32x2* rr = (f32x2*)(ws + WS_ROPE_R); f32x2* rm = (f32x2*)(ws + WS_ROPE_M);
        for (int i = bid * 256 + tid; i < SEQ * 64; i += nb * 256) {
            const int s = i >> 6, d = i & 63; const float inv = 1.0f / powf(10000.0f, (float)d / 64.0f); const float ang = (float)s * inv;
            float sn, cs; sincosf(ang, &sn, &cs); rr[i] = (f32x2){cs, sn};
        }
        for (int i = bid * 256 + tid; i < SEQ * 32; i += nb * 256) {
            const int s = i >> 5, d = i & 31; const float inv = 1.0f / powf(10000.0f, (float)d / 32.0f); const float ang = (float)s * inv;
            float sn, cs; sincosf(ang, &sn, &cs); rm[i] = (f32x2){cs, sn};
        }
    }
    rmsnorm_rows(p.x, p.norm_mix, (u16*)(ws + WS_H), bid, nb, tid);
}

template <int GM = 0>
__device__ __forceinline__ void phase_inproj(const Params& p, int rbid, int rnb) {
    const int bid = rbid * 2 + vhalf(), nb = rnb * 2;
    unsigned char* ws = p.ws;
    const u16* A = (const u16*)(ws + WS_H); const u16* Bt = (const u16*)(ws + WS_WINT);
    u16* proj = (u16*)(ws + WS_PROJ); float* ssq = (float*)(ws + WS_SSQ); const f32x2* rope = (const f32x2*)(ws + WS_ROPE_R);
    const int tid = opaque((int)threadIdx.x & 255);
    constexpr int NT = HY_IN / 256;
    for (int it = 0;; ++it) {
        int mt, nt; if (!tile_map3<NT>(it, rbid, rnb, mt, nt)) break;
        gemm_tile3(A, DM, Bt, DM, DM, mt * 256, nt * 256, [&](int m0, int n0) {
            const int tid = opaque((int)threadIdx.x & 255);
            const int chunk = m0 >> 7;
            if (n0 >= 2048 && n0 < 3072) {
                const bool isk = n0 >= 2560;
                const float sc = isk ? 0.08838834764831845f : 1.0f;
#pragma unroll
                for (int ps = 0; ps < 4; ++ps) {
                    const int m = ps * 32 + (tid >> 3), c = (tid & 7) * 8;
                    float x1[8], x2[8], y1[8], y2[8]; cs_read8(m, c, x1); cs_read8(m, c + 64, x2);
                    const f32x2* rp = rope + (size_t)((m0 + m) & (SEQ - 1)) * 64 + c;
#pragma unroll
                    for (int e = 0; e < 8; ++e) { const f32x2 cssn = rp[e]; y1[e] = (x1[e] * cssn[0] - x2[e] * cssn[1]) * sc; y2[e] = (x1[e] * cssn[1] + x2[e] * cssn[0]) * sc; }
                    u16* dst = proj + (size_t)(m0 + m) * HY_IN + n0 + c;
                    *(u32x4*)dst = pack8(y1); *(u32x4*)(dst + 64) = pack8(y2);
                    if (isk) {
                        *(f32x4*)(smem + (m * CS_LD + c) * 4) = (f32x4){y1[0], y1[1], y1[2], y1[3]}; *(f32x4*)(smem + (m * CS_LD + c + 4) * 4) = (f32x4){y1[4], y1[5], y1[6], y1[7]};
                        *(f32x4*)(smem + (m * CS_LD + c + 64) * 4) = (f32x4){y2[0], y2[1], y2[2], y2[3]}; *(f32x4*)(smem + (m * CS_LD + c + 68) * 4) = (f32x4){y2[4], y2[5], y2[6], y2[7]};
                    }
                }
                if (isk) { __syncthreads(); cs_store_transposed((u16*)(ws + WS_KT) + ((size_t)chunk * 512 + (n0 - 2560)) * 128, tid); }
            } else if (n0 >= 3072 && n0 < 4096) {
                cs_store_transposed((u16*)(ws + WS_VTR) + ((size_t)chunk * 1024 + (n0 - 3072)) * 128, tid);
            } else if (n0 >= 1024 && n0 < 2048) {
#pragma unroll
                for (int ps = 0; ps < 8; ++ps) {
                    const int m = ps * 16 + (tid >> 4), c = (tid & 15) * 8;
                    float v[8]; cs_read8(m, c, v);
                    float s = 0.f;
#pragma unroll
                    for (int e = 0; e < 8; ++e) { v[e] = gelu_f(v[e]); s += v[e] * v[e]; }
                    s += __shfl_xor(s, 1); s += __shfl_xor(s, 2); s += __shfl_xor(s, 4); s += __shfl_xor(s, 8);
                    if ((tid & 15) == 0) ssq[(size_t)(m0 + m) * 8 + ((n0 - 1024) >> 7)] = s;
                    *(f32x4*)(smem + (m * CS_LD + c) * 4) = (f32x4){v[0], v[1], v[2], v[3]}; *(f32x4*)(smem + (m * CS_LD + c + 4) * 4) = (f32x4){v[4], v[5], v[6], v[7]};
                }
                __syncthreads();
                cs_store_transposed((u16*)(ws + WS_AVT) + ((size_t)chunk * 1024 + (n0 - 1024)) * 128, tid);
            } else {
                const bool is_gate = n0 >= 4096;
#pragma unroll
                for (int ps = 0; ps < 8; ++ps) {
                    const int m = ps * 16 + (tid >> 4), c = (tid & 15) * 8;
                    float v[8]; cs_read8(m, c, v);
#pragma unroll
                    for (int e = 0; e < 8; ++e) v[e] = is_gate ? silu_f(v[e]) : gelu_f(v[e]);
                    *(u32x4*)(proj + (size_t)(m0 + m) * HY_IN + n0 + c) = pack8(v);
                }
            }
        });
    }
}

__device__ __forceinline__ float ret_log2gamma(int h) { return log2f(1.0f - exp2f(-5.0f - (float)h)); }
constexpr int YS_LD = 264;
__device__ __forceinline__ void zero4(f32x16 (&acc)[4][1]) {
#pragma unroll
    for (int i = 0; i < 4; ++i)
#pragma unroll
        for (int r = 0; r < 16; ++r) acc[i][0][r] = 0.f;
}

__device__ __forceinline__ void gmlp_task(const Params& p, int ci, int g, int dh) {
    unsigned char* ws = p.ws;
    const int tid = opaque((int)threadIdx.x & 255), lane = tid & 63, w = tid >> 6, lr = lane & 31, hi = lane >> 5;
    const int m0 = ci * 128, col0 = g * 256 + dh * 128;
    const u16* proj = (const u16*)(ws + WS_PROJ); const float* ssq = (const float*)(ws + WS_SSQ);
    float* r_s = (float*)(smem + 49152);
    __syncthreads();
    if (tid < 128) { const float s = ssq[(size_t)(m0 + tid) * 8 + 2 * g] + ssq[(size_t)(m0 + tid) * 8 + 2 * g + 1]; r_s[tid] = rsqrtf(s * (1.0f / 256.0f) + EPS); }
    f32x16 acc[4][1]; zero4(acc);
    const float* Wg = p.gm_w_s + (size_t)g * 128 * 128;
    for (int kb = 0; kb < 2; ++kb) {
        __syncthreads();
        { u32x4 rr[4]; gload_nat<128>(rr, (const u16*)(ws + WS_AVT) + ((size_t)ci * 1024 + col0) * 128 + kb * 64, 128, tid); sstore_nat<128>(0, rr, tid); }
#pragma unroll 2
        for (int i = 0; i < 8; ++i) {
            const int idx = tid + 256 * i, t = idx >> 4, c4 = idx & 15, s0 = kb * 64 + c4 * 4;
            const f32x4 wv = *(const f32x4*)(Wg + t * 128 + s0);
            float o[4];
#pragma unroll
            for (int e = 0; e < 4; ++e) o[e] = (s0 + e <= t) ? wv[e] * r_s[s0 + e] : 0.f;
            u32x2 pk; pk.x = pk2(o[0], o[1]); pk.y = pk2(o[2], o[3]);
            *(u32x2*)(smem + 16384 + toff_e(t, c4 * 4)) = pk;
        }
        __syncthreads();
        mma_kb<4, 1>(acc, 0, 0, 16384, w * 32, lane);
    }
    __syncthreads();
    const int t = w * 32 + lr;
    const float bs = p.gm_b_s[g * 128 + t];
    u16* Ys = (u16*)smem;
#pragma unroll
    for (int i = 0; i < 4; ++i)
#pragma unroll
        for (int q = 0; q < 4; ++q) {
            const int d = i * 32 + 8 * q + 4 * hi;
            const f32x4 gn = *(const f32x4*)(p.gm_v_norm + col0 + d);
            u32x2 pk; pk.x = pk2(acc[i][0][4 * q] * gn[0] + bs, acc[i][0][4 * q + 1] * gn[1] + bs); pk.y = pk2(acc[i][0][4 * q + 2] * gn[2] + bs, acc[i][0][4 * q + 3] * gn[3] + bs);
            *(u32x2*)(Ys + t * YS_LD + d) = pk;
        }
    __syncthreads();
    u16* y = (u16*)(ws + WS_Y);
#pragma unroll
    for (int ps = 0; ps < 8; ++ps) {
        const int tt = ps * 16 + (tid >> 4), c = (tid & 15) * 8;
        float mv[8], uv[8]; unpack8(*(const u32x4*)(Ys + tt * YS_LD + c), mv); unpack8(*(const u32x4*)(proj + (size_t)(m0 + tt) * HY_IN + col0 + c), uv);
#pragma unroll
        for (int e = 0; e < 8; ++e) mv[e] *= uv[e];
        *(u32x4*)(y + (size_t)(m0 + tt) * HY_OUT + col0 + c) = pack8(mv);
    }
}

__device__ __forceinline__ void ret_ds_task(const Params& p, int ci, int h, int eh) {
    unsigned char* ws = p.ws;
    const int tid = opaque((int)threadIdx.x & 255), lane = tid & 63, w = tid >> 6, lr = lane & 31, hi = lane >> 5;
    const int m0 = ci * 128;
    const u16* proj = (const u16*)(ws + WS_PROJ);
    float* kd_s = (float*)(smem + 49152);
    const float l2g = ret_log2gamma(h);
    __syncthreads();
    if (tid < 128) kd_s[tid] = exp2f((float)(127 - tid) * l2g);
    f32x16 acc[4][1]; zero4(acc);
    for (int kb = 0; kb < 2; ++kb) {
        __syncthreads();
        { u32x4 rr[4]; gload_nat<128>(rr, (const u16*)(ws + WS_KT) + ((size_t)ci * 512 + h * 128) * 128 + kb * 64, 128, tid); sstore_nat<128>(0, rr, tid); }
        load_nat_colscale(16384, (const u16*)(ws + WS_VTR) + ((size_t)ci * 1024 + h * 256 + eh * 128) * 128 + kb * 64, 128, tid, kd_s + kb * 64);
        __syncthreads();
        mma_kb<4, 1>(acc, 0, 0, 16384, w * 32, lane);
    }
    float* dst = (float*)(ws + WS_DST) + (size_t)(ci * 4 + h) * 256 * 128;
#pragma unroll
    for (int i = 0; i < 4; ++i)
#pragma unroll
        for (int q = 0; q < 4; ++q) {
            const int d = i * 32 + 8 * q + 4 * hi, e = eh * 128 + w * 32 + lr;
            f32x4 v = {acc[i][0][4 * q], acc[i][0][4 * q + 1], acc[i][0][4 * q + 2], acc[i][0][4 * q + 3]};
            *(f32x4*)(dst + (size_t)e * 128 + d) = v;
        }
}

__device__ __forceinline__ void phase_mixA(const Params& p, int bid, int nb) {
    for (int t = bid; t < 2048; t += nb) {
        const int ci = t >> 4, sub = (t + ((t / nb) << 3)) & 15;
        if (sub < 8) gmlp_task(p, ci, sub >> 1, sub & 1); else ret_ds_task(p, ci, (sub - 8) >> 1, sub & 1);
    }
}

__device__ __forceinline__ void phase_scan(const Params& p, int bid, int nb) {
    float* base = (float*)(p.ws + WS_DST);
    for (int i = bid * 256 + opaque((int)threadIdx.x & 255); i < 4 * 4 * 256 * 128 / 4; i += nb * 256) {
        const int b = i >> 15, h = (i >> 13) & 3, rest = i & 8191;
        const float cd = exp2f(128.0f * ret_log2gamma(h));
        f32x4 s = {0.f, 0.f, 0.f, 0.f};
        float* ptr = base + ((size_t)(b * 32) * 4 + h) * 32768 + (size_t)rest * 4;
#pragma unroll 8
        for (int n = 0; n < 32; ++n) {
            f32x4* q = (f32x4*)(ptr + (size_t)n * 4 * 32768);
            const f32x4 tmp = *q; *q = s; s = s * cd + tmp;
        }
    }
}

__device__ __forceinline__ void ret_out_task(const Params& p, int ci, int h) {
    unsigned char* ws = p.ws;
    const int tid = opaque((int)threadIdx.x & 255), lane = tid & 63, w = tid >> 6, lr = lane & 31, hi = lane >> 5;
    const int m0 = ci * 128;
    const u16* proj = (const u16*)(ws + WS_PROJ);
    const float l2g = ret_log2gamma(h);
    const int qi = w * 32 + lr;
    constexpr int RA = 0, RB = 16384, RC = 49152;
    __syncthreads();
    {
        u32x4 r0[4], r1[4];
        const u16* qp = proj + (size_t)m0 * HY_IN + 2048 + h * 128; const u16* kp = proj + (size_t)m0 * HY_IN + 2560 + h * 128;
        gload_nat<128>(r0, qp, HY_IN, tid); gload_nat<128>(r1, qp + 64, HY_IN, tid);
        sstore_nat<128>(RC, r0, tid); sstore_nat<128>(RC + 16384, r1, tid);
        gload_nat<128>(r0, kp, HY_IN, tid); gload_nat<128>(r1, kp + 64, HY_IN, tid);
        sstore_nat<128>(RB, r0, tid); sstore_nat<128>(RB + 16384, r1, tid);
    }
    __syncthreads();
    {
        f32x16 sc[4][1]; zero4(sc);
        mma_kb<4, 1>(sc, RB, 0, RC, w * 32, lane);
        mma_kb<4, 1>(sc, RB + 16384, 0, RC + 16384, w * 32, lane);
        __syncthreads();
#pragma unroll
        for (int i = 0; i < 4; ++i)
#pragma unroll
            for (int q = 0; q < 4; ++q) {
                const int j = i * 32 + 8 * q + 4 * hi;
                float o[4];
#pragma unroll
                for (int e = 0; e < 4; ++e) { const int df = qi - (j + e); o[e] = (df >= 0) ? sc[i][0][4 * q + e] * exp2f((float)df * l2g) : 0.f; }
                u32x2 pk; pk.x = pk2(o[0], o[1]); pk.y = pk2(o[2], o[3]);
                *(u32x2*)(smem + RB + (j >> 6) * 16384 + toff_e(qi, j & 63)) = pk;
            }
#pragma unroll 2
        for (int i = 0; i < 8; ++i) {
            const int idx = tid + 256 * i, row = idx >> 4, c16 = idx & 15;
            unsigned char* ptr = smem + RC + (c16 >> 3) * 16384 + toff(row, c16 & 7);
            float f[8]; unpack8(*(const u32x4*)ptr, f);
            const float qd = exp2f((float)(row + 1) * l2g);
#pragma unroll
            for (int e = 0; e < 8; ++e) f[e] *= qd;
            *(u32x4*)ptr = pack8(f);
        }
    }
    const float* st = (const float*)(ws + WS_DST) + (size_t)(ci * 4 + h) * 256 * 128;
    float ssq = 0.f;
    u16* ytmp = (u16*)(ws + WS_Y) + (size_t)(m0 + qi) * HY_OUT + 1024 + h * 256;
    f32x16 acc[4][1];
#pragma unroll
    for (int eh = 0; eh < 2; ++eh) {
        zero4(acc);
        for (int kb = 0; kb < 4; ++kb) {
            __syncthreads();
            if (kb < 2) {
                { u32x4 rr[4]; gload_nat<128>(rr, (const u16*)(ws + WS_VTR) + ((size_t)ci * 1024 + h * 256 + eh * 128) * 128 + kb * 64, 128, tid); sstore_nat<128>(RA, rr, tid); }
            } else {
                const int d0 = (kb - 2) * 64, tq = opaque(tid);
#pragma unroll 2
                for (int i = 0; i < 8; ++i) {
                    const int idx = tq + 256 * i, row = idx >> 4, c4 = idx & 15;
                    const f32x4 v = *(const f32x4*)(st + (size_t)(eh * 128 + row) * 128 + d0 + c4 * 4);
                    u32x2 pk; pk.x = pk2(v[0], v[1]); pk.y = pk2(v[2], v[3]);
                    *(u32x2*)(smem + RA + toff_e(row, c4 * 4)) = pk;
                }
            }
            __syncthreads();
            mma_kb<4, 1>(acc, RA, 0, (kb < 2) ? (RB + kb * 16384) : (RC + (kb - 2) * 16384), w * 32, lane);
        }
#pragma unroll
        for (int i = 0; i < 4; ++i)
#pragma unroll
            for (int r = 0; r < 16; ++r) ssq += acc[i][0][r] * acc[i][0][r];
        if (eh == 0) {
#pragma unroll
            for (int i = 0; i < 4; ++i)
#pragma unroll
                for (int q = 0; q < 4; ++q) {
                    u32x2 pk; pk.x = pk2(acc[i][0][4 * q], acc[i][0][4 * q + 1]); pk.y = pk2(acc[i][0][4 * q + 2], acc[i][0][4 * q + 3]);
                    *(u32x2*)(ytmp + i * 32 + 8 * q + 4 * hi) = pk;
                }
        }
    }
    ssq += __shfl_xor(ssq, 32);
    const float rn = rsqrtf(ssq * (1.0f / 256.0f) + EPS);
    __syncthreads();
    u16* Ys = (u16*)smem;
#pragma unroll
    for (int i = 0; i < 4; ++i)
#pragma unroll
        for (int q = 0; q < 4; ++q) {
            const int e = i * 32 + 8 * q + 4 * hi;
            const f32x4 g0 = *(const f32x4*)(p.ret_norm + h * 256 + e), g1 = *(const f32x4*)(p.ret_norm + h * 256 + 128 + e);
            u32x2 pk; const u32x2 z = *(const u32x2*)(ytmp + e);
            pk.x = pk2(bflo(z.x) * rn * g0[0], bfhi(z.x) * rn * g0[1]); pk.y = pk2(bflo(z.y) * rn * g0[2], bfhi(z.y) * rn * g0[3]);
            *(u32x2*)(Ys + qi * YS_LD + e) = pk;
            pk.x = pk2(acc[i][0][4 * q] * rn * g1[0], acc[i][0][4 * q + 1] * rn * g1[1]); pk.y = pk2(acc[i][0][4 * q + 2] * rn * g1[2], acc[i][0][4 * q + 3] * rn * g1[3]);
            *(u32x2*)(Ys + qi * YS_LD + 128 + e) = pk;
        }
    __syncthreads();
    u16* y = (u16*)(ws + WS_Y);
#pragma unroll 4
    for (int ps = 0; ps < 16; ++ps) {
        const int tt = ps * 8 + (tid >> 5), c = (tid & 31) * 8;
        float mv[8], gv[8]; unpack8(*(const u32x4*)(Ys + tt * YS_LD + c), mv); unpack8(*(const u32x4*)(proj + (size_t)(m0 + tt) * HY_IN + 4096 + h * 256 + c), gv);
#pragma unroll
        for (int e = 0; e < 8; ++e) mv[e] *= gv[e];
        *(u32x4*)(y + (size_t)(m0 + tt) * HY_OUT + 1024 + h * 256 + c) = pack8(mv);
    }
}
__device__ __forceinline__ void phase_mixB(const Params& p, int bid, int nb) {
    for (int t = bid; t < 512; t += nb) ret_out_task(p, t >> 2, t & 3);
}

__device__ __forceinline__ void phase_gemm_residual(const Params& p, const u16* A, int lda, const u16* Bt, int K, const float* xsrc, float* xdst, const float* g, u16* hb, float* ssq2, int bid, int nb) {
    constexpr int NT = DM / 256;
    for (int it = 0;; ++it) {
        int mt, nt; if (!tile_map3<NT>(it, bid, nb, mt, nt)) break;
        gemm_tile3(A, lda, Bt, K, K, mt * 256, nt * 256, [&](int m0, int n0) {
            const int tid = opaque((int)threadIdx.x & 255);
#pragma unroll
            for (int ps = 0; ps < 8; ++ps) {
                const int m = ps * 16 + (tid >> 4), c = (tid & 15) * 8;
                float v[8]; cs_read8(m, c, v);
                const size_t o = (size_t)(m0 + m) * DM + n0 + c;
                const f32x4 a = *(const f32x4*)(xsrc + o), b = *(const f32x4*)(xsrc + o + 4);
                v[0] += a[0]; v[1] += a[1]; v[2] += a[2]; v[3] += a[3]; v[4] += b[0]; v[5] += b[1]; v[6] += b[2]; v[7] += b[3];
                *(f32x4*)(xdst + o) = (f32x4){v[0], v[1], v[2], v[3]}; *(f32x4*)(xdst + o + 4) = (f32x4){v[4], v[5], v[6], v[7]};
                float s = 0.f;
#pragma unroll
                for (int e = 0; e < 8; ++e) s += v[e] * v[e];
                s += __shfl_xor(s, 1); s += __shfl_xor(s, 2); s += __shfl_xor(s, 4); s += __shfl_xor(s, 8);
                if ((tid & 15) == 0) ssq2[(size_t)(m0 + m) * 8 + (n0 >> 7)] = s;
                const f32x4 ga = *(const f32x4*)(g + n0 + c), gb = *(const f32x4*)(g + n0 + c + 4);
                v[0] *= ga[0]; v[1] *= ga[1]; v[2] *= ga[2]; v[3] *= ga[3]; v[4] *= gb[0]; v[5] *= gb[1]; v[6] *= gb[2]; v[7] *= gb[3];
                *(u32x4*)(hb + o) = pack8(v);
            }
        });
    }
}
template <int K, int N>
__device__ __forceinline__ void phase_gemm_f32(const u16* A, const u16* Bt, float* C, int bid, int nb) {
    const int tid = opaque((int)threadIdx.x & 255);
    constexpr int NT = N / 256, lda = K, ldc = N;
    for (int it = 0;; ++it) {
        int mt, nt; if (!tile_map3<NT>(it, bid, nb, mt, nt)) break;
        gemm_tile3(A, lda, Bt, K, K, mt * 256, nt * 256, [&](int m0, int n0) {
            const int tid = opaque((int)threadIdx.x & 255);
#pragma unroll
            for (int ps = 0; ps < 8; ++ps) {
                const int m = ps * 16 + (tid >> 4), c = (tid & 15) * 8;
                float v[8]; cs_read8(m, c, v);
                const size_t o = (size_t)(m0 + m) * ldc + n0 + c;
                f32x4 ra = {v[0], v[1], v[2], v[3]}, rb = {v[4], v[5], v[6], v[7]};
                *(f32x4*)(C + o) = ra; *(f32x4*)(C + o + 4) = rb;
            }
        });
    }
}

__device__ __forceinline__ void ce_desc(float& a, float& b) { const float hi = fmaxf(a, b), lo = fminf(a, b); a = hi; b = lo; }
__device__ __forceinline__ void sort16_desc(float (&v)[16]) {
#pragma unroll
    for (int k = 2; k <= 16; k <<= 1)
#pragma unroll
        for (int j = k >> 1; j > 0; j >>= 1)
#pragma unroll
            for (int i = 0; i < 16; ++i) { const int l = i ^ j; if (l > i) { if ((i & k) == 0) ce_desc(v[i], v[l]); else ce_desc(v[l], v[i]); } }
}
__device__ __forceinline__ void merge16_desc(float (&A)[16], const float (&B)[16]) {
#pragma unroll
    for (int i = 0; i < 16; ++i) A[i] = fmaxf(A[i], B[15 - i]);
#pragma unroll
    for (int j = 8; j > 0; j >>= 1)
#pragma unroll
        for (int i = 0; i < 16; ++i) { const int l = i ^ j; if (l > i) ce_desc(A[i], A[l]); }
}
__device__ __forceinline__ void ins16(float (&L)[16], float e) {
#pragma unroll
    for (int i = 0; i < 16; ++i) { const float hi = fmaxf(L[i], e); e = fminf(L[i], e); L[i] = hi; }
}
__device__ __forceinline__ float row_rscale(const float* ssq2, int t) {
    const f32x4 a = *(const f32x4*)(ssq2 + (size_t)t * 8), b = *(const f32x4*)(ssq2 + (size_t)t * 8 + 4);
    return rsqrtf(((a[0] + a[1]) + (a[2] + a[3]) + (b[0] + b[1]) + (b[2] + b[3])) * (1.0f / DM) + EPS);
}
constexpr int TKA_OFF = 67584;
__device__ __forceinline__ void phase_scores_top16(const Params& p, int L, int bid, int nb) {
    const u16* A = (const u16*)(p.ws + WS_H); const u16* Bt = (const u16*)(p.ws + WS_WPQT) + (size_t)L * 2048 * DM;
    u16* experts = (u16*)(p.ws + WS_EXP); float* gates = (float*)(p.ws + WS_GATE);
    constexpr int NT = 2048 / 256;
    for (int it = 0;; ++it) {
        int mt, nt; if (!tile_map3<NT>(it, bid, nb, mt, nt)) break;
        gemm_tile3(A, DM, Bt, DM, DM, mt * 256, nt * 256, [&](int m0, int n0) {
            const int tid = opaque((int)threadIdx.x & 255);
            const int m = tid >> 1, half = tid & 1;
            float Lst[16];
#pragma unroll
            for (int g = 0; g < 4; ++g) {
                float v[16];
#pragma unroll
                for (int c = 0; c < 4; ++c) {
                    const f32x4 x = *(const f32x4*)(smem + (m * CS_LD + half * 64 + g * 16 + c * 4) * 4);
#pragma unroll
                    for (int e = 0; e < 4; ++e) v[c * 4 + e] = __uint_as_float((__float_as_uint(x[e]) & ~127u) | (unsigned)(half * 64 + g * 16 + c * 4 + e));
                }
                sort16_desc(v);
                if (g == 0) {
#pragma unroll
                    for (int i = 0; i < 16; ++i) Lst[i] = v[i];
                } else merge16_desc(Lst, v);
            }
            float P[16];
#pragma unroll
            for (int i = 0; i < 16; ++i) P[i] = __shfl_xor(Lst[i], 1);
            merge16_desc(Lst, P);
            float* la = (float*)(smem + TKA_OFF);
            if (((n0 >> 7) & 1) == 0) {
                if (half == 0) {
#pragma unroll
                    for (int i = 0; i < 16; ++i) la[i * 128 + m] = Lst[i];
                }
            } else {
                __syncthreads();
                float* lb = (float*)smem;
                if (half == 0) {
#pragma unroll
                    for (int i = 0; i < 16; ++i) lb[i * 128 + m] = Lst[i];
                }
                __syncthreads();
                if (tid < 128) {
                    const int tkn = tid;
                    float a[16];
#pragma unroll
                    for (int i = 0; i < 16; ++i) a[i] = la[i * 128 + tkn];
                    float bq[16];
#pragma unroll
                    for (int i = 0; i < 16; ++i) bq[i] = lb[i * 128 + tkn];
                    float c[16];
#pragma unroll
                    for (int i = 0; i < 16; ++i) c[i] = -INFINITY;
#pragma unroll
                    for (int i = 0; i < 16; ++i)
#pragma unroll
                        for (int j = 0; j < 16; ++j)
                            if ((i + 1) * (j + 1) <= 16) {
                                const float s = __uint_as_float(__float_as_uint(a[i]) & ~127u) + __uint_as_float(__float_as_uint(bq[j]) & ~127u);
                                ins16(c, __uint_as_float((__float_as_uint(s) & ~255u) | (unsigned)(i * 16 + j)));
                            }
                    const int t = m0 + tkn, th = t * 8 + (n0 >> 8);
                    const float rs = row_rscale((const float*)(p.ws + WS_SSQ), t);
                    float bs[16]; unsigned ex[16]; float mx = -INFINITY;
#pragma unroll
                    for (int k = 0; k < 16; ++k) {
                        const unsigned code = __float_as_uint(c[k]) & 255u;
                        const unsigned av = __float_as_uint(la[(code >> 4) * 128 + tkn]), bv = __float_as_uint(lb[(code & 15) * 128 + tkn]);
                        bs[k] = (__uint_as_float(av & ~127u) + __uint_as_float(bv & ~127u)) * rs;
                        ex[k] = (av & 127u) * 128u + (bv & 127u);
                        mx = fmaxf(mx, bs[k]);
                    }
                    float sum = 0.f;
#pragma unroll
                    for (int k = 0; k < 16; ++k) { bs[k] = __expf(bs[k] - mx); sum += bs[k]; }
                    const float inv = 1.0f / sum;
                    u32x4 e0, e1;
                    e0.x = ex[0] | (ex[1] << 16); e0.y = ex[2] | (ex[3] << 16); e0.z = ex[4] | (ex[5] << 16); e0.w = ex[6] | (ex[7] << 16);
                    e1.x = ex[8] | (ex[9] << 16); e1.y = ex[10] | (ex[11] << 16); e1.z = ex[12] | (ex[13] << 16); e1.w = ex[14] | (ex[15] << 16);
                    *(u32x4*)(experts + (size_t)th * 16) = e0; *(u32x4*)(experts + (size_t)th * 16 + 8) = e1;
#pragma unroll
                    for (int k4 = 0; k4 < 4; ++k4) { f32x4 g = {bs[4 * k4] * inv, bs[4 * k4 + 1] * inv, bs[4 * k4 + 2] * inv, bs[4 * k4 + 3] * inv}; *(f32x4*)(gates + (size_t)th * 16 + k4 * 4) = g; }
                }
            }
        });
    }
}

__device__ __forceinline__ void fp4x16_to_f32(const u32x2 r, float* f) {
#define FP4_PAIR(D, B) { const f32x2 pr = __builtin_amdgcn_cvt_scalef32_pk_f32_fp4(r[D], 1.0f, B); f[((D) * 4 + (B)) * 2] = pr[0]; f[((D) * 4 + (B)) * 2 + 1] = pr[1]; }
    FP4_PAIR(0, 0) FP4_PAIR(0, 1) FP4_PAIR(0, 2) FP4_PAIR(0, 3) FP4_PAIR(1, 0) FP4_PAIR(1, 1) FP4_PAIR(1, 2) FP4_PAIR(1, 3)
#undef FP4_PAIR
}
__device__ __forceinline__ float folded_sum8(const float (&d)[8], int lane) {
    float d4[4], d2[2], d1;
#pragma unroll
    for (int k = 0; k < 4; ++k) { const bool up = (lane & 32) != 0; const float keep = up ? d[k + 4] : d[k], send = up ? d[k] : d[k + 4]; d4[k] = keep + __shfl_xor(send, 32); }
#pragma unroll
    for (int k = 0; k < 2; ++k) { const bool up = (lane & 16) != 0; const float keep = up ? d4[k + 2] : d4[k], send = up ? d4[k] : d4[k + 2]; d2[k] = keep + __shfl_xor(send, 16); }
    { const bool up = (lane & 8) != 0; const float keep = up ? d2[1] : d2[0], send = up ? d2[0] : d2[1]; d1 = keep + __shfl_xor(send, 8); }
    d1 += __shfl_xor(d1, 4); d1 += __shfl_xor(d1, 2); d1 += __shfl_xor(d1, 1);
    return d1;
}
__device__ __forceinline__ void fp8x16_to_f32(const u32x4 r, float* f) {
#pragma unroll
    for (int c = 0; c < 4; ++c) {
        const f32x2 lo = __builtin_amdgcn_cvt_pk_f32_fp8((int)r[c], false), hi = __builtin_amdgcn_cvt_pk_f32_fp8((int)r[c], true);
        f[4 * c] = lo[0]; f[4 * c + 1] = lo[1]; f[4 * c + 2] = hi[0]; f[4 * c + 3] = hi[1];
    }
}
__device__ __forceinline__ void sort128(unsigned& k_lo, unsigned& k_hi, int lane) {
#pragma unroll
    for (int k = 2; k <= 128; k <<= 1)
#pragma unroll
        for (int j = k >> 1; j > 0; j >>= 1) {
            if (j == 64) { const unsigned lo = min(k_lo, k_hi), hi2 = max(k_lo, k_hi); k_lo = lo; k_hi = hi2; }
            else {
                const unsigned o_lo = __shfl_xor(k_lo, j), o_hi = __shfl_xor(k_hi, j);
                const bool upper = (lane & j) != 0;
                const bool asc_lo = (k == 128) ? true : ((lane & k) == 0), asc_hi = (k == 128) ? true : (((lane + 64) & k) == 0);
                k_lo = (upper != asc_lo) ? min(k_lo, o_lo) : max(k_lo, o_lo);
                k_hi = (upper != asc_hi) ? min(k_hi, o_hi) : max(k_hi, o_hi);
            }
        }
}
#ifndef PEER_DUP_MODE
#define PEER_DUP_MODE 2
#endif
#ifndef PEER_EXMASK
#define PEER_EXMASK 0xffffffffu
#endif
#ifndef PEER_SKIP_U
#define PEER_SKIP_U 0
#endif
#ifndef PEER_SKIP_V
#define PEER_SKIP_V 0
#endif
#ifndef PEER_UB
#define PEER_UB 16
#endif
typedef __bf16 bf16x2_t __attribute__((ext_vector_type(2)));
typedef _Float16 f16x2_t __attribute__((ext_vector_type(2)));
template <int MODE>
__device__ __forceinline__ void phase_peer(const Params& p, int L, const float* gnext, int bid, int nb) {
    const int tid = opaque((int)threadIdx.x & 255), lane = tid & 63, w = tid >> 6;
    const u16* H = (const u16*)(p.ws + WS_H);
    const unsigned char* U = p.ws + WS_UBF + (size_t)L * NEXP * DM; const unsigned char* V = p.ws + WS_VBF + (size_t)L * NEXP * (DM / 2);
    const float* Usc = (const float*)(p.ws + WS_USC) + (size_t)L * NEXP; const float* Vsc = (const float*)(p.ws + WS_VSC) + (size_t)L * NEXP;
    const u16* experts = (const u16*)(p.ws + WS_EXP); const float* gates = (const float*)(p.ws + WS_GATE);
    const int srcl = (((lane & 7) >> 2) & 1) * 32 + (((lane & 7) >> 1) & 1) * 16 + (lane & 1) * 8;
    constexpr int TP = 4;
    for (int tb = (bid * 4 + w) * TP; tb < T; tb += nb * 4 * TP) {
        unsigned k_lo[TP], k_hi[TP]; float w_lo[TP], w_hi[TP], wmax[TP];
#pragma unroll
        for (int tk = 0; tk < TP; ++tk) {
            const int t = tb + tk;
            k_lo[tk] = ((unsigned)experts[(size_t)t * 128 + lane] << 7) | (unsigned)lane; k_hi[tk] = ((unsigned)experts[(size_t)t * 128 + 64 + lane] << 7) | (unsigned)(64 + lane);
            sort128(k_lo[tk], k_hi[tk], opaque(lane));
            w_lo[tk] = 0.f; w_hi[tk] = 0.f;
            __builtin_amdgcn_sched_barrier(0);
        }
#pragma unroll 1
        for (int eb = 0; eb < ((MODE >= 2 && PEER_SKIP_U) ? 0 : 128); eb += 16) {
#pragma unroll
            for (int tk = 0; tk < TP; ++tk) {
                u32x4 ru[16];
#pragma unroll
                for (int k = 0; k < 16; ++k) {
                    const int e = eb + k;
                    const unsigned ex = (__builtin_amdgcn_readlane((e < 64) ? k_lo[tk] : k_hi[tk], e & 63) >> 7) & ((MODE >= 2) ? PEER_EXMASK : 0xffffffffu);
                    if (MODE == 4) { ru[k] = (u32x4){ex, ex ^ 0x3a3a3a3au, k_lo[tk], k_hi[tk]}; asm volatile("" : "+v"(ru[k])); } else
                    ru[k] = *(const u32x4*)(U + (size_t)ex * DM + lane * 16);
                }
                u32x4 xq0, xq1;
                { const u16* hp = H + (size_t)(tb + tk) * DM + lane * 16; xq0 = *(const u32x4*)hp; xq1 = *(const u32x4*)(hp + 8); }
                float dA[8], dB[8];
#pragma unroll
                for (int k = 0; k < 16; ++k) {
                    asm volatile("" : "+v"(ru[k]));
                    float s = 0.f;
                    if (MODE == 3) { s = __uint_as_float(ru[k][0] ^ ru[k][1] ^ ru[k][2] ^ ru[k][3]); } else {
#pragma unroll
                    for (int c = 0; c < 4; ++c) {
                        const unsigned xa = (c < 2) ? xq0[2 * c] : xq1[2 * c - 4], xb = (c < 2) ? xq0[2 * c + 1] : xq1[2 * c - 3];
                        s = __builtin_amdgcn_fdot2_f32_bf16(__builtin_amdgcn_cvt_scalef32_pk_bf16_fp8(ru[k][c], 1.0f, false), __builtin_bit_cast(bf16x2_t, xa), s, false);
                        s = __builtin_amdgcn_fdot2_f32_bf16(__builtin_amdgcn_cvt_scalef32_pk_bf16_fp8(ru[k][c], 1.0f, true), __builtin_bit_cast(bf16x2_t, xb), s, false);
                    }
                    }
                    asm volatile("" : "+v"(s));
                    if (k < 8) dA[k] = s; else dB[k - 8] = s;
                }
                const float sA = folded_sum8(dA, lane), sB = folded_sum8(dB, lane);
                const float vA = __shfl(sA, srcl), vB = __shfl(sB, srcl);
                const int j = (lane & 63) - (eb & 63);
                const float val = ((j & 8) != 0) ? vB : vA;
                if (j >= 0 && j < 16) { if (eb < 64) w_lo[tk] = val; else w_hi[tk] = val; }
                __builtin_amdgcn_sched_barrier(0);
            }
        }
#pragma unroll
        for (int tk = 0; tk < TP; ++tk) {
            const int t = tb + tk;
            const float rs = row_rscale((const float*)(p.ws + WS_SSQ), t);
            const unsigned e0 = k_lo[tk] >> 7, e1 = k_hi[tk] >> 7;
            w_lo[tk] = gelu_f(w_lo[tk] * rs * Usc[e0]) * gates[(size_t)t * 128 + (k_lo[tk] & 127u)] * Vsc[e0];
            w_hi[tk] = gelu_f(w_hi[tk] * rs * Usc[e1]) * gates[(size_t)t * 128 + (k_hi[tk] & 127u)] * Vsc[e1];
            float wm = fmaxf(fabsf(w_lo[tk]), fabsf(w_hi[tk]));
#pragma unroll
            for (int o2 = 32; o2 >= 1; o2 >>= 1) wm = fmaxf(wm, __shfl_xor(wm, o2));
            wm = fmaxf(wm, 1e-30f); wmax[tk] = wm;
            const float winv = 1.0f / wm;
            { const f16x2_t a = {(_Float16)(w_lo[tk] * winv), (_Float16)(w_lo[tk] * winv)}, b = {(_Float16)(w_hi[tk] * winv), (_Float16)(w_hi[tk] * winv)}; w_lo[tk] = __uint_as_float(__builtin_bit_cast(unsigned, a)); w_hi[tk] = __uint_as_float(__builtin_bit_cast(unsigned, b)); }
        }
        f16x2_t o16[TP][8];
#pragma unroll
        for (int tk = 0; tk < TP; ++tk)
#pragma unroll
            for (int i = 0; i < 8; ++i) o16[tk][i] = (f16x2_t){(_Float16)0.f, (_Float16)0.f};
#pragma unroll 1
        for (int eb = 0; eb < ((MODE >= 2 && PEER_SKIP_V) ? 0 : 128); eb += 32) {
#pragma unroll
            for (int tk = 0; tk < TP; ++tk) {
                u32x2 rv[32]; unsigned wk[32];
#pragma unroll
                for (int k = 0; k < 32; ++k) {
                    const int e = eb + k;
                    const unsigned ex = (__builtin_amdgcn_readlane((e < 64) ? k_lo[tk] : k_hi[tk], e & 63) >> 7) & ((MODE >= 2) ? PEER_EXMASK : 0xffffffffu);
                    wk[k] = __builtin_amdgcn_readlane(__float_as_uint((e < 64) ? w_lo[tk] : w_hi[tk]), e & 63);
                    if (MODE == 4) { rv[k] = (u32x2){ex ^ k_lo[tk], ex ^ 0x3a3a3a3au}; asm volatile("" : "+v"(rv[k])); } else
                    rv[k] = *(const u32x2*)(V + (size_t)ex * (DM / 2) + lane * 8);
                }
#pragma unroll
                for (int k = 0; k < 32; ++k) {
                    asm volatile("" : "+v"(rv[k]));
                    {
                        const f16x2_t w2 = __builtin_bit_cast(f16x2_t, wk[k]);
#define FP4_ACC(D, B) o16[tk][(D) * 4 + (B)] = __builtin_elementwise_fma(__builtin_bit_cast(f16x2_t, __builtin_amdgcn_cvt_scalef32_pk_f16_fp4(rv[k][D], 1.0f, B)), w2, o16[tk][(D) * 4 + (B)]);
                        FP4_ACC(0, 0) FP4_ACC(0, 1) FP4_ACC(0, 2) FP4_ACC(0, 3) FP4_ACC(1, 0) FP4_ACC(1, 1) FP4_ACC(1, 2) FP4_ACC(1, 3)
#undef FP4_ACC
                    }
                    asm volatile("" : "+v"(o16[tk][0]), "+v"(o16[tk][1]), "+v"(o16[tk][2]), "+v"(o16[tk][3]), "+v"(o16[tk][4]), "+v"(o16[tk][5]), "+v"(o16[tk][6]), "+v"(o16[tk][7]));
                }
            }
        }
#pragma unroll
        for (int tk = 0; tk < TP; ++tk) {
            const int t = tb + tk;
            float o[TP][16];
#pragma unroll
            for (int i = 0; i < 8; ++i) { o[tk][2 * i] = (float)o16[tk][i][0] * wmax[tk]; o[tk][2 * i + 1] = (float)o16[tk][i][1] * wmax[tk]; }
            float* xr = ((MODE >= 2) ? (float*)(p.ws + WS_PROJ) : p.out) + (size_t)t * DM + lane * 16;
            if (MODE >= 2) {
#pragma unroll
                for (int c = 0; c < 4; ++c) *(f32x4*)(xr + 4 * c) = (f32x4){o[tk][4 * c], o[tk][4 * c + 1], o[tk][4 * c + 2], o[tk][4 * c + 3]};
                continue;
            }
            float xv[16];
#pragma unroll
            for (int c = 0; c < 4; ++c) { const f32x4 a = *(const f32x4*)(xr + 4 * c); xv[4 * c] = a[0]; xv[4 * c + 1] = a[1]; xv[4 * c + 2] = a[2]; xv[4 * c + 3] = a[3]; }
            float ss = 0.f;
#pragma unroll
            for (int i = 0; i < 16; ++i) { xv[i] += o[tk][i]; ss += xv[i] * xv[i]; }
            ss = wave_sum(ss);
            const float rn = rsqrtf(ss * (1.0f / DM) + EPS);
            float gv[16];
#pragma unroll
            for (int c = 0; c < 4; ++c) { const f32x4 a = *(const f32x4*)(gnext + lane * 16 + 4 * c); gv[4 * c] = a[0]; gv[4 * c + 1] = a[1]; gv[4 * c + 2] = a[2]; gv[4 * c + 3] = a[3]; }
            if (MODE == 0) {
#pragma unroll
                for (int c = 0; c < 4; ++c) *(f32x4*)(xr + 4 * c) = (f32x4){xv[4 * c], xv[4 * c + 1], xv[4 * c + 2], xv[4 * c + 3]};
                float hv[16];
#pragma unroll
                for (int i = 0; i < 16; ++i) hv[i] = xv[i] * rn * gv[i];
                u16* hp = (u16*)(p.ws + WS_H) + (size_t)t * DM + lane * 16;
                *(u32x4*)hp = pack8(hv); *(u32x4*)(hp + 8) = pack8(hv + 8);
            } else {
#pragma unroll
                for (int c = 0; c < 4; ++c) *(f32x4*)(xr + 4 * c) = (f32x4){xv[4 * c] * rn * gv[4 * c], xv[4 * c + 1] * rn * gv[4 * c + 1], xv[4 * c + 2] * rn * gv[4 * c + 2], xv[4 * c + 3] * rn * gv[4 * c + 3]};
            }
        }
    }
}

__device__ __forceinline__ void phase_mla_norm(const Params& p, int bid, int nb) {
    const int tid = opaque((int)threadIdx.x & 255), lane = tid & 63, w = tid >> 6;
    const float* down = (const float*)(p.ws + WS_DOWN);
    u16* cqn = (u16*)(p.ws + WS_CQN); u16* ckvn = (u16*)(p.ws + WS_CKVN); u16* kr = (u16*)(p.ws + WS_KROPE);
    const f32x2* rope = (const f32x2*)(p.ws + WS_ROPE_M);
    for (int t = bid * 4 + w; t < T; t += nb * 4) {
        const float* dr = down + (size_t)t * MLA_DOWN_PAD;
        float q[6], kv[4];
#pragma unroll
        for (int i = 0; i < 6; ++i) q[i] = dr[i * 64 + lane];
#pragma unroll
        for (int i = 0; i < 4; ++i) kv[i] = dr[384 + i * 64 + lane];
        const float rp = dr[640 + lane];
        float sq = 0.f, sk = 0.f;
#pragma unroll
        for (int i = 0; i < 6; ++i) sq += q[i] * q[i];
#pragma unroll
        for (int i = 0; i < 4; ++i) sk += kv[i] * kv[i];
        sq = wave_sum(sq); sk = wave_sum(sk);
        const float rq = rsqrtf(sq * (1.0f / MLA_QR) + EPS), rk = rsqrtf(sk * (1.0f / MLA_KVR) + EPS);
#pragma unroll
        for (int i = 0; i < 6; ++i) cqn[(size_t)t * MLA_QR + i * 64 + lane] = f2bf(q[i] * rq * p.mla_q_norm[i * 64 + lane]);
#pragma unroll
        for (int i = 0; i < 4; ++i) ckvn[(size_t)t * MLA_KVR + i * 64 + lane] = f2bf(kv[i] * rk * p.mla_kv_norm[i * 64 + lane]);
        const float other = __shfl_xor(rp, 32);
        const f32x2 cssn = rope[(size_t)(t & (SEQ - 1)) * 32 + (lane & 31)];
        const float res = (lane < 32) ? (rp * cssn[0] - other * cssn[1]) : (other * cssn[1] + rp * cssn[0]);
        kr[(size_t)t * 64 + lane] = f2bf(res);
    }
}

__device__ __forceinline__ void phase_mla_up(const Params& p, int bid, int nb) {
    unsigned char* ws = p.ws;
    const f32x2* rope = (const f32x2*)(ws + WS_ROPE_M);
    u16* qo = (u16*)(ws + WS_Q); u16* kvo = (u16*)(ws + WS_KV);
    constexpr int NTQ = 1536 / 256, NTKV = 2048 / 256, NTT = NTQ + NTKV;
    for (int it = 0;; ++it) {
        int mt, nt; if (!tile_map3<NTT>(it, bid, nb, mt, nt)) break;
        const bool isq = nt < NTQ;
        const u16* A = (const u16*)(ws + (isq ? WS_CQN : WS_CKVN)); const u16* Bt = (const u16*)(ws + (isq ? WS_WQUPT : WS_WKVUPT));
        const int K = isq ? MLA_QR : MLA_KVR, ntl = isq ? nt : nt - NTQ;
        gemm_tile3(A, K, Bt, K, K, mt * 256, ntl * 256, [&](int m0, int n0) {
            const int tid = opaque((int)threadIdx.x & 255);
            if (isq) {
#pragma unroll
                for (int ps = 0; ps < 8; ++ps) {
                    const int m = ps * 16 + (tid >> 4), c = (tid & 15) * 8;
                    const int within = (n0 + c) % 192;
                    u16* dst = qo + (size_t)(m0 + m) * 1536 + n0 + c;
                    if (within < 128) { float v[8]; cs_read8(m, c, v); *(u32x4*)dst = pack8(v); }
                    else if (within < 160) {
                        float x1[8], x2[8], y1[8], y2[8]; cs_read8(m, c, x1); cs_read8(m, c + 32, x2);
                        const f32x2* rp = rope + (size_t)((m0 + m) & (SEQ - 1)) * 32 + (within - 128);
#pragma unroll
                        for (int e = 0; e < 8; ++e) { const f32x2 cssn = rp[e]; y1[e] = x1[e] * cssn[0] - x2[e] * cssn[1]; y2[e] = x1[e] * cssn[1] + x2[e] * cssn[0]; }
                        *(u32x4*)dst = pack8(y1); *(u32x4*)(dst + 32) = pack8(y2);
                    }
                }
            } else {
                const int head = n0 >> 8;
                if (((n0 >> 7) & 1) == 0) {
#pragma unroll
                    for (int ps = 0; ps < 8; ++ps) {
                        const int m = ps * 16 + (tid >> 4), c = (tid & 15) * 8;
                        float v[8]; cs_read8(m, c, v);
                        *(u32x4*)(kvo + (size_t)(m0 + m) * 1024 + head * 128 + c) = pack8(v);
                    }
                } else {
                    u16* vT = kvo + (size_t)T * 1024 + ((size_t)((m0 >> 12) * 8 + head) * 128) * SEQ + (m0 & (SEQ - 1));
#pragma unroll
                    for (int ps = 0; ps < 8; ++ps) {
                        const int dv = ps * 16 + (tid >> 4), tk8 = (tid & 15) * 8;
                        float v[8];
#pragma unroll
                        for (int e = 0; e < 8; ++e) v[e] = *(const float*)(smem + ((tk8 + e) * CS_LD + dv) * 4);
                        *(u32x4*)(vT + (size_t)dv * SEQ + tk8) = pack8(v);
                    }
                }
            }
        });
    }
}

__device__ __forceinline__ int crow(int r, int hi) { return (r & 3) + 8 * (r >> 2) + 4 * hi; }
template <int ROWS, bool PERM>
__device__ __forceinline__ void glds_rows(int lds, const u16* src, size_t ld, int tid) {
    const int lane = tid & 63, w = tid >> 6;
#pragma unroll
    for (int i = 0; i < ROWS / 32; ++i) {
        const int r0 = (w * (ROWS / 32) + i) * 8, r = r0 + (lane >> 3), c8 = (lane & 7) ^ ((r >> 1) & 7);
        const int sr = PERM ? ((r & ~12) | ((r & 4) << 1) | ((r & 8) >> 1)) : r;
        __builtin_amdgcn_global_load_lds((const unsigned*)(src + (size_t)sr * ld + c8 * 8), (unsigned*)(smem + lds + r0 * 128), 16, 0, 0);
    }
}
constexpr int ATT_STAGE = 40960;
__device__ __forceinline__ void attn_task(const Params& p, int b, int h, int qb) {
    unsigned char* ws = p.ws;
    const int tid = opaque((int)threadIdx.x & 255), lane = tid & 63, w = tid >> 6, lr = lane & 31, hi = lane >> 5;
    const u16* Q = (const u16*)(ws + WS_Q); const u16* KN = (const u16*)(ws + WS_KV); const u16* KR = (const u16*)(ws + WS_KROPE);
    const u16* VT = KN + (size_t)T * 1024 + (size_t)((b * 8 + h) * 128) * SEQ;
    const int t0 = b * SEQ, q0 = qb * 128, qrow = q0 + w * 32 + lr;
    const int ntiles = (q0 + 128) >> 6;
    __syncthreads();
    bf16x8 qf[12];
#pragma unroll
    for (int s = 0; s < 12; ++s) qf[s] = *(const bf16x8*)(Q + (size_t)(t0 + qrow) * 1536 + h * 192 + s * 16 + hi * 8);
    auto fill = [&](int jt, int st) {
        const int j0 = jt * 64;
        glds_rows<64, true>(st, KN + (size_t)(t0 + j0) * 1024 + h * 128, 1024, tid);
        glds_rows<64, true>(st + 8192, KN + (size_t)(t0 + j0) * 1024 + h * 128 + 64, 1024, tid);
        glds_rows<64, true>(st + 16384, KR + (size_t)(t0 + j0) * 64, 64, tid);
        glds_rows<128, false>(st + 24576, VT + j0, SEQ, tid);
    };
    fill(0, 0);
    f32x16 o[4];
#pragma unroll
    for (int i = 0; i < 4; ++i)
#pragma unroll
        for (int r = 0; r < 16; ++r) o[i][r] = 0.f;
    float m = -1e30f, l = 0.f;
    const float c2 = 0.07216878364870322f * 1.4426950408889634f;
    for (int jt = 0; jt < ntiles; ++jt) {
        const int j0 = jt * 64, st = (jt & 1) * ATT_STAGE;
        asm volatile("s_waitcnt vmcnt(0)" ::: "memory");
        __syncthreads();
        if (jt + 1 < ntiles) fill(jt + 1, st ^ ATT_STAGE);
        f32x16 s0, s1;
#pragma unroll
        for (int r = 0; r < 16; ++r) { s0[r] = 0.f; s1[r] = 0.f; }
#pragma unroll
        for (int kbk = 0; kbk < 3; ++kbk) {
            bf16x8 a0[4], a1[4];
#pragma unroll
            for (int s = 0; s < 4; ++s) { const int c8 = 2 * s + hi; a0[s] = *(const bf16x8*)(smem + st + kbk * 8192 + toff(lr, c8)); a1[s] = *(const bf16x8*)(smem + st + kbk * 8192 + toff(32 + lr, c8)); }
            __builtin_amdgcn_sched_barrier(0);
#pragma unroll
            for (int s = 0; s < 4; ++s) {
                s0 = __builtin_amdgcn_mfma_f32_32x32x16_bf16(a0[s], qf[kbk * 4 + s], s0, 0, 0, 0);
                s1 = __builtin_amdgcn_mfma_f32_32x32x16_bf16(a1[s], qf[kbk * 4 + s], s1, 0, 0, 0);
            }
            __builtin_amdgcn_sched_barrier(0);
        }
        if (j0 + 63 > q0 + w * 32) {
#pragma unroll
            for (int r = 0; r < 16; ++r) {
                const int ko = 16 * (r >> 3) + 8 * hi + 4 * ((r >> 2) & 1) + (r & 3);
                if (j0 + ko > qrow) s0[r] = -INFINITY;
                if (j0 + 32 + ko > qrow) s1[r] = -INFINITY;
            }
        }
        float mx = s0[0];
#pragma unroll
        for (int r = 1; r < 16; ++r) mx = fmaxf(mx, s0[r]);
#pragma unroll
        for (int r = 0; r < 16; ++r) mx = fmaxf(mx, s1[r]);
        mx = fmaxf(mx, __shfl_xor(mx, 32));
        const float mn = fmaxf(m, mx), alpha = __builtin_amdgcn_exp2f((m - mn) * c2), nmc = -mn * c2;
        m = mn;
        float rs = 0.f;
#pragma unroll
        for (int r = 0; r < 16; ++r) { s0[r] = __builtin_amdgcn_exp2f(fmaf(s0[r], c2, nmc)); s1[r] = __builtin_amdgcn_exp2f(fmaf(s1[r], c2, nmc)); rs += s0[r] + s1[r]; }
        l = l * alpha + rs;
#pragma unroll
        for (int i = 0; i < 4; ++i)
#pragma unroll
            for (int r = 0; r < 16; ++r) o[i][r] *= alpha;
        bf16x8 pf[4];
#pragma unroll
        for (int ks = 0; ks < 4; ++ks) {
            u32x4 wv; const int bs = 8 * (ks & 1);
            if (ks < 2) { wv.x = pk2(s0[bs], s0[bs + 1]); wv.y = pk2(s0[bs + 2], s0[bs + 3]); wv.z = pk2(s0[bs + 4], s0[bs + 5]); wv.w = pk2(s0[bs + 6], s0[bs + 7]); }
            else { wv.x = pk2(s1[bs], s1[bs + 1]); wv.y = pk2(s1[bs + 2], s1[bs + 3]); wv.z = pk2(s1[bs + 4], s1[bs + 5]); wv.w = pk2(s1[bs + 6], s1[bs + 7]); }
            pf[ks] = __builtin_bit_cast(bf16x8, wv);
        }
#pragma unroll
        for (int kh = 0; kh < 2; ++kh) {
            bf16x8 av[2][4];
#pragma unroll
            for (int k2 = 0; k2 < 2; ++k2)
#pragma unroll
                for (int dvb = 0; dvb < 4; ++dvb) av[k2][dvb] = *(const bf16x8*)(smem + st + 24576 + toff(dvb * 32 + lr, 2 * (kh * 2 + k2) + hi));
            __builtin_amdgcn_sched_barrier(0);
#pragma unroll
            for (int k2 = 0; k2 < 2; ++k2)
#pragma unroll
                for (int dvb = 0; dvb < 4; ++dvb) o[dvb] = __builtin_amdgcn_mfma_f32_32x32x16_bf16(av[k2][dvb], pf[kh * 2 + k2], o[dvb], 0, 0, 0);
            __builtin_amdgcn_sched_barrier(0);
        }
    }
    l += __shfl_xor(l, 32);
    const float inv = 1.0f / l;
    __syncthreads();
    u16* Os = (u16*)smem;
#pragma unroll
    for (int dvb = 0; dvb < 4; ++dvb)
#pragma unroll
        for (int q = 0; q < 4; ++q) {
            const int dv = dvb * 32 + 8 * q + 4 * hi;
            u32x2 pk; pk.x = pk2(o[dvb][4 * q] * inv, o[dvb][4 * q + 1] * inv); pk.y = pk2(o[dvb][4 * q + 2] * inv, o[dvb][4 * q + 3] * inv);
            *(u32x2*)(Os + (w * 32 + lr) * 136 + dv) = pk;
        }
    __syncthreads();
    u16* O = (u16*)(ws + WS_O);
#pragma unroll
    for (int ps = 0; ps < 8; ++ps) {
        const int qq = ps * 16 + (tid >> 4), c = (tid & 15) * 8;
        *(u32x4*)(O + (size_t)(t0 + q0 + qq) * DM + h * 128 + c) = *(const u32x4*)(Os + qq * 136 + c);
    }
}
__device__ __forceinline__ void phase_attn(const Params& p, int bid, int nb) {
    const int x = bid & 7, lb = bid >> 3, nlb = nb >> 3, vh = vhalf();
    for (int it = 0;; ++it) {
        const int c = it * nlb + lb;
        if (c >= 64) break;
        const int bh = x * 4 + (c >> 5) * 2 + vh, q = c & 31, qb = (it & 1) ? q : 31 - q;
        attn_task(p, bh >> 3, bh & 7, qb);
    }
}

#define XB_TMO      128
#define XB_XCNT(j)  (256  + 64 * (j))
#define XB_XSUB(j)  (1280 + 64 * (j))
#define XB_XGEN(j)  (2304 + 64 * (j))
#define XB_TOP      3328
#define XB_TOPGEN   3392
#define XCD_BAR_WORDS 3456
#define XB_SPIN_CAP (1u << 22)
#define LAS __attribute__((address_space(3)))
__device__ __forceinline__ unsigned xb_ld(unsigned* p)              { return __hip_atomic_load(p, __ATOMIC_RELAXED, __HIP_MEMORY_SCOPE_AGENT); }
__device__ __forceinline__ unsigned xb_add(unsigned* p, unsigned v) { return __hip_atomic_fetch_add(p, v, __ATOMIC_RELAXED, __HIP_MEMORY_SCOPE_AGENT); }
__device__ __forceinline__ unsigned xb_xcc_id() { return (unsigned)__builtin_amdgcn_s_getreg((3 << 11) | 20) & 0xFu; }
#define XB_SPIN(cond, bar) do { unsigned _sp = 0; while (cond) { __builtin_amdgcn_s_sleep(1); \
    if ((++_sp & 255u) == 0u) { if (xb_ld(&(bar)[XB_TMO])) break; if (_sp > XB_SPIN_CAP) { atomicAdd(&(bar)[XB_TMO], 1u); break; } } } } while (0)
__device__ __forceinline__ void xcd_barrier_complete(unsigned* bar, unsigned x, unsigned& nloc, unsigned& nx) {
    const unsigned G = gridDim.x;
    unsigned sum, cnt, mine, sp = 0u;
    for (;;) {
        sum = 0u; cnt = 0u; mine = 0u;
#pragma unroll
        for (unsigned j = 0; j < 16; ++j) { const unsigned c = xb_ld(&bar[XB_XCNT(j)]); sum += c; cnt += (c > 0u) ? 1u : 0u; mine = (j == x) ? c : mine; }
        if (sum == G) break;
        __builtin_amdgcn_s_sleep(1);
        if ((++sp & 255u) == 0u) { if (xb_ld(&bar[XB_TMO])) break; if (sp > XB_SPIN_CAP) { atomicAdd(&bar[XB_TMO], 1u); break; } }
    }
    nloc = mine > 0u ? mine : 1u; nx = cnt > 0u ? cnt : 1u;
}
__device__ __forceinline__ void xcd_barrier(unsigned* bar, unsigned nloc, unsigned nx) {
    asm volatile("s_waitcnt vmcnt(0)" ::: "memory");
    __syncthreads();
    if (threadIdx.x == 0) {
        const unsigned x = xb_xcc_id();
        __builtin_amdgcn_s_waitcnt(0);
        const unsigned old = xb_add(&bar[XB_XSUB(x)], 1u);
        const unsigned gen = old / nloc;
        if (old + 1u == (gen + 1u) * nloc) {
            __builtin_amdgcn_fence(__ATOMIC_RELEASE, "agent");
            asm volatile("s_waitcnt vmcnt(0)" ::: "memory");
            const unsigned og = xb_add(&bar[XB_TOP], 1u);
            const unsigned tg = og / nx;
            if (og + 1u == (tg + 1u) * nx) xb_add(&bar[XB_TOPGEN], 1u);
            else XB_SPIN(xb_ld(&bar[XB_TOPGEN]) == tg, bar);
            __builtin_amdgcn_fence(__ATOMIC_ACQUIRE, "agent");
            xb_add(&bar[XB_XGEN(x)], 1u);
            asm volatile("s_waitcnt vmcnt(0)" ::: "memory");
        } else {
            XB_SPIN(xb_ld(&bar[XB_XGEN(x)]) == gen, bar);
            __builtin_amdgcn_fence(__ATOMIC_ACQUIRE, "agent");
            asm volatile("s_waitcnt vmcnt(0)" ::: "memory");
        }
    }
    __syncthreads();
}

constexpr int NPHASES = 15;
template <int PH>
__device__ __forceinline__ void run_phase(const Params& p, int rbid, int rnb) {
    unsigned char* ws = p.ws;
    u16* hb = (u16*)(ws + WS_H); float* ssq2 = (float*)(ws + WS_SSQ);
    constexpr bool REAL = (PH == 1 || PH == 5 || PH == 6 || PH == 8 || PH == 10 || PH == 11 || PH == 12 || PH == 13);
    const int bid = REAL ? rbid : rbid * 2 + vhalf(), nb = REAL ? rnb : rnb * 2;
    if constexpr (PH == 0) phase_prep(p, bid, nb);
    else if constexpr (PH == 1) phase_inproj(p, bid, nb);
    else if constexpr (PH == 2) phase_mixA(p, bid, nb);
    else if constexpr (PH == 3) phase_scan(p, bid, nb);
    else if constexpr (PH == 4) phase_mixB(p, bid, nb);
    else if constexpr (PH == 5) phase_gemm_residual(p, (const u16*)(ws + WS_Y), HY_OUT, (const u16*)(ws + WS_WOUTT), HY_OUT, p.x, p.out, p.norm_ffn, hb, ssq2, bid, nb);
    else if constexpr (PH == 6) phase_scores_top16(p, 0, bid, nb);
    else if constexpr (PH == 7) phase_peer<0>(p, 0, p.norm_mix + DM, bid, nb);
    else if constexpr (PH == 8) phase_gemm_f32<DM, MLA_DOWN_PAD>((const u16*)(ws + WS_H), (const u16*)(ws + WS_WDOWNT), (float*)(ws + WS_DOWN), bid, nb);
    else if constexpr (PH == 9) phase_mla_norm(p, bid, nb);
    else if constexpr (PH == 10) phase_mla_up(p, bid, nb);
    else if constexpr (PH == 11) phase_attn(p, bid, nb);
    else if constexpr (PH == 12) phase_gemm_residual(p, (const u16*)(ws + WS_O), DM, (const u16*)(ws + WS_WMOT), DM, p.out, p.out, p.norm_ffn + DM, hb, ssq2, bid, nb);
    else if constexpr (PH == 13) phase_scores_top16(p, 1, bid, nb);
    else if constexpr (PH == 14) phase_peer<1>(p, 1, p.final_norm, bid, nb);
}

typedef const __attribute__((address_space(4))) unsigned long long* cptr64;
typedef __attribute__((address_space(1))) unsigned char* gptr8;
__device__ __forceinline__ void load_params(Params& r, cptr64 s) {
    const float** f = (const float**)&r;
#pragma unroll
    for (int i = 0; i < 20; ++i) f[i] = (const float*)(gptr8)s[i];
    r.out = (float*)(gptr8)s[20]; r.ws = (unsigned char*)(gptr8)s[21];
}
#ifdef PROBE_A_LO
__device__ __forceinline__ void probe_stamp(cptr64 ka, int k) {
    if (blockIdx.x == 0 && threadIdx.x == 0) { unsigned long long* ts = (unsigned long long*)((unsigned char*)ka[21] + WS_TS); __hip_atomic_store(&ts[k], (unsigned long long)__builtin_amdgcn_s_memrealtime(), __ATOMIC_RELAXED, __HIP_MEMORY_SCOPE_AGENT); }
}
__device__ __forceinline__ void probe_emit(cptr64 ka) {
    unsigned long long* ts = (unsigned long long*)((unsigned char*)ka[21] + WS_TS);
    const float ta = (float)(long long)(__hip_atomic_load(&ts[PROBE_A_HI], __ATOMIC_RELAXED, __HIP_MEMORY_SCOPE_AGENT) - __hip_atomic_load(&ts[PROBE_A_LO], __ATOMIC_RELAXED, __HIP_MEMORY_SCOPE_AGENT)) * 0.01f;
    const float tb = (float)(long long)(__hip_atomic_load(&ts[PROBE_B_HI], __ATOMIC_RELAXED, __HIP_MEMORY_SCOPE_AGENT) - __hip_atomic_load(&ts[PROBE_B_LO], __ATOMIC_RELAXED, __HIP_MEMORY_SCOPE_AGENT)) * 0.01f;
    float* out = (float*)ka[20];
    for (int i = blockIdx.x * 256 + threadIdx.x; i < 1024 * DM; i += gridDim.x * 256) out[i] += tb * 0.01f;
    if (blockIdx.x == 0 && threadIdx.x == 0) out[(size_t)T * DM - 1] = ta;
}
#endif
#ifndef DUP_MASK
#define DUP_MASK 0u
#endif

#ifdef MB_KIND
__device__ __forceinline__ void microbench(const Params& p) {
    float a[16]; f32x2 d[8]; unsigned src = threadIdx.x * 0x01010101u + 0x3c3c3c3cu; float x = (float)threadIdx.x * 1e-3f, y = 1.0001f;
#pragma unroll
    for (int i = 0; i < 16; ++i) a[i] = (float)i;
#pragma unroll
    for (int i = 0; i < 8; ++i) d[i] = (f32x2){0.f, 0.f};
#pragma unroll 1
    for (int it = 0; it < MB_N; ++it) {
#if MB_KIND == 0
#pragma unroll
        for (int i = 0; i < 16; ++i) asm volatile("v_fmac_f32 %0, %1, %2" : "+v"(a[i]) : "v"(x), "v"(y));
#elif MB_KIND == 1
#pragma unroll
        for (int i = 0; i < 16; ++i) asm volatile("v_fmac_f32 %0, %1, %2" : "+v"(a[0]) : "v"(x), "v"(y));
#elif MB_KIND == 2
#pragma unroll
        for (int i = 0; i < 16; ++i) asm volatile("v_cvt_pk_f32_fp8 %0, %1" : "=v"(d[i & 7]) : "v"(src));
#elif MB_KIND == 3
#pragma unroll
        for (int i = 0; i < 16; ++i) asm volatile("v_cvt_pk_f32_fp8_sdwa %0, %1 src0_sel:WORD_1" : "=v"(d[i & 7]) : "v"(src));
#elif MB_KIND == 4
#pragma unroll
        for (int i = 0; i < 16; ++i) asm volatile("v_cvt_scalef32_pk_f32_fp4 %0, %1, 1.0" : "=v"(d[i & 7]) : "v"(src));
#elif MB_KIND == 5
#pragma unroll
        for (int i = 0; i < 16; ++i) asm volatile("v_perm_b32 %0, %1, %2, %3" : "=v"(a[i]) : "v"(src), "v"(x), "v"(y));
#elif MB_KIND == 6
#pragma unroll
        for (int i = 0; i < 16; ++i) asm volatile("v_pk_fma_f16 %0, %1, %2, %0" : "+v"(a[i]) : "v"(x), "v"(y));
#elif MB_KIND == 7
#pragma unroll
        for (int i = 0; i < 16; ++i) asm volatile("v_cvt_scalef32_pk_f16_fp4 %0, %1, 1.0" : "=v"(a[i]) : "v"(src));
#elif MB_KIND == 8
#pragma unroll
        for (int i = 0; i < 16; ++i) asm volatile("v_pk_fma_f32 %0, %1, %2, %0" : "+v"(d[i & 7]) : "v"(d[(i + 1) & 7]), "v"(d[(i + 2) & 7]));
#elif MB_KIND == 9
#pragma unroll
        for (int i = 0; i < 16; ++i) asm volatile("v_dot2c_f32_bf16 %0, %1, %2" : "+v"(a[i]) : "v"(src), "v"(y));
#elif MB_KIND == 10
        {
            typedef _Float16 h32 __attribute__((ext_vector_type(32))); typedef unsigned u6 __attribute__((ext_vector_type(6)));
            u6 sv = {src, src ^ 1u, src ^ 2u, src ^ 3u, src ^ 4u, src ^ 5u};
#pragma unroll
            for (int i = 0; i < 16; ++i) { asm volatile("" : "+v"(sv)); h32 h = __builtin_amdgcn_cvt_scalef32_pk32_f16_fp6(sv, 1.0f); asm volatile("" :: "v"(h)); }
        }
#elif MB_KIND == 11
#pragma unroll
        for (int i = 0; i < 16; ++i) asm volatile("v_dot2c_f32_f16 %0, %1, %2" : "+v"(a[i]) : "v"(src), "v"(y));
#elif MB_KIND == 12
#pragma unroll
        for (int i = 0; i < 16; ++i) asm volatile("v_dot2c_f32_f16 %0, %1, %2" : "+v"(a[0]) : "v"(src), "v"(y));
#elif MB_KIND == 13
#pragma unroll
        for (int i = 0; i < 16; ++i) asm volatile("v_cvt_scalef32_pk_bf16_fp8 %0, %1, 1.0" : "=v"(a[i]) : "v"(src));
#elif MB_KIND == 14
#pragma unroll
        for (int i = 0; i < 16; ++i) asm volatile("v_cvt_scalef32_pk_f16_fp8 %0, %1, 1.0" : "=v"(a[i]) : "v"(src));
#elif MB_KIND == 15
#pragma unroll
        for (int i = 0; i < 16; ++i) asm volatile("v_add_f32_dpp %0, %0, %0 row_ror:4 row_mask:0xf bank_mask:0xf" : "+v"(a[i]));
#endif
    }
    float r = 0.f;
#pragma unroll
    for (int i = 0; i < 16; ++i) r += a[i];
#pragma unroll
    for (int i = 0; i < 8; ++i) r += d[i][0] + d[i][1];
    if (r == 123.456f) ((float*)(p.ws + WS_PROJ))[threadIdx.x] = r;
}
#endif
template <int PH>
__device__ __forceinline__ void run_dup(const Params& lp, int bid, int nb) {
    unsigned char* ws = lp.ws;
    if constexpr (PH == 7) phase_peer<PEER_DUP_MODE>(lp, 0, lp.norm_mix + DM, bid * 2 + vhalf(), nb * 2);
    else if constexpr (PH == 14) phase_peer<PEER_DUP_MODE>(lp, 1, lp.final_norm, bid * 2 + vhalf(), nb * 2);
    else if constexpr (PH == 12) phase_gemm_residual(lp, (const u16*)(ws + WS_O), DM, (const u16*)(ws + WS_WMOT), DM, lp.out, (float*)(ws + WS_PROJ), lp.norm_ffn + DM, (u16*)(ws + WS_PROJ + (size_t)T * DM * 4), (float*)(ws + WS_PROJ + (size_t)T * DM * 6), bid, nb);
#ifdef MB_KIND
    else if constexpr (PH == 3) microbench(lp);
#else
    else if constexpr (PH == 3) {}
#endif
#ifdef PROBE_GM
    else if constexpr (PH == 1) phase_inproj<PROBE_GM>(lp, bid, nb);
#endif
    else run_phase<PH>(lp, bid, nb);
}
template <int PH>
__device__ __forceinline__ void run_from(cptr64 ka, unsigned nloc, unsigned nx) {
#ifdef PROBE_A_LO
    probe_stamp(ka, PH);
#endif
    if constexpr (((DUP_MASK >> PH) & 1u) != 0u) {
        cptr64 q = ka; asm volatile("" : "+s"(q));
        Params lp; load_params(lp, q);
        run_dup<PH>(lp, (int)blockIdx.x, (int)gridDim.x);
        xcd_barrier((unsigned*)((unsigned char*)q[21] + WS_BAR), nloc, nx);
    }
    {
        cptr64 q = ka; asm volatile("" : "+s"(q));
        Params lp; load_params(lp, q);
        run_phase<PH>(lp, (int)blockIdx.x, (int)gridDim.x);
    }
    if constexpr (PH + 1 < NPHASES) {
        cptr64 q = ka; asm volatile("" : "+s"(q));
        xcd_barrier((unsigned*)((unsigned char*)q[21] + WS_BAR), nloc, nx);
        run_from<PH + 1>(ka, nloc, nx);
    }
#ifdef PROBE_A_LO
    else {
        cptr64 q = ka; asm volatile("" : "+s"(q));
        xcd_barrier((unsigned*)((unsigned char*)q[21] + WS_BAR), nloc, nx);
        probe_stamp(ka, NPHASES);
        xcd_barrier((unsigned*)((unsigned char*)q[21] + WS_BAR), nloc, nx);
        probe_emit(ka);
    }
#endif
}
__global__ void __launch_bounds__(NTHREADS, 2) k_mega(Params p_unused) {
    cg::grid_group grid = cg::this_grid();
    cptr64 ka = (cptr64)__builtin_amdgcn_kernarg_segment_ptr();
    unsigned* bar = (unsigned*)((unsigned char*)ka[21] + WS_BAR);
    if (threadIdx.x == 0) (void)xb_add(&bar[XB_XCNT(xb_xcc_id())], 1u);
#ifdef PROBE_A_LO
    probe_stamp(ka, 0);
#endif
    {
        cptr64 q = ka; asm volatile("" : "+s"(q));
        Params lp; load_params(lp, q);
        run_phase<0>(lp, (int)blockIdx.x, (int)gridDim.x);
    }
    if constexpr ((DUP_MASK & 1u) != 0u) {
        __syncthreads();
        cptr64 q = ka; asm volatile("" : "+s"(q));
        Params lp; load_params(lp, q);
        run_phase<0>(lp, (int)blockIdx.x, (int)gridDim.x);
    }
    unsigned nloc, nx;
    {
        const unsigned x = xb_xcc_id(), G = gridDim.x;
        unsigned cnt, mine, sum, sp = 0u;
        for (;;) {
            sum = 0u; cnt = 0u; mine = 0u;
#pragma unroll
            for (unsigned j = 0; j < 16; ++j) { const unsigned c = __builtin_amdgcn_readfirstlane(xb_ld(&bar[XB_XCNT(j)])); sum += c; cnt += (c > 0u) ? 1u : 0u; mine = (j == x) ? c : mine; }
            if (sum == G) break;
            __builtin_amdgcn_s_sleep(2);
            if (++sp > XB_SPIN_CAP) break;
        }
        nloc = __builtin_amdgcn_readfirstlane(mine > 0u ? mine : 1u); nx = __builtin_amdgcn_readfirstlane(cnt > 0u ? cnt : 1u);
    }
    xcd_barrier(bar, nloc, nx);
    run_from<1>(ka, nloc, nx);
}

extern "C" void kernel_launch(void* const* d_in, const int* in_sizes, int n_in, void* d_out, int out_size, void* d_ws, size_t ws_size, hipStream_t stream) {
    if (n_in != 20 || out_size != T * DM || ws_size < WS_END) { fprintf(stderr, "kernel_launch: unexpected shapes (n_in %d out %d ws %zu need %zu)\n", n_in, out_size, ws_size, (size_t)WS_END); return; }
    static int grid_blocks = 0;
    if (!grid_blocks) {
        int dev = 0, cus = 0, per_cu = 0;
        (void)hipGetDevice(&dev);
        (void)hipDeviceGetAttribute(&cus, hipDeviceAttributeMultiprocessorCount, dev);
        if (hipFuncSetAttribute((const void*)k_mega, hipFuncAttributeMaxDynamicSharedMemorySize, LDS_TOTAL) != hipSuccess) { fprintf(stderr, "kernel_launch: hipFuncSetAttribute failed\n"); return; }
        if (hipOccupancyMaxActiveBlocksPerMultiprocessor(&per_cu, (const void*)k_mega, NTHREADS, LDS_TOTAL) != hipSuccess || per_cu < 1) { fprintf(stderr, "kernel_launch: occupancy query failed (%d)\n", per_cu); return; }
        if (per_cu > 1) per_cu = 1;
        grid_blocks = cus * per_cu;
        fprintf(stderr, "kernel_launch: %d CUs x %d blocks\n", cus, per_cu);
    }
    Params p{};
    const float** f = (const float**)&p;
    for (int i = 0; i < 20; ++i) f[i] = (const float*)d_in[i];
    p.out = (float*)d_out; p.ws = (unsigned char*)d_ws;
    (void)hipMemsetAsync((unsigned char*)d_ws + WS_BAR, 0, 16384, stream);
    void* args[] = {&p};
    hipError_t e = hipLaunchCooperativeKernel((const void*)k_mega, dim3(grid_blocks), dim3(NTHREADS), args, LDS_TOTAL, stream);
    if (e != hipSuccess) fprintf(stderr, "cooperative launch failed: %s (grid %d)\n", hipGetErrorString(e), grid_blocks);
}
```
